# Optimizing an MI355X kernel written in HIP

```python
import jax
import jax.numpy as jnp
from jax import lax
import numpy as np

D_MODEL = 1024
BATCH = 8
SEQ = 8192
DEPTH = 1
DEC_BATCH = 32
DEC_SEQ = 32
PAST_LEN = 4096

CHUNK = 64
N_META = 16
Q_BLOCK = 128
EPS = 1e-6
NEG_INF = -1e30
MLA_HEADS = 8
MLA_Q_LORA = 384
MLA_KV_LORA = 256
MLA_NOPE = 64
MLA_ROPE = 32
MLA_QK_DIM = MLA_NOPE + MLA_ROPE
MLA_V = 64
MLA_WIDTH = MLA_HEADS * MLA_V
MLA_SCALE = MLA_QK_DIM ** -0.5
ROPE_THETA = 10000.0
FOX_HEADS = 8
FOX_HEAD_DIM = 64
FOX_WIDTH = FOX_HEADS * FOX_HEAD_DIM
FOX_SCALE = FOX_HEAD_DIM ** -0.5
FORGET_BIAS_INIT = 3.0
D_MIX = MLA_WIDTH + FOX_WIDTH
IN_SPLIT_SIZES = (MLA_Q_LORA, MLA_KV_LORA, MLA_ROPE, FOX_WIDTH, FOX_WIDTH, FOX_WIDTH, FOX_HEADS)
D_IN = sum(IN_SPLIT_SIZES)
IN_SPLIT_POINTS = tuple(int(v) for v in np.cumsum(IN_SPLIT_SIZES)[:-1])
D_FF = ((8 * D_MODEL + 3 * 256 - 1) // (3 * 256)) * 256

kernel_name = 'hymba_mla_fox_streaming_step'


def rms_norm(x, g):
    xf = x.astype(jnp.float32)
    y = xf * lax.rsqrt(jnp.mean(xf * xf, axis=-1, keepdims=True) + EPS)
    return (y * g.astype(jnp.float32)).astype(x.dtype)


def rope(x, pos):
    half = MLA_ROPE // 2
    inv_freq = ROPE_THETA ** (-jnp.arange(half, dtype=jnp.float32) / half)
    ang = pos.astype(jnp.float32)[:, None] * inv_freq[None, :]
    cos = jnp.cos(ang)[None, :, None, :]
    sin = jnp.sin(ang)[None, :, None, :]
    xf = x.astype(jnp.float32)
    x1, x2 = xf[..., :half], xf[..., half:]
    return jnp.concatenate([x1 * cos - x2 * sin, x2 * cos + x1 * sin], axis=-1).astype(x.dtype)


def attend(q, k, v, scale, valid, bias=None):
    s = jnp.einsum('bqhd,bkhd->bhqk', q, k).astype(jnp.float32) * scale
    if bias is not None:
        s = s + bias
    if valid is not None:
        s = jnp.where(valid, s, NEG_INF)
    p = jax.nn.softmax(s, axis=-1).astype(v.dtype)
    return jnp.einsum('bhqk,bkhd->bqhd', p, v)


def fox_bias(cum_q, cum_k):
    return jnp.transpose(cum_q, (0, 2, 1))[..., :, None] - jnp.transpose(cum_k, (0, 2, 1))[..., None, :]


def project(h, pos, w_in, b_forget, q_norm, w_uq, kv_norm):
    B, L, _ = h.shape
    proj = h @ w_in
    c_q, c_kv, k_r, f_q, f_k, f_v, f_logit = jnp.split(proj, IN_SPLIT_POINTS, axis=-1)
    q = (rms_norm(c_q, q_norm) @ w_uq).reshape(B, L, MLA_HEADS, MLA_QK_DIM)
    q_mla = jnp.concatenate([q[..., :MLA_NOPE], rope(q[..., MLA_NOPE:], pos)], axis=-1)
    latent = rms_norm(c_kv, kv_norm)
    k_rope = rope(k_r[:, :, None, :], pos)[:, :, 0, :]
    heads = lambda a: a.reshape(B, L, FOX_HEADS, FOX_HEAD_DIM)
    log_f = jax.nn.log_sigmoid(f_logit.astype(jnp.float32) + b_forget.astype(jnp.float32))
    return q_mla, latent, k_rope, heads(f_q), heads(f_k), heads(f_v), log_f


def expand_mla_kv(latent, k_rope, w_ukv):
    B, K, _ = latent.shape
    kv = (latent @ w_ukv).reshape(B, K, MLA_HEADS, MLA_NOPE + MLA_V)
    k = jnp.concatenate([kv[..., :MLA_NOPE],
                         jnp.broadcast_to(k_rope[:, :, None, :], (B, K, MLA_HEADS, MLA_ROPE))], axis=-1)
    return k, kv[..., MLA_NOPE:]


def mix_prompt(h, w_in, b_forget, q_norm, w_uq, kv_norm, w_ukv):
    B, L, _ = h.shape
    idx = jnp.arange(L)
    cid = jnp.where(idx < N_META, -1, (idx - N_META) // CHUNK)
    q_mla, latent, k_rope, f_q, f_k, f_v, log_f = project(h, idx, w_in, b_forget, q_norm, w_uq, kv_norm)
    k_mla, v_mla = expand_mla_kv(latent, k_rope, w_ukv)
    cum = jnp.cumsum(log_f, axis=1)

    def block(start):
        take = lambda a: lax.dynamic_slice_in_dim(a, start, Q_BLOCK, axis=1)
        q_idx = start + jnp.arange(Q_BLOCK)
        q_cid = lax.dynamic_slice_in_dim(cid, start, Q_BLOCK, axis=0)
        o_a = attend(take(q_mla), k_mla, v_mla, MLA_SCALE, cid[None, :] <= q_cid[:, None])
        o_b = attend(take(f_q), f_k, f_v, FOX_SCALE, idx[None, :] <= q_idx[:, None],
                     fox_bias(take(cum), cum))
        return jnp.concatenate([o_a.reshape(B, Q_BLOCK, MLA_WIDTH),
                                o_b.reshape(B, Q_BLOCK, FOX_WIDTH)], axis=-1)

    out = lax.map(block, jnp.arange(0, L, Q_BLOCK))
    mixed = jnp.moveaxis(out, 0, 1).reshape(B, L, D_MIX)
    return mixed, (latent, k_rope, f_k, f_v, log_f)


def mix_sample(h, c_lat, c_kr, c_fk, c_fv, c_lf, w_in, b_forget, q_norm, w_uq, kv_norm, w_ukv):
    B, S, _ = h.shape
    past = c_lat.shape[1]
    pos = past + jnp.arange(S)
    q_mla, latent, k_rope, f_q, f_k, f_v, log_f = project(h, pos, w_in, b_forget, q_norm, w_uq, kv_norm)
    k_mla, v_mla = expand_mla_kv(jnp.concatenate([c_lat, latent], axis=1),
                                 jnp.concatenate([c_kr, k_rope], axis=1), w_ukv)
    o_a = attend(q_mla, k_mla, v_mla, MLA_SCALE, None)
    cum = jnp.cumsum(jnp.concatenate([c_lf.astype(jnp.float32), log_f], axis=1), axis=1)
    valid = jnp.arange(past + S)[None, :] <= pos[:, None]
    o_b = attend(f_q, jnp.concatenate([c_fk, f_k], axis=1), jnp.concatenate([c_fv, f_v], axis=1),
                 FOX_SCALE, valid, fox_bias(cum[:, past:], cum))
    mixed = jnp.concatenate([o_a.reshape(B, S, MLA_WIDTH), o_b.reshape(B, S, FOX_WIDTH)], axis=-1)
    return mixed, (latent, k_rope, f_k, f_v, log_f)


def finish_layer(x, mixed, w_out, norm_ffn, w_gate, w_up, w_down):
    x = x + mixed @ w_out
    h = rms_norm(x, norm_ffn)
    return x + (jax.nn.silu(h @ w_gate) * (h @ w_up)) @ w_down


def setup_inputs(seed: int = 0) -> dict:
    key = jax.random.key(seed)
    ks = jax.random.split(key, 22)
    nrm = lambda k, shape, scale=1.0: scale * jax.random.normal(k, shape, jnp.float32)
    gain = lambda k, shape: 1.0 + 0.02 * jax.random.normal(k, shape, jnp.float32)
    return {
        'x_prompt': nrm(ks[0], (BATCH, SEQ, D_MODEL)),
        'x_sample': nrm(ks[1], (DEC_BATCH, DEC_SEQ, D_MODEL)),
        'cache_mla_latent': nrm(ks[2], (DEPTH, DEC_BATCH, PAST_LEN, MLA_KV_LORA)),
        'cache_mla_krope': nrm(ks[3], (DEPTH, DEC_BATCH, PAST_LEN, MLA_ROPE)),
        'cache_fox_k': nrm(ks[4], (DEPTH, DEC_BATCH, PAST_LEN, FOX_HEADS, FOX_HEAD_DIM)),
        'cache_fox_v': nrm(ks[5], (DEPTH, DEC_BATCH, PAST_LEN, FOX_HEADS, FOX_HEAD_DIM)),
        'cache_fox_logf': jax.nn.log_sigmoid(FORGET_BIAS_INIT + nrm(ks[6], (DEPTH, DEC_BATCH, PAST_LEN, FOX_HEADS))),
        'meta_tokens': nrm(ks[7], (N_META, D_MODEL)),
        'norm_mix': gain(ks[8], (DEPTH, D_MODEL)),
        'w_in': nrm(ks[9], (DEPTH, D_MODEL, D_IN), D_MODEL ** -0.5),
        'b_forget': FORGET_BIAS_INIT + 0.5 * nrm(ks[10], (DEPTH, FOX_HEADS)),
        'mla_q_norm': gain(ks[11], (DEPTH, MLA_Q_LORA)),
        'w_mla_uq': nrm(ks[12], (DEPTH, MLA_Q_LORA, MLA_HEADS * MLA_QK_DIM), MLA_Q_LORA ** -0.5),
        'mla_kv_norm': gain(ks[13], (DEPTH, MLA_KV_LORA)),
        'w_mla_ukv': nrm(ks[14], (DEPTH, MLA_KV_LORA, MLA_HEADS * (MLA_NOPE + MLA_V)), MLA_KV_LORA ** -0.5),
        'w_out': nrm(ks[15], (DEPTH, D_MIX, D_MODEL), D_MIX ** -0.5),
        'norm_ffn': gain(ks[16], (DEPTH, D_MODEL)),
        'w_ffn_gate': nrm(ks[17], (DEPTH, D_MODEL, D_FF), D_MODEL ** -0.5),
        'w_ffn_up': nrm(ks[18], (DEPTH, D_MODEL, D_FF), D_MODEL ** -0.5),
        'w_ffn_down': nrm(ks[19], (DEPTH, D_FF, D_MODEL), D_FF ** -0.5),
        'norm_final': gain(ks[20], (D_MODEL,)),
    }


def reference(x_prompt, x_sample, cache_mla_latent, cache_mla_krope, cache_fox_k, cache_fox_v,
              cache_fox_logf, meta_tokens, norm_mix, w_in, b_forget, mla_q_norm, w_mla_uq,
              mla_kv_norm, w_mla_ukv, w_out, norm_ffn, w_ffn_gate, w_ffn_up, w_ffn_down, norm_final):
    B = x_prompt.shape[0]
    L = N_META + x_prompt.shape[1]
    L_pad = -(-L // Q_BLOCK) * Q_BLOCK
    xp = jnp.concatenate([jnp.broadcast_to(meta_tokens[None].astype(x_prompt.dtype), (B, N_META, D_MODEL)),
                          x_prompt], axis=1)
    xp = jnp.pad(xp, ((0, 0), (0, L_pad - L), (0, 0)))
    xs = x_sample
    prompt_rows = []
    sample_rows = []
    for l in range(DEPTH):
        mix_w = (w_in[l], b_forget[l], mla_q_norm[l], w_mla_uq[l], mla_kv_norm[l], w_mla_ukv[l])
        ffn_w = (w_out[l], norm_ffn[l], w_ffn_gate[l], w_ffn_up[l], w_ffn_down[l])
        mixed, rows = mix_prompt(rms_norm(xp, norm_mix[l]), *mix_w)
        xp = finish_layer(xp, mixed, *ffn_w)
        prompt_rows.append(rows)
        mixed, rows = mix_sample(rms_norm(xs, norm_mix[l]), cache_mla_latent[l], cache_mla_krope[l],
                                 cache_fox_k[l], cache_fox_v[l], cache_fox_logf[l], *mix_w)
        xs = finish_layer(xs, mixed, *ffn_w)
        sample_rows.append(rows)
    y_prompt = rms_norm(xp[:, N_META:L], norm_final)
    y_sample = rms_norm(xs, norm_final)
    lat_p, kr_p, fk_p, fv_p, lf_p = [jnp.stack([r[i][:, :L] for r in prompt_rows]) for i in range(5)]
    lat_s, kr_s, fk_s, fv_s, lf_s = [jnp.stack([r[i] for r in sample_rows]) for i in range(5)]
    return (y_prompt, y_sample, lat_p, kr_p, fk_p, fv_p, lf_p, lat_s, kr_s, fk_s, fv_s, lf_s)
```

```cpp
#include <hip/hip_runtime.h>
#include <hip/hip_cooperative_groups.h>
#include <cstdio>
#include <cstdint>
namespace cg = cooperative_groups;
namespace pg8 {
#define PG8_LAS __attribute__((address_space(3)))
typedef unsigned short bf16_t;
typedef short bf16x8 __attribute__((ext_vector_type(8)));
typedef float f32x4 __attribute__((ext_vector_type(4)));
typedef unsigned u32x4 __attribute__((ext_vector_type(4)));
constexpr int BM = 256, BK = 64, HALF = 128, HTB = HALF * BK * 2  , STAGE_BYTES = 8 * HTB, NXCD = 8, WGM = 8;

__host__ __device__ __forceinline__ int lds_byte(int r, int c) { const int st = (r >> 4) * 2 + (c >> 5), rr = r & 15, cc = c & 31, ob = rr * 64 + cc * 2; return st * 1024 + (ob ^ (((ob >> 9) & 1) << 5)); }
__host__ __device__ __forceinline__ void stage_rc(int b, int& R, int& C) { const int st = b / 1024, sb = b % 1024, swz = sb ^ (((sb >> 9) & 1) << 5); R = (st >> 1) * 16 + swz / 64; C = (st & 1) * 32 + (swz % 64) / 2; }
__host__ __device__ __forceinline__ int perm32(int rho) { const int n = rho >> 4, i = rho & 15; return 8 * (i >> 2) + 4 * n + (i & 3); }

struct Unit { int pm, pn, ko; };
struct Gemm { const bf16_t* A; const bf16_t* Bt; int M, N, K, ld; };

struct StaticOrder {
    int nM, nN, nwg, G, c;
    __host__ __device__ void init(int M, int N, int G_, int c_) { nM = M / BM; nN = N / BM; nwg = nM * nN; G = G_; c = c_; }
    __host__ __device__ bool next(int i, Unit& u) const {
        const long L = (long)i * G + c; if (L >= nwg) return false;
        int wgid = (int)L; { const int q = nwg / NXCD, r = nwg % NXCD, xcd = wgid % NXCD, off = wgid / NXCD; wgid = (xcd < r ? xcd * (q + 1) : r * (q + 1) + (xcd - r) * q) + off; }
        const int nig = WGM * nN, gid = wgid / nig, fm = gid * WGM, gsz = (nM - fm) < WGM ? (nM - fm) : WGM;
        u.pm = fm + ((wgid % nig) % gsz); u.pn = (wgid % nig) / gsz; u.ko = 0; return true;
    }
    __device__ __forceinline__ void a_ready(const Unit&) const {}
    __device__ __forceinline__ void done(const Unit&) const {}
};

__device__ __forceinline__ unsigned cvt_pk_bf16(float lo, float hi) { unsigned r; asm volatile("v_cvt_pk_bf16_f32 %0, %1, %2" : "=v"(r) : "v"(lo), "v"(hi)); return r; }
template <class Epi, class Sched, bool ALIGN_EPI = false, bool SP2 = false>
__device__ __forceinline__ void gemm_phase(PG8_LAS unsigned char* lds, const Gemm g, const Sched& S, const Epi& E) {
    int tid_o = threadIdx.x; asm volatile("" : "+v"(tid_o));
    const int tid = tid_o, wid = __builtin_amdgcn_readfirstlane(tid >> 6), lane = tid & 63, wr = wid >> 2, wc = wid & 3, fr = lane & 15, fq = lane >> 4;
    const int K = g.K, nt = K / BK, LD = g.ld ? g.ld : g.K;
    unsigned voffA[2], voffB[2];
#pragma unroll
    for (int i = 0; i < 2; ++i) { int R, C; stage_rc(tid * 16 + i * 8192, R, C); const int Rb = Epi::PERM ? ((R & ~31) + perm32(R & 31)) : R;
        voffA[i] = (unsigned)(R * LD + C) * 2u; voffB[i] = (unsigned)(Rb * LD + C) * 2u; }
    const size_t kstep = (size_t)(BK * 2);
    const size_t hstep = (size_t)HALF * LD * 2;
    const size_t tstep = 2 * hstep;
    const unsigned ldsw = (unsigned)wid * 1024u;
    const int aoff = lds_byte(wr * 64 + fr, fq * 8), boff = lds_byte(wc * 32 + fr, fq * 8);
#define PG8_SA(b, h) (((b) * 2 + (h)) * HTB)
#define PG8_SB(b, h) ((4 + (b) * 2 + (h)) * HTB)
#define PG8_STAGE(bufoff, gbase, voff) do { _Pragma("unroll") for (int _i = 0; _i < 2; ++_i) \
        __builtin_amdgcn_global_load_lds((const unsigned*)((const char*)(gbase) + (voff)[_i]), (PG8_LAS unsigned*)(lds + (bufoff) + ldsw + _i * 8192), 16, 0, 0); } while (0)
#define PG8_LDA(dst, b, h) do { _Pragma("unroll") for (int m = 0; m < 4; ++m) _Pragma("unroll") for (int k = 0; k < 2; ++k) dst[m][k] = *(const PG8_LAS bf16x8*)(lds + PG8_SA(b, h) + aoff + m * 2048 + k * 1024); } while (0)
#define PG8_LDB(dst, b, h) do { _Pragma("unroll") for (int n = 0; n < 2; ++n) _Pragma("unroll") for (int k = 0; k < 2; ++k) dst[n][k] = *(const PG8_LAS bf16x8*)(lds + PG8_SB(b, h) + boff + n * 2048 + k * 1024); } while (0)
#define PG8_MMA(ai, bj, At, Bt) do { __builtin_amdgcn_s_setprio(1); _Pragma("unroll") for (int m = 0; m < 4; ++m) _Pragma("unroll") for (int n = 0; n < 2; ++n) _Pragma("unroll") for (int k = 0; k < 2; ++k) \
        acc[ai][bj][m][n] = __builtin_amdgcn_mfma_f32_16x16x32_bf16(Bt[n][k], At[m][k], acc[ai][bj][m][n], 0, 0, 0); __builtin_amdgcn_s_setprio(0); } while (0)
#define PG8_WAIT_V(n) asm volatile("s_waitcnt vmcnt(" #n ")" ::: "memory")
#define PG8_WAIT_L(n) asm volatile("s_waitcnt lgkmcnt(" #n ")" ::: "memory")
#define PG8_BAR __builtin_amdgcn_s_barrier()
#define PG8_SCHED __builtin_amdgcn_sched_barrier(0)
    Unit cur, nxt; int ui = 0;
    if (!S.next(0, cur)) return;
    f32x4 acc[2][2][4][2];
#pragma unroll
    for (int a = 0; a < 2; ++a)
#pragma unroll
        for (int b = 0; b < 2; ++b)
#pragma unroll
            for (int m = 0; m < 4; ++m)
#pragma unroll
                for (int n = 0; n < 2; ++n) acc[a][b][m][n] = (f32x4){0.f, 0.f, 0.f, 0.f};
    bf16x8 At[4][2], B0[2][2], B1[2][2];
    const char* cA = (const char*)g.A + (size_t)cur.pm * tstep + (size_t)cur.ko * 2; const char* cB = (const char*)g.Bt + (size_t)cur.pn * tstep + (size_t)cur.ko * 2;
    S.a_ready(cur);
    if constexpr (SP2) {
        PG8_STAGE(PG8_SB(0, 0), cB, voffB); PG8_STAGE(PG8_SB(0, 1), cB + hstep, voffB); PG8_STAGE(PG8_SA(0, 0), cA, voffA); PG8_STAGE(PG8_SA(0, 1), cA + hstep, voffA);
        if (wr == 1) PG8_BAR;
        PG8_WAIT_V(2); PG8_BAR;
        PG8_STAGE(PG8_SB(1, 0), cB + kstep, voffB); PG8_STAGE(PG8_SA(1, 0), cA + kstep, voffA); PG8_STAGE(PG8_SB(1, 1), cB + hstep + kstep, voffB);
        PG8_WAIT_V(6); PG8_BAR;
    } else {
        PG8_STAGE(PG8_SB(0, 0), cB, voffB); PG8_STAGE(PG8_SA(0, 0), cA, voffA); PG8_STAGE(PG8_SB(0, 1), cB + hstep, voffB); PG8_STAGE(PG8_SA(0, 1), cA + hstep, voffA);
        if (wr == 1) PG8_BAR;
        PG8_WAIT_V(4); PG8_BAR;
        PG8_STAGE(PG8_SB(1, 0), cB + kstep, voffB); PG8_STAGE(PG8_SA(1, 0), cA + kstep, voffA); PG8_STAGE(PG8_SB(1, 1), cB + hstep + kstep, voffB);
        PG8_WAIT_V(6); PG8_BAR;
    }
    for (;;) {
        const bool has_next = S.next(ui + 1, nxt);
        const char* nA = has_next ? (const char*)g.A + (size_t)nxt.pm * tstep + (size_t)nxt.ko * 2 : cA; const char* nB = has_next ? (const char*)g.Bt + (size_t)nxt.pn * tstep + (size_t)nxt.ko * 2 : cB;
        for (int t = 0; t < nt; t += 2) {
            const bool last = (t == nt - 2);
            const char* a1 = cA + (size_t)(t + 1) * kstep;
            const char* a2 = last ? nA : cA + (size_t)(t + 2) * kstep; const char* b2 = last ? nB : cB + (size_t)(t + 2) * kstep;
            const char* a3 = a2 + kstep; const char* b3 = b2 + kstep;
            if (last && has_next) S.a_ready(nxt);
            if constexpr (SP2) {
            PG8_LDB(B0, 0, 0); PG8_LDB(B1, 0, 1); PG8_SCHED; PG8_LDA(At, 0, 0); PG8_STAGE(PG8_SA(1, 1), a1 + hstep, voffA);
            PG8_WAIT_V(8); PG8_WAIT_L(0); PG8_BAR; PG8_MMA(0, 0, At, B0); PG8_MMA(0, 1, At, B1); PG8_BAR; PG8_SCHED;
            PG8_LDA(At, 0, 1); PG8_STAGE(PG8_SB(0, 0), b2, voffB); PG8_STAGE(PG8_SB(0, 1), b2 + hstep, voffB); PG8_STAGE(PG8_SA(0, 0), a2, voffA);
            PG8_WAIT_V(8); PG8_WAIT_L(0); PG8_BAR; PG8_MMA(1, 0, At, B0); PG8_MMA(1, 1, At, B1); PG8_BAR; PG8_SCHED;
            PG8_LDB(B0, 1, 0); PG8_LDB(B1, 1, 1); PG8_SCHED; PG8_LDA(At, 1, 0); PG8_STAGE(PG8_SA(0, 1), a2 + hstep, voffA);
            PG8_WAIT_V(8); PG8_WAIT_L(0); PG8_BAR; PG8_MMA(0, 0, At, B0); PG8_MMA(0, 1, At, B1); PG8_BAR; PG8_SCHED;
            PG8_LDA(At, 1, 1); PG8_STAGE(PG8_SB(1, 0), b3, voffB); PG8_STAGE(PG8_SB(1, 1), b3 + hstep, voffB); PG8_STAGE(PG8_SA(1, 0), a3, voffA);
            PG8_WAIT_V(8); PG8_WAIT_L(0); PG8_BAR; PG8_MMA(1, 0, At, B0); PG8_MMA(1, 1, At, B1); PG8_BAR; PG8_SCHED;
            } else {
            PG8_LDB(B0, 0, 0); PG8_SCHED; PG8_LDA(At, 0, 0); PG8_STAGE(PG8_SA(1, 1), a1 + hstep, voffA);
            PG8_WAIT_L(8); PG8_BAR; PG8_WAIT_L(0); PG8_MMA(0, 0, At, B0); PG8_BAR; PG8_SCHED;
            PG8_LDB(B1, 0, 1); PG8_STAGE(PG8_SB(0, 0), b2, voffB);
            PG8_BAR; PG8_WAIT_L(0); PG8_MMA(0, 1, At, B1); PG8_BAR;
            PG8_LDA(At, 0, 1); PG8_STAGE(PG8_SA(0, 0), a2, voffA);
            PG8_BAR; PG8_WAIT_L(0); PG8_MMA(1, 0, At, B0); PG8_BAR; PG8_SCHED;
            PG8_STAGE(PG8_SB(0, 1), b2 + hstep, voffB);
            PG8_WAIT_V(6); PG8_BAR; PG8_MMA(1, 1, At, B1); PG8_BAR;
            PG8_LDB(B0, 1, 0); PG8_SCHED; PG8_LDA(At, 1, 0); PG8_STAGE(PG8_SA(0, 1), a2 + hstep, voffA);
            PG8_WAIT_L(8); PG8_BAR; PG8_WAIT_L(0); PG8_MMA(0, 0, At, B0); PG8_BAR; PG8_SCHED;
            PG8_LDB(B1, 1, 1); PG8_STAGE(PG8_SB(1, 0), b3, voffB);
            PG8_BAR; PG8_WAIT_L(0); PG8_MMA(0, 1, At, B1); PG8_BAR;
            PG8_LDA(At, 1, 1); PG8_STAGE(PG8_SA(1, 0), a3, voffA);
            PG8_BAR; PG8_WAIT_L(0); PG8_MMA(1, 0, At, B0); PG8_BAR; PG8_SCHED;
            PG8_STAGE(PG8_SB(1, 1), b3 + hstep, voffB);
            PG8_WAIT_V(6); PG8_BAR; PG8_MMA(1, 1, At, B1); PG8_BAR;
            }
        }
        if constexpr (ALIGN_EPI) { if (wr == 0) PG8_BAR; }
        if constexpr (!Epi::AFTER_DRAIN) { E(acc, cur, wr, wc, fr, fq); S.done(cur); }
        if (!has_next) break;
#pragma unroll
        for (int a = 0; a < 2; ++a)
#pragma unroll
            for (int b = 0; b < 2; ++b)
#pragma unroll
                for (int m = 0; m < 4; ++m)
#pragma unroll
                    for (int n = 0; n < 2; ++n) acc[a][b][m][n] = (f32x4){0.f, 0.f, 0.f, 0.f};
        cur = nxt; cA = nA; cB = nB; ++ui;
        if constexpr (ALIGN_EPI) { if (wr == 1) PG8_BAR; }
    }
    PG8_WAIT_V(0);
    if constexpr (!ALIGN_EPI) { if (wr == 0) PG8_BAR; }
    PG8_BAR;
    if constexpr (Epi::AFTER_DRAIN) { E.fused(acc, cur, wr, wc, fr, fq, lds, wid, lane); S.done(cur); }
#undef PG8_SA
#undef PG8_SB
#undef PG8_STAGE
#undef PG8_LDA
#undef PG8_LDB
#undef PG8_MMA
#undef PG8_WAIT_V
#undef PG8_WAIT_L
#undef PG8_BAR
#undef PG8_SCHED
}
}

#define DI __device__ __forceinline__
#define LAS __attribute__((address_space(3)))
typedef unsigned short bf16_t;
typedef short bf16x8 __attribute__((ext_vector_type(8)));
typedef short s16x4 __attribute__((ext_vector_type(4)));
typedef float f32x4 __attribute__((ext_vector_type(4)));
typedef float f32x16 __attribute__((ext_vector_type(16)));
typedef unsigned u32x4 __attribute__((ext_vector_type(4)));
typedef unsigned u32x2 __attribute__((ext_vector_type(2)));
typedef float f32x2_t __attribute__((ext_vector_type(2)));
typedef __bf16 bf16x2_t __attribute__((ext_vector_type(2)));
typedef short v4i16_t __attribute__((ext_vector_type(4)));
typedef int i32x4 __attribute__((ext_vector_type(4)));

constexpr int DM = 1024, NB = 8, SEQ = 8192, NMETA = 16, LP = 8208, SBN = 32, SSN = 32, PAST = 4096;
constexpr int RS0 = 65536, RM0 = 66560, RV = 66576, RT = 66816;
constexpr int DFF = 2816, DIN = 2216;
constexpr int NGRP = 2081;
constexpr float EPS = 1e-6f, LOG2E = 1.4426950408889634f;
constexpr float QS_FOX = 0.125f * LOG2E;
constexpr float QS_MLA = 0.10206207261596577f * LOG2E;
constexpr float NEGF = -1e30f;

constexpr size_t O_YP = 0, O_YS = O_YP + (size_t)NB * SEQ * DM, O_LATP = O_YS + (size_t)SBN * SSN * DM, O_KRP = O_LATP + (size_t)NB * LP * 256,
                 O_FKP = O_KRP + (size_t)NB * LP * 32, O_FVP = O_FKP + (size_t)NB * LP * 512, O_LFP = O_FVP + (size_t)NB * LP * 512,
                 O_LATS = O_LFP + (size_t)NB * LP * 8, O_KRS = O_LATS + (size_t)1024 * 256, O_FKS = O_KRS + (size_t)1024 * 32,
                 O_FVS = O_FKS + (size_t)1024 * 512, O_LFS = O_FVS + (size_t)1024 * 512, O_END = O_LFS + (size_t)1024 * 8;

constexpr size_t MiB = 1u << 20;
constexpr size_t WS_SS2 = 524288;
constexpr size_t WS_SS1 = 4096;
constexpr size_t WS_KINF = 0;
constexpr size_t WS_ROPE = 1 * MiB, WS_LC = 3 * MiB, WS_CLC = 6 * MiB, WS_TT = 10 * MiB, WS_CTT = 10 * MiB + 512 * 1024;
constexpr size_t WS_WIN = 11 * MiB, WS_WUQ = 16 * MiB, WS_WUKV = 17 * MiB, WS_WOUT = 18 * MiB, WS_WGU = 20 * MiB, WS_WDN = 31 * MiB;
constexpr size_t WS_XN = 37 * MiB;
constexpr size_t WS_CQN = WS_XN, WS_LATN = WS_XN + 50 * MiB, WS_MIXED = WS_XN;
constexpr size_t WS_PROJC = 168 * MiB;
constexpr size_t WS_QMLA = WS_PROJC;
constexpr size_t WS_KR = 266 * MiB;
constexpr size_t WS_CKR = 271 * MiB;
constexpr size_t WS_CLAT = 279 * MiB;
constexpr size_t WS_FQKV = 343 * MiB;
constexpr size_t WS_KVX = 539 * MiB;
constexpr size_t WS_KVXC = 670 * MiB;
constexpr size_t WS_XPART = 928 * MiB;
constexpr size_t WS_END = 972 * MiB;
constexpr size_t HM_BYTES = (size_t)RT * 512 * 2;
constexpr size_t WS_FQ = WS_FQKV, WS_FKH = WS_FQKV + HM_BYTES, WS_FVH = WS_FQKV + 2 * HM_BYTES;
constexpr size_t WS_KNH = WS_KVX, WS_VMH = WS_KVX + HM_BYTES;
constexpr size_t WS_KNC = WS_KVXC, WS_VMC = WS_KVXC + 128 * MiB;
static_assert(WS_FVH + HM_BYTES <= WS_KVX && WS_VMH + HM_BYTES <= WS_KVXC, "ws map");
constexpr size_t WS_HN = WS_FQKV;
constexpr size_t WS_ACT = WS_FQKV + 131 * MiB;
static_assert(WS_ACT + (size_t)RT * DFF * 2 <= WS_END, "ws map");
static_assert(WS_LATN + (size_t)RT * 256 * 2 <= WS_PROJC && WS_CQN + (size_t)RT * 384 * 2 <= WS_LATN, "ws map");

constexpr int LDS_BYTES = 147456;

struct Params { const float* in[21]; float* out; unsigned char* ws; int ph_lo, ph_hi; };

DI unsigned pk2(float lo, float hi) { f32x2_t v = {lo, hi}; bf16x2_t b = __builtin_convertvector(v, bf16x2_t); return __builtin_bit_cast(unsigned, b); }
DI float bf2f(unsigned short x) { return __uint_as_float((unsigned)x << 16); }
DI u32x4 pack8(f32x4 a, f32x4 b) { return (u32x4){pk2(a.x, a.y), pk2(a.z, a.w), pk2(b.x, b.y), pk2(b.z, b.w)}; }
DI float wave_sum(float v) {
#pragma unroll
    for (int o = 1; o < 64; o <<= 1) v += __shfl_xor(v, o);
    return v;
}
DI int row_pos(int row) { return row < RS0 ? NMETA + (row & 8191) : (row < RM0 ? PAST + ((row - RS0) & 31) : (row < RV ? row - RM0 : 0)); }
DI const float* x_of_row(const Params& p, int row) {
    return row < RS0 ? p.in[0] + (size_t)row * DM : (row < RM0 ? p.in[1] + (size_t)(row - RS0) * DM : (row < RV ? p.in[7] + (size_t)(row - RM0) * DM : nullptr));
}
DI void out_store8(float* outp, float* outs, int width, int row, int cc, f32x4 v0, f32x4 v1) {
    if (row < RS0) { const int b = row >> 13, t = row & 8191; float* d = outp + (size_t)(b * LP + NMETA + t) * width + cc; *(f32x4*)d = v0; *(f32x4*)(d + 4) = v1; }
    else if (row < RM0) { float* d = outs + (size_t)(row - RS0) * width + cc; *(f32x4*)d = v0; *(f32x4*)(d + 4) = v1; }
    else if (row < RV) { const int m = row - RM0;
#pragma unroll 1
        for (int b = 0; b < NB; ++b) { float* d = outp + (size_t)(b * LP + m) * width + cc; *(f32x4*)d = v0; *(f32x4*)(d + 4) = v1; } }
}

struct EpiG1 {
    static constexpr bool PERM = true, AFTER_DRAIN = false;
    bf16_t* projc; bf16_t* fqp; bf16_t* fkh; bf16_t* fvh; float* out; unsigned* kinf;
    DI void operator()(const f32x4 (&acc)[2][2][4][2], const pg8::Unit& u, int wr, int wc, int fr, int fq) const {
        const int pn = u.pn;
        float kmx[2] = {0.f, 0.f};
#pragma unroll
        for (int ai = 0; ai < 2; ++ai)
#pragma unroll
            for (int m = 0; m < 4; ++m) {
                const int row = u.pm * 256 + ai * 128 + wr * 64 + m * 16 + fr;
#pragma unroll
                for (int bj = 0; bj < 2; ++bj) {
                    const int col8 = bj * 128 + wc * 32 + 8 * fq;
                    f32x4 v0 = acc[ai][bj][m][0], v1 = acc[ai][bj][m][1];
                    if (pn < 3) { *(u32x4*)(projc + (size_t)row * 768 + pn * 256 + col8) = pack8(v0, v1); }
                    else {
                        const int c = (pn - 3) * 256 + col8;
                        if (pn < 5) *(u32x4*)(fqp + (size_t)row * 512 + c) = pack8(v0, v1);
                        else { char* base = (char*)((pn < 7 ? fkh : fvh) + (size_t)(((pn - 5) & 1) * 4 + bj * 2 + (wc >> 1)) * RT * 64);
                               *(u32x4*)(base + (unsigned)(row * 64 + (wc & 1) * 32 + 8 * fq) * 2u) = pack8(v0, v1); }
                        if (pn == 5 || pn == 6) {
                            float q2 = (v0.x * v0.x + v0.y * v0.y) + (v0.z * v0.z + v0.w * v0.w) + (v1.x * v1.x + v1.y * v1.y) + (v1.z * v1.z + v1.w * v1.w);
                            q2 += __shfl_xor(q2, 16); q2 += __shfl_xor(q2, 32);
                            kmx[bj] = fmaxf(kmx[bj], q2); }
                        if (pn >= 5) { const int which = (pn - 5) >> 1, cc = ((pn - 5) & 1) * 256 + col8;
                            out_store8(out + (which ? O_FVP : O_FKP), out + (which ? O_FVS : O_FKS), 512, row, cc, v0, v1); }
                    }
                }
            }
        if (pn == 5 || pn == 6) {
#pragma unroll
            for (int bj = 0; bj < 2; ++bj) { float m = kmx[bj];
#pragma unroll
                for (int o = 1; o < 64; o <<= 1) m = fmaxf(m, __shfl_xor(m, o));
                if ((fr | (fq << 4)) == 0) atomicMax(kinf + ((pn - 5) * 4 + bj * 2 + (wc >> 1)) * 2 + (wc & 1), __float_as_uint(m)); }
        }
    }
};
struct EpiBf16 {
    static constexpr bool PERM = true, AFTER_DRAIN = false;
    bf16_t* O; int ldc;
    DI void operator()(const f32x4 (&acc)[2][2][4][2], const pg8::Unit& u, int wr, int wc, int fr, int fq) const {
#pragma unroll
        for (int ai = 0; ai < 2; ++ai)
#pragma unroll
            for (int m = 0; m < 4; ++m) {
                const int row = u.pm * 256 + ai * 128 + wr * 64 + m * 16 + fr;
#pragma unroll
                for (int bj = 0; bj < 2; ++bj) {
                    const int col = u.pn * 256 + bj * 128 + wc * 32 + 8 * fq;
                    *(u32x4*)(O + (size_t)row * ldc + col) = pack8(acc[ai][bj][m][0], acc[ai][bj][m][1]);
                }
            }
    }
};
struct EpiKV {
    static constexpr bool PERM = true, AFTER_DRAIN = false;
    bf16_t* kn; bf16_t* vm; size_t nrows;
    DI void operator()(const f32x4 (&acc)[2][2][4][2], const pg8::Unit& u, int wr, int wc, int fr, int fq) const {
        const int d = (wc & 1) * 32 + 8 * fq;
#pragma unroll
        for (int bj = 0; bj < 2; ++bj) {
            char* base = (char*)(((wc >> 1) ? vm : kn) + (size_t)(u.pn * 2 + bj) * nrows * 64);
#pragma unroll
            for (int ai = 0; ai < 2; ++ai)
#pragma unroll
                for (int m = 0; m < 4; ++m) {
                    const int row = u.pm * 256 + ai * 128 + wr * 64 + m * 16 + fr;
                    *(u32x4*)(base + (unsigned)(row * 64 + d) * 2u) = pack8(acc[ai][bj][m][0], acc[ai][bj][m][1]);
                }
        }
    }
};
struct EpiQ {
    static constexpr bool PERM = false, AFTER_DRAIN = false;
    bf16_t* O; const float* rope;
    DI void operator()(const f32x4 (&acc)[2][2][4][2], const pg8::Unit& u, int wr, int wc, int fr, int fq) const {
#pragma unroll
        for (int bj = 0; bj < 2; ++bj) {
            const int g = u.pn * 8 + bj * 4 + wc;
            const bool is_rope = (g % 3) == 2;
#pragma unroll
            for (int ai = 0; ai < 2; ++ai)
#pragma unroll
                for (int m = 0; m < 4; ++m) {
                    const int row = u.pm * 256 + ai * 128 + wr * 64 + m * 16 + fr;
                    f32x4 a = acc[ai][bj][m][0], b = acc[ai][bj][m][1];
                    if (is_rope) {
                        const float* t = rope + (size_t)row_pos(row) * 32;
                        const f32x4 c = *(const f32x4*)(t + 4 * fq), s = *(const f32x4*)(t + 16 + 4 * fq);
                        const f32x4 o1 = a * c - b * s, o2 = b * c + a * s; a = o1; b = o2;
                    }
                    a = a * QS_MLA; b = b * QS_MLA;
                    bf16_t* d = O + (size_t)row * 768 + g * 32 + 4 * fq;
                    *(u32x2*)d = (u32x2){pk2(a.x, a.y), pk2(a.z, a.w)};
                    *(u32x2*)(d + 16) = (u32x2){pk2(b.x, b.y), pk2(b.z, b.w)};
                }
        }
    }
};
struct EpiRes {
    static constexpr bool PERM = true, AFTER_DRAIN = false;
    const float* xp; const float* xs; bf16_t* x1b; float* ss;
    DI void operator()(const f32x4 (&acc)[2][2][4][2], const pg8::Unit& u, int wr, int wc, int fr, int fq) const {
#pragma unroll
        for (int ai = 0; ai < 2; ++ai)
#pragma unroll
            for (int m = 0; m < 4; ++m) {
                const int row = u.pm * 256 + ai * 128 + wr * 64 + m * 16 + fr;
                float q = 0.f;
                if (row < RM0) {
                    const float* xr = row < RS0 ? xp + (size_t)row * DM : xs + (size_t)(row - RS0) * DM;
#pragma unroll
                    for (int bj = 0; bj < 2; ++bj) {
                        const int col = u.pn * 256 + bj * 128 + wc * 32 + 8 * fq;
                        const f32x4 y0 = *(const f32x4*)(xr + col) + acc[ai][bj][m][0], y1 = *(const f32x4*)(xr + col + 4) + acc[ai][bj][m][1];
                        q += (y0.x * y0.x + y0.y * y0.y) + (y0.z * y0.z + y0.w * y0.w) + (y1.x * y1.x + y1.y * y1.y) + (y1.z * y1.z + y1.w * y1.w);
                        *(u32x4*)(x1b + (size_t)row * DM + col) = pack8(y0, y1);
                    }
                }
                q += __shfl_xor(q, 16); q += __shfl_xor(q, 32);
                if (fq == 0 && row < RM0) atomicAdd(ss + row, q);
            }
    }
};
struct SplitOrder {
    int c;
    DI bool next(int i, pg8::Unit& u) const { if (i != 0 || c >= 176) return false; u.pm = 256 + c / 44; u.pn = (c / 11) & 3; u.ko = (c % 11) * 256; return true; }
    DI void a_ready(const pg8::Unit&) const {}
    DI void done(const pg8::Unit&) const {}
};
struct EpiPart {
    static constexpr bool PERM = true, AFTER_DRAIN = false;
    float* xp;
    DI void operator()(const f32x4 (&acc)[2][2][4][2], const pg8::Unit& u, int wr, int wc, int fr, int fq) const {
        float* base = xp + (size_t)(u.ko >> 8) * 1024 * 1024;
#pragma unroll
        for (int ai = 0; ai < 2; ++ai)
#pragma unroll
            for (int m = 0; m < 4; ++m) {
                const int rs = (u.pm - 256) * 256 + ai * 128 + wr * 64 + m * 16 + fr;
#pragma unroll
                for (int bj = 0; bj < 2; ++bj) {
                    float* d = base + (size_t)rs * 1024 + u.pn * 256 + bj * 128 + wc * 32 + 8 * fq;
                    *(f32x4*)d = acc[ai][bj][m][0]; *(f32x4*)(d + 4) = acc[ai][bj][m][1];
                }
            }
    }
};
struct EpiAcc {
    static constexpr bool PERM = true, AFTER_DRAIN = false;
    bf16_t* x1b; float* ss;
    DI void operator()(const f32x4 (&acc)[2][2][4][2], const pg8::Unit& u, int wr, int wc, int fr, int fq) const {
#pragma unroll
        for (int ai = 0; ai < 2; ++ai)
#pragma unroll
            for (int m = 0; m < 4; ++m) {
                const int row = u.pm * 256 + ai * 128 + wr * 64 + m * 16 + fr;
                float q = 0.f;
                if (row < RM0) {
#pragma unroll
                    for (int bj = 0; bj < 2; ++bj) {
                        const int col = u.pn * 256 + bj * 128 + wc * 32 + 8 * fq;
                        bf16_t* d = x1b + (size_t)row * DM + col;
                        const u32x4 w = *(const u32x4*)d;
                        const f32x4 y0 = (f32x4){__uint_as_float(w.x << 16), __uint_as_float(w.x & 0xffff0000u), __uint_as_float(w.y << 16), __uint_as_float(w.y & 0xffff0000u)} + acc[ai][bj][m][0];
                        const f32x4 y1 = (f32x4){__uint_as_float(w.z << 16), __uint_as_float(w.z & 0xffff0000u), __uint_as_float(w.w << 16), __uint_as_float(w.w & 0xffff0000u)} + acc[ai][bj][m][1];
                        q += (y0.x * y0.x + y0.y * y0.y) + (y0.z * y0.z + y0.w * y0.w) + (y1.x * y1.x + y1.y * y1.y) + (y1.z * y1.z + y1.w * y1.w);
                        *(u32x4*)d = pack8(y0, y1);
                    }
                }
                q += __shfl_xor(q, 16); q += __shfl_xor(q, 32);
                if (fq == 0 && row < RM0) atomicAdd(ss + row, q);
            }
    }
};
DI float silu_mul(float g, float u) { return g * u * __builtin_amdgcn_rcpf(1.0f + __builtin_amdgcn_exp2f(-g * LOG2E)); }
struct EpiSwiglu {
    static constexpr bool PERM = true, AFTER_DRAIN = false;
    bf16_t* O; const float* ss;
    DI void operator()(const f32x4 (&acc)[2][2][4][2], const pg8::Unit& u, int wr, int wc, int fr, int fq) const {
#pragma unroll
        for (int ai = 0; ai < 2; ++ai)
#pragma unroll
            for (int m = 0; m < 4; ++m) {
                const int row = u.pm * 256 + ai * 128 + wr * 64 + m * 16 + fr;
                const float rstd = 1.0f / sqrtf(ss[row] * (1.0f / DM) + EPS);
                const f32x4 g0 = acc[ai][0][m][0] * rstd, g1 = acc[ai][0][m][1] * rstd, u0 = acc[ai][1][m][0] * rstd, u1 = acc[ai][1][m][1] * rstd;
                f32x4 a0, a1;
#pragma unroll
                for (int i = 0; i < 4; ++i) { a0[i] = silu_mul(g0[i], u0[i]); a1[i] = silu_mul(g1[i], u1[i]); }
                *(u32x4*)(O + (size_t)row * DFF + u.pn * 128 + wc * 32 + 8 * fq) = pack8(a0, a1);
            }
    }
};

DI int wmap(int kind, int n) {
    if (kind == 0 || kind == 4) return n;
    if (kind == 1) return n < 384 ? 256 + n : (n < 640 ? n - 384 : (n < 672 ? n : (n < 2208 ? n + 96 : n - 1536)));
    if (kind == 2) return 256 * (n >> 7) + (n & 127);
    return 256 * (n >> 7) + 128 + (n & 127);
}
DI float wscale(int kind, int n) { return kind == 4 ? QS_MLA : ((kind == 1 && n >= 672 && n < 1184) ? QS_FOX : 1.0f); }
DI void p0_transpose_item(const float* W, int K, int N, bf16_t* WT, int kind, LAS float* scr, int item, int lane, const float* kscale = nullptr) {
    const int nblk = (N + 31) / 32, kb = item / nblk, nb = item % nblk, k0 = 64 * kb, n0 = 32 * nb;
    const int nl = n0 + (lane & 31);
    const float wsc = wscale(kind, nl);
#pragma unroll 8
    for (int i = 0; i < 32; ++i) { const int kk = 2 * i + (lane >> 5); scr[kk * 33 + (lane & 31)] = (nl < N) ? W[(size_t)(k0 + kk) * N + nl] * (kscale ? wsc * kscale[k0 + kk] : wsc) : 0.f; }
    asm volatile("s_waitcnt lgkmcnt(0)" ::: "memory");
    const int c = lane & 7;
#pragma unroll
    for (int j = 0; j < 4; ++j) { const int n = (lane >> 3) + 8 * j; const LAS float* s = scr + (8 * c) * 33 + n;
        u32x4 o; o.x = pk2(s[0 * 33], s[1 * 33]); o.y = pk2(s[2 * 33], s[3 * 33]); o.z = pk2(s[4 * 33], s[5 * 33]); o.w = pk2(s[6 * 33], s[7 * 33]);
        if (n0 + n < N) *(u32x4*)(WT + (size_t)wmap(kind, n0 + n) * K + k0 + 8 * c) = o; }
    asm volatile("s_waitcnt lgkmcnt(0)" ::: "memory");
}
DI void norm_row_to_bf16(const float* xrow, const float* g, bf16_t* orow, int lane) {
    f32x4 v[4]; float s = 0.f;
#pragma unroll
    for (int j = 0; j < 4; ++j) { v[j] = ((const f32x4*)xrow)[lane + 64 * j]; s += (v[j].x * v[j].x + v[j].y * v[j].y) + (v[j].z * v[j].z + v[j].w * v[j].w); }
    const float rstd = 1.0f / sqrtf(wave_sum(s) * (1.0f / DM) + EPS);
#pragma unroll
    for (int j = 0; j < 4; ++j) { const f32x4 gg = ((const f32x4*)g)[lane + 64 * j]; const f32x4 y = v[j] * rstd * gg;
        ((u32x2*)orow)[lane + 64 * j] = (u32x2){pk2(y.x, y.y), pk2(y.z, y.w)}; }
}
DI void norm_rows2_to_bf16(const float* x0, const float* x1, const float* g, bf16_t* o0, bf16_t* o1, int lane) {
    f32x4 v[4], w[4]; float s = 0.f, t = 0.f;
#pragma unroll
    for (int j = 0; j < 4; ++j) { v[j] = ((const f32x4*)x0)[lane + 64 * j]; w[j] = ((const f32x4*)x1)[lane + 64 * j]; }
#pragma unroll
    for (int j = 0; j < 4; ++j) { s += (v[j].x * v[j].x + v[j].y * v[j].y) + (v[j].z * v[j].z + v[j].w * v[j].w); t += (w[j].x * w[j].x + w[j].y * w[j].y) + (w[j].z * w[j].z + w[j].w * w[j].w); }
#pragma unroll
    for (int o = 1; o < 64; o <<= 1) { s += __shfl_xor(s, o); t += __shfl_xor(t, o); }
    const float rs = 1.0f / sqrtf(s * (1.0f / DM) + EPS), rt = 1.0f / sqrtf(t * (1.0f / DM) + EPS);
#pragma unroll
    for (int j = 0; j < 4; ++j) { const f32x4 gg = ((const f32x4*)g)[lane + 64 * j]; const f32x4 y = v[j] * rs * gg, z = w[j] * rt * gg;
        ((u32x2*)o0)[lane + 64 * j] = (u32x2){pk2(y.x, y.y), pk2(y.z, y.w)}; ((u32x2*)o1)[lane + 64 * j] = (u32x2){pk2(z.x, z.y), pk2(z.z, z.w)}; }
}
DI void rope_entry(float* tab, int idx) {
    const int pos = idx >> 4, i = idx & 15;
    double inv = 1.0; for (int k = 0; k < i; ++k) inv *= 0.5623413251903491;
    const double ang = (double)pos * inv;
    const double k2 = __builtin_rint(ang * 0.15915494309189535);
    double r = __builtin_fma(-k2, 6.283185307179586, ang); r = __builtin_fma(-k2, 2.4492935982947064e-16, r);
    const double q = __builtin_rint(r * 0.6366197723675814);
    const double y = __builtin_fma(-q, 1.5707963267948966, r), y2 = y * y;
    double sp = 1.0 / 6227020800.0; sp = sp * y2 - 1.0 / 39916800.0; sp = sp * y2 + 1.0 / 362880.0; sp = sp * y2 - 1.0 / 5040.0; sp = sp * y2 + 1.0 / 120.0; sp = sp * y2 - 1.0 / 6.0; sp = sp * y2 + 1.0;
    const double sn = sp * y;
    double cp = -1.0 / 87178291200.0; cp = cp * y2 + 1.0 / 479001600.0; cp = cp * y2 - 1.0 / 3628800.0; cp = cp * y2 + 1.0 / 40320.0; cp = cp * y2 - 1.0 / 720.0; cp = cp * y2 + 1.0 / 24.0; cp = cp * y2 - 0.5; cp = cp * y2 + 1.0;
    const int qi = ((int)q) & 3;
    const double s = (qi == 0) ? sn : (qi == 1) ? cp : (qi == 2) ? -sn : -cp;
    const double c = (qi == 0) ? cp : (qi == 1) ? -sn : (qi == 2) ? -cp : sn;
    tab[pos * 32 + i] = (float)c; tab[pos * 32 + 16 + i] = (float)s;
}
DI void cache_cum_group(const float* lf, float* clc, float* ctt, int g, int lane) {
    f32x4 v = ((const f32x4*)(lf + (size_t)g * 256))[lane];
#pragma unroll
    for (int off = 2; off < 64; off <<= 1) {
        f32x4 t; t.x = __shfl_up(v.x, off); t.y = __shfl_up(v.y, off); t.z = __shfl_up(v.z, off); t.w = __shfl_up(v.w, off);
        if (lane >= off) v = v + t;
    }
    ((f32x4*)(clc + (size_t)g * 256))[lane] = v;
    if (lane >= 62) *(f32x4*)(ctt + (size_t)g * 8 + 4 * (lane & 1)) = v;
}
DI float log_sigmoid(float z) { return fminf(z, 0.f) - log1pf(expf(-fabsf(z))); }

DI void p2_group(const Params& p, int gi, int lane) {
    unsigned char* ws = p.ws;
    const bf16_t* projc = (const bf16_t*)(ws + WS_PROJC);
    bf16_t* cqn = (bf16_t*)(ws + WS_CQN); bf16_t* latn = (bf16_t*)(ws + WS_LATN); bf16_t* krb = (bf16_t*)(ws + WS_KR);
    const float* rope = (const float*)(ws + WS_ROPE); float* LC = (float*)(ws + WS_LC); float* TT = (float*)(ws + WS_TT);
    const float* qn = p.in[11]; const float* kvn = p.in[13]; const float* bfg = p.in[10];
    const int row0 = gi * 32, nrows = (gi == NGRP - 1) ? 16 : 32;
    f32x4 g0a, g0b, g1a, g1b;
    if (lane < 32) { g0a = *(const f32x4*)(kvn + 8 * lane); g0b = *(const f32x4*)(kvn + 8 * lane + 4); }
    else { g0a = *(const f32x4*)(qn + 8 * (lane - 32)); g0b = *(const f32x4*)(qn + 8 * (lane - 32) + 4); }
    if (lane < 16) { g1a = *(const f32x4*)(qn + 256 + 8 * lane); g1b = *(const f32x4*)(qn + 256 + 8 * lane + 4); } else { g1a = (f32x4){0, 0, 0, 0}; g1b = g1a; }
    const float bfl = bfg[lane & 7];
    float run1 = 0.f;
#pragma unroll 1
    for (int rr0 = 0; rr0 < nrows; rr0 += 4) {
      u32x4 w0s[4], w1s[4];
#pragma unroll
      for (int k = 0; k < 4; ++k) { const bf16_t* pr = projc + (size_t)(row0 + rr0 + k) * 768;
          w0s[k] = *(const u32x4*)(pr + 8 * lane); w1s[k] = (u32x4){0, 0, 0, 0}; if (lane < 32) w1s[k] = *(const u32x4*)(pr + 512 + 8 * lane); }
#pragma unroll
      for (int k = 0; k < 4; ++k) {
        const int row = row0 + rr0 + k;
        const u32x4 w0 = w0s[k], w1 = w1s[k];
        float a[8], b[8];
#pragma unroll
        for (int i = 0; i < 4; ++i) { a[2 * i] = __uint_as_float(w0[i] << 16); a[2 * i + 1] = __uint_as_float(w0[i] & 0xffff0000u);
                                      b[2 * i] = __uint_as_float(w1[i] << 16); b[2 * i + 1] = __uint_as_float(w1[i] & 0xffff0000u); }
        float sa = 0.f, sb = 0.f;
#pragma unroll
        for (int i = 0; i < 8; ++i) { sa += a[i] * a[i]; sb += b[i] * b[i]; }
        float skv = (lane < 32) ? sa : 0.f, sq = ((lane >= 32) ? sa : 0.f) + ((lane < 16) ? sb : 0.f);
        skv = wave_sum(skv); sq = wave_sum(sq);
        const float rkv = 1.0f / sqrtf(skv * (1.0f / 256.0f) + EPS), rq = 1.0f / sqrtf(sq * (1.0f / 384.0f) + EPS);
        const float r0 = (lane < 32) ? rkv : rq;
        f32x4 y0 = (f32x4){a[0], a[1], a[2], a[3]} * r0 * g0a, y1 = (f32x4){a[4], a[5], a[6], a[7]} * r0 * g0b;
        if (lane < 32) { *(u32x4*)(latn + (size_t)row * 256 + 8 * lane) = pack8(y0, y1);
            out_store8(p.out + O_LATP, p.out + O_LATS, 256, row, 8 * lane, y0, y1); }
        else { *(u32x4*)(cqn + (size_t)row * 384 + 8 * (lane - 32)) = pack8(y0, y1); }
        if (lane < 16) { f32x4 z0 = (f32x4){b[0], b[1], b[2], b[3]} * rq * g1a, z1 = (f32x4){b[4], b[5], b[6], b[7]} * rq * g1b;
            *(u32x4*)(cqn + (size_t)row * 384 + 256 + 8 * lane) = pack8(z0, z1); }
        float ob[8];
#pragma unroll
        for (int i = 0; i < 8; ++i) ob[i] = __shfl_xor(b[i], 2);
        if (lane >= 16 && lane < 20) {
            const int pos = row_pos(row); const bool first = lane < 18; const int j0 = 8 * (lane - (first ? 16 : 18));
            const float* t = rope + (size_t)pos * 32 + j0;
            const f32x4 c0 = *(const f32x4*)t, c1 = *(const f32x4*)(t + 4), s0 = *(const f32x4*)(t + 16), s1 = *(const f32x4*)(t + 20);
            float cc[8] = {c0.x, c0.y, c0.z, c0.w, c1.x, c1.y, c1.z, c1.w}, ss[8] = {s0.x, s0.y, s0.z, s0.w, s1.x, s1.y, s1.z, s1.w};
            float o[8];
#pragma unroll
            for (int i = 0; i < 8; ++i) o[i] = first ? (b[i] * cc[i] - ob[i] * ss[i]) : (b[i] * cc[i] + ob[i] * ss[i]);
            const f32x4 o0 = (f32x4){o[0], o[1], o[2], o[3]}, o1 = (f32x4){o[4], o[5], o[6], o[7]};
            *(u32x4*)(krb + (size_t)row * 32 + 8 * (lane - 16)) = pack8(o0, o1);
            out_store8(p.out + O_KRP, p.out + O_KRS, 32, row, 8 * (lane - 16), o0, o1);
        }
        {
            float z = 0.f;
#pragma unroll
            for (int i = 0; i < 8; ++i) { const float t = __shfl(b[i], 20); if ((lane & 7) == i) z = t; }
            const float lf = log_sigmoid(z + bfl);
            run1 += lf;
            if (lane < 8) {
                LC[(size_t)row * 8 + lane] = run1;
                if (row < RS0) { const int bb = row >> 13, t = row & 8191; p.out[O_LFP + (size_t)(bb * LP + NMETA + t) * 8 + lane] = lf; }
                else if (row < RM0) { p.out[O_LFS + (size_t)(row - RS0) * 8 + lane] = lf; }
                else { const int m = row - RM0;
#pragma unroll 1
                    for (int bb = 0; bb < NB; ++bb) p.out[O_LFP + (size_t)(bb * LP + m) * 8 + lane] = lf; }
            }
        }
      }
    }
    if (lane < 8) TT[(size_t)gi * 8 + lane] = run1;
}

template <int DK> struct ACfg { static constexpr int NK = (DK == 64) ? 5 : 6, KP = (DK == 64) ? 176 : 208; };
constexpr int VP = 192;
constexpr float THR = 8.0f;
#define MFMA32(a, b, c) __builtin_amdgcn_mfma_f32_32x32x16_bf16((a), (b), (c), 0, 0, 0)
DI int crow(int r, int hi) { return (r & 3) + 8 * (r >> 2) + 4 * hi; }
DI s16x4 vtr(const LAS unsigned char* p) { return __builtin_bit_cast(s16x4, __builtin_amdgcn_ds_read_tr16_b64_v4i16((LAS v4i16_t*)p)); }
DI float bf16_round(float x) { return __uint_as_float(pk2(x, 0.f) << 16); }
DI u32x4 bias_chunk(float bv) {
    const unsigned h = pk2(bv, 0.f) & 0xffffu; const float r1 = bv - __uint_as_float(h << 16);
    const unsigned m = pk2(r1, 0.f) & 0xffffu; const float r2 = r1 - __uint_as_float(m << 16);
    const unsigned l = pk2(r2, 0.f) & 0xffffu;
    return (u32x4){0x3F80u | (h << 16), m | (l << 16), 0u, 0u};
}
DI void rope_qfrag(bf16x8& x1, bf16x8& x2, const float* t) {
    const f32x4 c0 = *(const f32x4*)t, c1 = *(const f32x4*)(t + 4), s0 = *(const f32x4*)(t + 16), s1 = *(const f32x4*)(t + 20);
    const float cc[8] = {c0.x, c0.y, c0.z, c0.w, c1.x, c1.y, c1.z, c1.w}, ss[8] = {s0.x, s0.y, s0.z, s0.w, s1.x, s1.y, s1.z, s1.w};
    float o1[8], o2[8];
#pragma unroll
    for (int i = 0; i < 8; ++i) { const float a = bf2f((unsigned short)x1[i]), b = bf2f((unsigned short)x2[i]); o1[i] = a * cc[i] - b * ss[i]; o2[i] = b * cc[i] + a * ss[i]; }
    const u32x4 w1 = (u32x4){pk2(o1[0], o1[1]), pk2(o1[2], o1[3]), pk2(o1[4], o1[5]), pk2(o1[6], o1[7])};
    const u32x4 w2 = (u32x4){pk2(o2[0], o2[1]), pk2(o2[2], o2[3]), pk2(o2[4], o2[5]), pk2(o2[6], o2[7])};
    x1 = __builtin_bit_cast(bf16x8, w1); x2 = __builtin_bit_cast(bf16x8, w2);
}
template <int DK, bool FOX>
DI void load_qfrags(const Params& p, int qrow0  , int r32, int h, int hi, bf16x8 (&qf)[DK / 16 + 1]) {
    unsigned char* ws = p.ws;
    const char* qb_ = FOX ? (const char*)((const bf16_t*)(ws + WS_FQ) + (size_t)qrow0 * 512 + h * 64) : (const char*)((const bf16_t*)(ws + WS_QMLA) + (size_t)qrow0 * 768 + h * 96);
    const unsigned qo = (unsigned)(r32 * (FOX ? 512 : 768) + 8 * hi) * 2u;
#pragma unroll
    for (int d0 = 0; d0 < DK / 16; ++d0) qf[d0] = *(const bf16x8*)(qb_ + qo + 32 * d0);
    if (!FOX) { const char* rt_ = (const char*)((const float*)(ws + WS_ROPE) + (size_t)row_pos(qrow0) * 32); rope_qfrag(qf[DK / 16 - 2], qf[DK / 16 - 1], (const float*)(rt_ + (unsigned)(r32 * 32 + 8 * hi) * 4u)); }
    const u32x4 ex = hi == 0 ? (u32x4){0x3F800000u, 0x3F803F80u, 0u, 0u} : (u32x4){0u, 0u, 0u, 0u};
    qf[DK / 16] = __builtin_bit_cast(bf16x8, ex);
}
template <int DK, int NKB>
DI void attn_qk(const LAS unsigned char* Kb, const bf16x8 (&qf)[DK / 16 + 1], f32x16 (&s)[NKB], int lane, const f32x16& negm) {
    constexpr int NK = ACfg<DK>::NK, KP = ACfg<DK>::KP;
    const LAS unsigned char* kp = Kb + (lane & 31) * KP + (lane >> 5) * 16;
    f32x16 z;
#pragma unroll
    for (int r = 0; r < 16; ++r) z[r] = (DK == 64) ? 0.f : negm[r];
#pragma unroll
    for (int d0 = 0; d0 < NK; ++d0)
#pragma unroll
        for (int blk = 0; blk < NKB; ++blk) {
            const bf16x8 kf = *(const LAS bf16x8*)(kp + blk * 32 * KP + d0 * 32);
            s[blk] = MFMA32(kf, qf[d0], d0 == 0 ? z : s[blk]);
        }
}
template <int NKB, bool CINIT>
DI void attn_sm_a(f32x16 (&s)[NKB], f32x16 (&o)[2], float& rref, float& l, bf16x8& qfx, bool first, int maskmode, int mparam, int lane, float& rmin, f32x16& negm) {
    const int r32 = lane & 31, hi = lane >> 5;
    if (CINIT && maskmode == 1) {
#pragma unroll
        for (int blk = 0; blk < NKB; ++blk)
#pragma unroll
            for (int r = 0; r < 16; ++r) if (blk * 32 + crow(r, hi) < 48) s[blk][r] = NEGF;
    }
    if (maskmode == 2) {
        const int lim = mparam + r32;
#pragma unroll
        for (int blk = 0; blk < NKB; ++blk)
#pragma unroll
            for (int r = 0; r < 16; ++r) if (blk * 32 + crow(r, hi) > lim) s[blk][r] = NEGF;
    }
    float mx = s[0][0];
#pragma unroll
    for (int blk = 0; blk < NKB; ++blk)
#pragma unroll
        for (int r = 0; r < 16; ++r) mx = fmaxf(mx, s[blk][r]);
    mx = fmaxf(mx, __shfl_xor(mx, 32));
    const bool need = first || (mx > THR);
    if (__any(need)) {
        const float rn = need ? bf16_round(rref + mx) : rref;
        const float d = rn - rref; rref = rn;
#pragma unroll
        for (int blk = 0; blk < NKB; ++blk)
#pragma unroll
            for (int r = 0; r < 16; ++r) s[blk][r] -= d;
        const float f = __builtin_amdgcn_exp2f(-d);
        l *= f;
#pragma unroll
        for (int dd = 0; dd < 2; ++dd)
#pragma unroll
            for (int r = 0; r < 16; ++r) o[dd][r] *= f;
        if (CINIT) {
#pragma unroll
            for (int r = 0; r < 16; ++r) negm[r] = -rref;
        } else if (hi == 0) qfx[0] = (short)(pk2(-rref, 0.f) & 0xffffu);
        float mn = rref;
#pragma unroll
        for (int off = 1; off < 64; off <<= 1) mn = fminf(mn, __shfl_xor(mn, off));
        rmin = mn;
    }
}
template <int NKB>
DI void attn_sm_b(f32x16 (&s)[NKB], float& l, bf16x8 (&pf)[NKB][2]) {
    float ls = 0.f;
#pragma unroll
    for (int blk = 0; blk < NKB; ++blk)
#pragma unroll
        for (int r = 0; r < 16; ++r) { s[blk][r] = __builtin_amdgcn_exp2f(s[blk][r]); ls += s[blk][r]; }
    l += ls;
#pragma unroll
    for (int blk = 0; blk < NKB; ++blk)
#pragma unroll
        for (int s2 = 0; s2 < 2; ++s2) {
            const u32x4 w = (u32x4){pk2(s[blk][8 * s2 + 0], s[blk][8 * s2 + 1]), pk2(s[blk][8 * s2 + 2], s[blk][8 * s2 + 3]),
                                    pk2(s[blk][8 * s2 + 4], s[blk][8 * s2 + 5]), pk2(s[blk][8 * s2 + 6], s[blk][8 * s2 + 7])};
            pf[blk][s2] = __builtin_bit_cast(bf16x8, w);
        }
}
template <int NKB>
DI void attn_pv(const LAS unsigned char* Vb, const bf16x8 (&pf)[NKB][2], f32x16 (&o)[2], int lane) {
    const int hi = lane >> 5, q4 = (lane & 15) >> 2, p4 = lane & 3, gb = (lane >> 4) & 1;
    const LAS unsigned char* vp = Vb + (4 * hi + q4) * VP + 32 * gb + 8 * p4;
#pragma unroll
    for (int blk = 0; blk < NKB; ++blk)
#pragma unroll
        for (int s2 = 0; s2 < 2; ++s2)
#pragma unroll
            for (int d = 0; d < 2; ++d) {
                const LAS unsigned char* a = vp + (blk * 32 + 16 * s2) * VP + d * 64;
                const s16x4 lo = vtr(a), hi4 = vtr(a + 8 * VP);
                const bf16x8 vf = __builtin_shufflevector(lo, hi4, 0, 1, 2, 3, 4, 5, 6, 7);
                o[d] = MFMA32(vf, pf[blk][s2], o[d]);
            }
}
template <int NKB>
DI void attn_sm_pv(f32x16 (&s)[NKB], float& l, const LAS unsigned char* Vb, f32x16 (&o)[2], int lane) {
    const int hi = lane >> 5, q4 = (lane & 15) >> 2, p4 = lane & 3, gb = (lane >> 4) & 1;
    const LAS unsigned char* vp = Vb + (4 * hi + q4) * VP + 32 * gb + 8 * p4;
    float ls0 = 0.f, ls1 = 0.f;
#pragma unroll
    for (int blk = 0; blk < NKB; ++blk) {
#pragma unroll
        for (int r = 0; r < 16; r += 2) { s[blk][r] = __builtin_amdgcn_exp2f(s[blk][r]); s[blk][r + 1] = __builtin_amdgcn_exp2f(s[blk][r + 1]); ls0 += s[blk][r]; ls1 += s[blk][r + 1]; }
#pragma unroll
        for (int s2 = 0; s2 < 2; ++s2) {
            const u32x4 w = (u32x4){pk2(s[blk][8 * s2 + 0], s[blk][8 * s2 + 1]), pk2(s[blk][8 * s2 + 2], s[blk][8 * s2 + 3]),
                                    pk2(s[blk][8 * s2 + 4], s[blk][8 * s2 + 5]), pk2(s[blk][8 * s2 + 6], s[blk][8 * s2 + 7])};
            const bf16x8 pfr = __builtin_bit_cast(bf16x8, w);
#pragma unroll
            for (int d = 0; d < 2; ++d) {
                const LAS unsigned char* a = vp + (blk * 32 + 16 * s2) * VP + d * 64;
                const s16x4 lo = vtr(a), hi4 = vtr(a + 8 * VP);
                const bf16x8 vf = __builtin_shufflevector(lo, hi4, 0, 1, 2, 3, 4, 5, 6, 7);
                o[d] = MFMA32(vf, pfr, o[d]);
            }
        }
    }
    l += ls0 + ls1;
}
DI void attn_store_o(bf16_t* orow, const f32x16 (&o)[2], float l, int hi) {
    l = l + __shfl_xor(l, 32);
    const float inv = 1.0f / l;
#pragma unroll
    for (int d = 0; d < 2; ++d)
#pragma unroll
        for (int g = 0; g < 4; ++g)
            *(u32x2*)(orow + d * 32 + 8 * g + 4 * hi) = (u32x2){pk2(o[d][4 * g] * inv, o[d][4 * g + 1] * inv), pk2(o[d][4 * g + 2] * inv, o[d][4 * g + 3] * inv)};
}

constexpr int A_K0 = 0, A_KSZ = 2 * 15360, A_V0 = 2 * A_KSZ, A_VSZ = 2 * 64 * VP, A_TP = A_V0 + 2 * A_VSZ, A_CBN = A_TP + 1024, A_FLG = A_CBN + 64;
template <bool FOX>
DI void attn_prompt_unit(const Params& p, LAS unsigned char* lds, int b, int h, int qb) {
    constexpr int DK = FOX ? 64 : 96, CPR = DK / 8, NK = ACfg<DK>::NK, KP = ACfg<DK>::KP;
    unsigned char* ws = p.ws;
    int tid_o = threadIdx.x; asm volatile("" : "+v"(tid_o));
    const int tid = tid_o, lane = tid & 63, wid = __builtin_amdgcn_readfirstlane(tid >> 6), r32 = lane & 31, hi = lane >> 5;
    const bf16_t* kh = (const bf16_t*)(ws + (FOX ? WS_FKH : WS_KNH)) + (size_t)h * RT * 64; const bf16_t* vh = (const bf16_t*)(ws + (FOX ? WS_FVH : WS_VMH)) + (size_t)h * RT * 64;
    const bf16_t* krb = (const bf16_t*)(ws + WS_KR); const float* LC = (const float*)(ws + WS_LC); const float* TT = (const float*)(ws + WS_TT);
    bf16_t* mixed = (bf16_t*)(ws + WS_MIXED);
    LAS float* TPs = (LAS float*)(lds + A_TP);
    __syncthreads();
    if (FOX && wid == 0) {
        float t[4];
#pragma unroll
        for (int i = 0; i < 4; ++i) t[i] = TT[(size_t)(b * 256 + 4 * lane + i) * 8 + h];
        float e[4]; e[0] = 0.f; e[1] = t[0]; e[2] = t[0] + t[1]; e[3] = e[2] + t[2]; const float tot = e[3] + t[3];
        float inc = tot;
#pragma unroll
        for (int off = 1; off < 64; off <<= 1) { const float v = __shfl_up(inc, off); if (lane >= off) inc += v; }
        const float ex = inc - tot;
#pragma unroll
        for (int i = 0; i < 4; ++i) TPs[4 * lane + i] = ex + e[i];
    }
    __syncthreads();
    const float ref = FOX ? TPs[8 * qb] : 0.f;
    const float tpmeta = FOX ? -TT[(size_t)(NGRP - 1) * 8 + h] : 0.f;
    const int qrow = b * SEQ + 256 * qb + 32 * wid + r32;
    bf16x8 qf[DK / 16 + 1];
    load_qfrags<DK, FOX>(p, b * SEQ + 256 * qb + 32 * wid, r32, h, hi, qf);
    f32x16 o[2];
#pragma unroll
    for (int r = 0; r < 16; ++r) { o[0][r] = 0.f; o[1][r] = 0.f; }
    float rref = 0.f, l = 0.f, rmin = 0.f, qkb = 0.f;
    f32x16 negm;
#pragma unroll
    for (int r = 0; r < 16; ++r) negm[r] = 0.f;
    if (FOX) {
        float a = 0.f, c = 0.f;
#pragma unroll
        for (int i = 0; i < 8; ++i) { const float x0 = bf2f((unsigned short)qf[0][i]), x1 = bf2f((unsigned short)qf[1][i]), x2 = bf2f((unsigned short)qf[2][i]), x3 = bf2f((unsigned short)qf[3][i]);
            a += x0 * x0 + x1 * x1; c += x2 * x2 + x3 * x3; }
        a += __shfl_xor(a, 32); c += __shfl_xor(c, 32);
#pragma unroll
        for (int off = 1; off < 32; off <<= 1) { a = fmaxf(a, __shfl_xor(a, off)); c = fmaxf(c, __shfl_xor(c, off)); }
        const unsigned* kn2 = (const unsigned*)(ws + WS_KINF) + 2 * h;
        qkb = 1.02f * (sqrtf(a * __uint_as_float(kn2[0])) + sqrtf(c * __uint_as_float(kn2[1])));
    }
    LAS float* CBN = (LAS float*)(lds + A_CBN); LAS int* FLG = (LAS int*)(lds + A_FLG);
    bool done = false;
    const int ktmax = 4 * qb + 3, mykt = 4 * qb + (wid >> 1);
    const int vj = tid >> 3, vp = tid & 7, rj = tid >> 2, rp = tid & 3;
    u32x4 rk0_0, rk0_1, rk1_0 = (u32x4){0, 0, 0, 0}, rk1_1 = (u32x4){0, 0, 0, 0}, rv_0, rv_1; float rb_0 = 0.f, rb_1 = 0.f;
#define TROW0(kt) ((kt) < 0 ? RM0 : b * SEQ + 64 * (kt))
#define JOFF(kt, j) ((kt) < 0 ? ((j) >= 48 ? (j) - 48 : 0) : (j))
#define LOADKV(kt, U) do { const int r0_ = TROW0(kt); \
        { const unsigned of_ = (unsigned)(JOFF(kt, vj) * 64 + vp * 8) * 2u; \
          rk0_##U = *(const u32x4*)((const char*)(kh + (size_t)r0_ * 64) + of_); rv_##U = *(const u32x4*)((const char*)(vh + (size_t)r0_ * 64) + of_); } \
        if (!FOX) { \
               if (tid < 256) { const char* rb_ = (const char*)(krb + (size_t)r0_ * 32); rk1_##U = *(const u32x4*)(rb_ + (unsigned)(JOFF(kt, rj) * 32 + rp * 8) * 2u); } } \
        if (tid < 64) { rb_##U = 0.f; \
          if (FOX) { const float tp = (kt) < 0 ? tpmeta : TPs[2 * (kt) + (tid >> 5)]; rb_##U = -(*(const float*)((const char*)(LC + (size_t)r0_ * 8 + h) + (unsigned)JOFF(kt, tid) * 32u) + tp - ref) * LOG2E; } \
          if ((kt) < 0 && tid < 48) rb_##U = NEGF; } \
    } while (0)
#define STOREKV(slot, U) do { LAS unsigned char* B_ = lds + A_K0 + (slot) * A_KSZ + (U) * 64 * KP; \
        *(LAS u32x4*)(B_ + vj * KP + vp * 16) = rk0_##U; \
        if (!FOX && tid < 256) *(LAS u32x4*)(B_ + rj * KP + (8 + rp) * 16) = rk1_##U; \
        if (FOX && tid < 64) { *(LAS u32x4*)(B_ + tid * KP + DK * 2) = bias_chunk(rb_##U); *(LAS u32x4*)(B_ + tid * KP + DK * 2 + 16) = (u32x4){0u, 0u, 0u, 0u}; } \
        *(LAS u32x4*)(lds + A_V0 + (slot) * A_VSZ + (U) * 64 * VP + vj * VP + vp * 16) = rv_##U; \
        if (FOX && tid == 63) CBN[(slot) * 2 + (U)] = rb_##U; \
    } while (0)
#define COMPUTE(kt, slot, U) do { \
        if (FOX && !first && !done && CBN[(slot) * 2 + (U)] + qkb - rmin < -130.0f) done = true;     \
        if ((kt) <= mykt && !done) { \
            const int mm = (FOX && (kt) == mykt) ? 2 : ((!FOX && (kt) < 0) ? 1 : 0); \
            attn_qk<DK, 2>(lds + A_K0 + (slot) * A_KSZ + (U) * 64 * KP, qf, sA, lane, negm); \
            attn_sm_a<2, !FOX>(sA, o, rref, l, qf[DK / 16], first, mm, 32 * (wid & 1), lane, rmin, negm); \
            first = false; \
            attn_sm_pv<2>(sA, l, lds + A_V0 + (slot) * A_VSZ + (U) * 64 * VP, o, lane); } } while (0)
    const int Smax = 2 * qb + 1;
    LOADKV(2 * Smax + 1, 0); LOADKV(2 * Smax, 1); STOREKV(Smax & 1, 0); STOREKV(Smax & 1, 1);
    __syncthreads();
    f32x16 sA[2];
    bool first = true;
    if (wid >= 4) __builtin_amdgcn_s_setprio(1);
#pragma unroll 1
    for (int S = Smax; S >= -1; --S) {
        const int slot = S & 1;
        if (S >= 1) { LOADKV(2 * S - 1, 0); LOADKV(2 * S - 2, 1); } else if (S == 0) { LOADKV(-1, 0); }
        if (S >= 0) { COMPUTE(2 * S + 1, slot, 0); COMPUTE(2 * S, slot, 1); } else { COMPUTE(-1, slot, 0); }
        if (S >= 1) { STOREKV(slot ^ 1, 0); STOREKV(slot ^ 1, 1); } else if (S == 0) { STOREKV(slot ^ 1, 0); }
        if (FOX && lane == 0) FLG[slot * 8 + wid] = done ? 1 : 0;
        __syncthreads();
        if (FOX) { const i32x4 f0 = *(const LAS i32x4*)(FLG + slot * 8), f1 = *(const LAS i32x4*)(FLG + slot * 8 + 4);
            if ((f0.x & f0.y & f0.z & f0.w & f1.x & f1.y & f1.z & f1.w) != 0) break; }
    }
    __builtin_amdgcn_s_setprio(0);
#undef LOADKV
#undef STOREKV
#undef COMPUTE
#undef TROW0
#undef JOFF
    attn_store_o(mixed + (size_t)qrow * 1024 + (FOX ? 512 : 0) + h * 64, o, l, hi);
}

constexpr int SWB = 14336, S_V = 7680, S_TP = S_V + 32 * VP;
constexpr int M_O = 0, M_ML = 65536;
template <bool FOX>
DI void attn_sample_unit(const Params& p, LAS unsigned char* lds0, int sb, int h) {
    constexpr int DK = FOX ? 64 : 96, CPR = DK / 8, NK = ACfg<DK>::NK, KP = ACfg<DK>::KP, NKC = 32 * CPR / 64;
    unsigned char* ws = p.ws;
    int tid_o = threadIdx.x; asm volatile("" : "+v"(tid_o));
    const int tid = tid_o, lane = tid & 63, wid = __builtin_amdgcn_readfirstlane(tid >> 6), r32 = lane & 31, hi = lane >> 5;
    LAS unsigned char* lds = lds0 + wid * SWB;
    const bf16_t* kh = (const bf16_t*)(ws + (FOX ? WS_FKH : WS_KNH)) + (size_t)h * RT * 64; const bf16_t* vh = (const bf16_t*)(ws + (FOX ? WS_FVH : WS_VMH)) + (size_t)h * RT * 64;
    const bf16_t* knc = (const bf16_t*)(ws + WS_KNC) + (size_t)h * 131072 * 64; const bf16_t* vmc = (const bf16_t*)(ws + WS_VMC) + (size_t)h * 131072 * 64;
    const bf16_t* krb = (const bf16_t*)(ws + WS_KR); const bf16_t* ckr = (const bf16_t*)(ws + WS_CKR);
    const float* LC = (const float*)(ws + WS_LC); const float* CLC = (const float*)(ws + WS_CLC); const float* CTT = (const float*)(ws + WS_CTT);
    const float* cfk = p.in[4]; const float* cfv = p.in[5];
    bf16_t* mixed = (bf16_t*)(ws + WS_MIXED);
    LAS float* TPs = (LAS float*)(lds + S_TP);
    __syncthreads();
    float tall = 0.f;
    if (FOX) {
        const float t0 = CTT[(size_t)(sb * 128 + 2 * lane) * 8 + h], t1 = CTT[(size_t)(sb * 128 + 2 * lane + 1) * 8 + h];
        const float tot = t0 + t1; float inc = tot;
#pragma unroll
        for (int off = 1; off < 64; off <<= 1) { const float v = __shfl_up(inc, off); if (lane >= off) inc += v; }
        const float ex = inc - tot;
        TPs[2 * lane] = ex; TPs[2 * lane + 1] = ex + t0;
        tall = __shfl(inc, 63);
    }
    const int row0 = RS0 + sb * 32, qrow = row0 + r32;
    bf16x8 qf[DK / 16 + 1];
    load_qfrags<DK, FOX>(p, row0, r32, h, hi, qf);
    f32x16 o[2];
#pragma unroll
    for (int r = 0; r < 16; ++r) { o[0][r] = 0.f; o[1][r] = 0.f; }
    float rref = 0.f, l = 0.f, rmin = 0.f;
    f32x16 negm;
#pragma unroll
    for (int r = 0; r < 16; ++r) negm[r] = 0.f;
    f32x16 s1[1];
    bool first = true;
    if (wid == 0) {
        const char* nk_ = (const char*)(kh + (size_t)row0 * 64); const char* nv_ = (const char*)(vh + (size_t)row0 * 64);
#pragma unroll
        for (int i = 0; i < 4; ++i) { const unsigned off = (unsigned)(((lane >> 3) + 8 * i) * 64 + (lane & 7) * 8) * 2u;
            *(LAS u32x4*)(lds + (lane >> 3) * KP + (lane & 7) * 16 + i * 8 * KP) = *(const u32x4*)(nk_ + off); *(LAS u32x4*)(lds + S_V + (lane >> 3) * VP + (lane & 7) * 16 + i * 8 * VP) = *(const u32x4*)(nv_ + off); }
        if (!FOX) { const char* nr_ = (const char*)(krb + (size_t)row0 * 32);
#pragma unroll
            for (int i = 0; i < 2; ++i) *(LAS u32x4*)(lds + (lane >> 2) * KP + (8 + (lane & 3)) * 16 + i * 16 * KP) = *(const u32x4*)(nr_ + (unsigned)((lane >> 2) * 32 + (lane & 3) * 8) * 2u + i * 16 * 64); }
        if (FOX && lane < 32) { const float bv = FOX ? -(*(const float*)((const char*)(LC + (size_t)row0 * 8 + h) + (unsigned)lane * 32u)) * LOG2E : 0.f;
            *(LAS u32x4*)(lds + lane * KP + DK * 2) = bias_chunk(bv); *(LAS u32x4*)(lds + lane * KP + DK * 2 + 16) = (u32x4){0u, 0u, 0u, 0u}; }
        asm volatile("s_waitcnt lgkmcnt(0)" ::: "memory");
        attn_qk<DK, 1>(lds, qf, s1, lane, negm);
        attn_sm_a<1, !FOX>(s1, o, rref, l, qf[DK / 16], true, FOX ? 2 : 0, 0, lane, rmin, negm);
        attn_sm_pv<1>(s1, l, lds + S_V, o, lane);
        first = false;
    }
    const size_t crow0 = (size_t)sb * PAST;
    const unsigned ldk0 = (lane >> 3) * KP + (lane & 7) * 16, ldv0 = S_V + (lane >> 3) * VP + (lane & 7) * 16;
    const unsigned so0 = FOX ? (unsigned)((lane >> 3) * 512 + h * 64 + (lane & 7) * 8) * 4u : (unsigned)((lane >> 3) * 64 + (lane & 7) * 8) * 2u;
    constexpr unsigned SROW8 = FOX ? 8u * 512u * 4u : 8u * 64u * 2u;
    if (FOX) {
        f32x4 rk[4][2], rv[4][2]; float rc = 0.f;
#define LOADC(tt) do { const char* kb_ = (const char*)(cfk + (crow0 + 32 * (tt)) * 512); const char* vb_ = (const char*)(cfv + (crow0 + 32 * (tt)) * 512); \
            _Pragma("unroll") for (int i = 0; i < 4; ++i) { const unsigned so_ = so0 + i * SROW8; rk[i][0] = *(const f32x4*)(kb_ + so_); rk[i][1] = *(const f32x4*)(kb_ + so_ + 16); rv[i][0] = *(const f32x4*)(vb_ + so_); rv[i][1] = *(const f32x4*)(vb_ + so_ + 16); } \
            if (lane < 32) rc = *(const float*)((const char*)(CLC + (crow0 + 32 * (tt)) * 8 + h) + (unsigned)lane * 32u); } while (0)
        LOADC(127 - wid);
#pragma unroll 1
        for (int t = 127 - wid; t >= 0; t -= 8) {
#if 0
            for (int i = 0; i < 4; ++i) { const unsigned so_ = so0 + i * SROW8; rk[i][0] = *(const f32x4*)(kb_ + so_); rk[i][1] = *(const f32x4*)(kb_ + so_ + 16); rv[i][0] = *(const f32x4*)(vb_ + so_); rv[i][1] = *(const f32x4*)(vb_ + so_ + 16); }
#endif
#pragma unroll
            for (int i = 0; i < 4; ++i) { *(LAS u32x4*)(lds + ldk0 + i * 8 * KP) = pack8(rk[i][0], rk[i][1]); *(LAS u32x4*)(lds + ldv0 + i * 8 * VP) = pack8(rv[i][0], rv[i][1]); }
            if (lane < 32) { *(LAS u32x4*)(lds + lane * KP + DK * 2) = bias_chunk(-(rc + TPs[t] - tall) * LOG2E); *(LAS u32x4*)(lds + lane * KP + DK * 2 + 16) = (u32x4){0u, 0u, 0u, 0u}; }
            if (t >= 8) LOADC(t - 8);
            asm volatile("s_waitcnt lgkmcnt(0)" ::: "memory");
            attn_qk<DK, 1>(lds, qf, s1, lane, negm);
            attn_sm_a<1, !FOX>(s1, o, rref, l, qf[DK / 16], first, 0, 0, lane, rmin, negm);
            attn_sm_pv<1>(s1, l, lds + S_V, o, lane);
            first = false;
        }
#undef LOADC
    } else {
        const unsigned ro0 = (unsigned)((lane >> 2) * 32 + (lane & 3) * 8) * 2u, rld0 = (lane >> 2) * KP + (8 + (lane & 3)) * 16;
        u32x4 rk[4], rr[2], rv[4];
#define LOADC(tt) do { const char* kb_ = (const char*)(knc + (crow0 + 32 * (tt)) * 64); const char* vb_ = (const char*)(vmc + (crow0 + 32 * (tt)) * 64); const char* rb_ = (const char*)(ckr + (crow0 + 32 * (tt)) * 32); \
            _Pragma("unroll") for (int i = 0; i < 4; ++i) { const unsigned so_ = so0 + i * SROW8; rk[i] = *(const u32x4*)(kb_ + so_); rv[i] = *(const u32x4*)(vb_ + so_); } \
            _Pragma("unroll") for (int i = 0; i < 2; ++i) rr[i] = *(const u32x4*)(rb_ + ro0 + i * 16 * 64); } while (0)
        LOADC(127 - wid);
#pragma unroll 1
        for (int t = 127 - wid; t >= 0; t -= 8) {
#pragma unroll
            for (int i = 0; i < 4; ++i) { *(LAS u32x4*)(lds + ldk0 + i * 8 * KP) = rk[i]; *(LAS u32x4*)(lds + ldv0 + i * 8 * VP) = rv[i]; }
#pragma unroll
            for (int i = 0; i < 2; ++i) *(LAS u32x4*)(lds + rld0 + i * 16 * KP) = rr[i];
            if (t >= 8) LOADC(t - 8);
            asm volatile("s_waitcnt lgkmcnt(0)" ::: "memory");
            attn_qk<DK, 1>(lds, qf, s1, lane, negm);
            attn_sm_a<1, !FOX>(s1, o, rref, l, qf[DK / 16], first, 0, 0, lane, rmin, negm);
            attn_sm_pv<1>(s1, l, lds + S_V, o, lane);
            first = false;
        }
#undef LOADC
    }
    l = l + __shfl_xor(l, 32);
    __syncthreads();
    {
        LAS float* MO = (LAS float*)(lds0 + M_O) + (size_t)(wid * 32 + r32) * 64; LAS float* ML = (LAS float*)(lds0 + M_ML) + (wid * 32 + r32) * 2;
#pragma unroll
        for (int d = 0; d < 2; ++d)
#pragma unroll
            for (int g = 0; g < 4; ++g) *(LAS f32x4*)(MO + d * 32 + 8 * g + 4 * hi) = (f32x4){o[d][4 * g], o[d][4 * g + 1], o[d][4 * g + 2], o[d][4 * g + 3]};
        if (hi == 0) { ML[0] = rref; ML[1] = l; }
    }
    __syncthreads();
    {
        const int q = tid >> 4, c4 = (tid & 15) * 4;
        const LAS float* ML = (const LAS float*)(lds0 + M_ML) + q * 2; const LAS float* MO = (const LAS float*)(lds0 + M_O) + q * 64 + c4;
        float M = ML[0];
#pragma unroll
        for (int w = 1; w < 8; ++w) M = fmaxf(M, ML[w * 64]);
        float L = 0.f; f32x4 acc = (f32x4){0.f, 0.f, 0.f, 0.f};
#pragma unroll
        for (int w = 0; w < 8; ++w) { const float f = __builtin_amdgcn_exp2f(ML[w * 64] - M); L += ML[w * 64 + 1] * f; acc = acc + *(const LAS f32x4*)(MO + w * 2048) * f; }
        const float inv = 1.0f / L;
        *(u32x2*)((char*)(mixed + (size_t)row0 * 1024 + (FOX ? 512 : 0) + h * 64) + (unsigned)(q * 1024 + c4) * 2u) = (u32x2){pk2(acc.x * inv, acc.y * inv), pk2(acc.z * inv, acc.w * inv)};
    }
}

constexpr int NPHASE = 10;
__global__ void __launch_bounds__(512, 2) mega_fwd(Params p) {
    extern __shared__ __attribute__((aligned(16))) unsigned char lds_raw[];
    LAS unsigned char* lds = (LAS unsigned char*)lds_raw;
    __builtin_assume(__builtin_amdgcn_workitem_id_y() == 0); __builtin_assume(__builtin_amdgcn_workitem_id_z() == 0);
    cg::grid_group grid = cg::this_grid();
    unsigned char* ws = p.ws;
    const int tid = threadIdx.x, lane = tid & 63, wid = __builtin_amdgcn_readfirstlane(tid >> 6);
    const int G = gridDim.x, gw = blockIdx.x * 8 + wid, NGW = G * 8, gt = blockIdx.x * 512 + tid, NGT = G * 512;
    const int lo = p.ph_lo, hi = p.ph_hi;
#ifdef PH_ONLY
#define IN(k) ((k) == PH_ONLY && lo <= (k) && (k) < hi)
#else
#define IN(k) (lo <= (k) && (k) < hi)
#endif
#define SEAM(k) do { if (IN(k) && IN((k) + 1)) grid.sync(); } while (0)
#define PHASE_IDS() int tid_q = threadIdx.x; asm volatile("" : "+v"(tid_q)); const int lane = tid_q & 63, gt = blockIdx.x * 512 + tid_q; (void)gt; (void)lane

    if (IN(0)) {
        PHASE_IDS();
        LAS float* scr = (LAS float*)(lds + wid * 8448);
        constexpr int I_IN = 16 * 70, I_UQ = 6 * 24, I_UKV = 4 * 32, I_OUT = 16 * 32, I_G = 16 * 88, I_D = 44 * 32;
        constexpr int NITEMS = I_IN + I_UQ + I_UKV + I_OUT + 2 * I_G + I_D;
        for (int it = gw; it < NITEMS; it += NGW) {
            int r = it;
            if (r < I_IN) { p0_transpose_item(p.in[9], 1024, DIN, ((bf16_t*)(ws + WS_WIN)), 1, scr, r, lane); continue; } r -= I_IN;
            if (r < I_UQ) { p0_transpose_item(p.in[12], 384, 768, ((bf16_t*)(ws + WS_WUQ)), 4, scr, r, lane); continue; } r -= I_UQ;
            if (r < I_UKV) { p0_transpose_item(p.in[14], 256, 1024, ((bf16_t*)(ws + WS_WUKV)), 0, scr, r, lane); continue; } r -= I_UKV;
            if (r < I_OUT) { p0_transpose_item(p.in[15], 1024, 1024, ((bf16_t*)(ws + WS_WOUT)), 0, scr, r, lane); continue; } r -= I_OUT;
            if (r < I_G) { p0_transpose_item(p.in[17], 1024, DFF, ((bf16_t*)(ws + WS_WGU)), 2, scr, r, lane, p.in[16]); continue; } r -= I_G;
            if (r < I_G) { p0_transpose_item(p.in[18], 1024, DFF, ((bf16_t*)(ws + WS_WGU)), 3, scr, r, lane, p.in[16]); continue; } r -= I_G;
            p0_transpose_item(p.in[19], DFF, 1024, ((bf16_t*)(ws + WS_WDN)), 0, scr, r, lane);
        }
        if (gt < 16) ((unsigned*)(ws + WS_KINF))[gt] = 0u;
        for (int c = gt; c < RT; c += NGT) { ((float*)(ws + WS_SS1))[c] = 0.f; ((float*)(ws + WS_SS2))[c] = 0.f; }
        for (int c = gt; c < 88 * 128; c += NGT) ((u32x4*)(((bf16_t*)(ws + WS_WIN)) + (size_t)680 * 1024))[c] = (u32x4){0, 0, 0, 0};
        bf16_t* XN = (bf16_t*)(ws + WS_XN);
        for (int r0 = gw; r0 < RT; r0 += 2 * NGW) {
            const int r1 = r0 + NGW;
            const float* xa = x_of_row(p, r0); const float* xb = r1 < RT ? x_of_row(p, r1) : nullptr;
            if (xa && xb) { norm_rows2_to_bf16(xa, xb, p.in[8], XN + (size_t)r0 * DM, XN + (size_t)r1 * DM, lane); continue; }
#pragma unroll 1
            for (int k = 0; k < 2; ++k) { const int r = k ? r1 : r0; if (r >= RT) break; const float* xr = k ? xb : xa;
                if (xr) norm_row_to_bf16(xr, p.in[8], XN + (size_t)r * DM, lane);
                else { ((u32x4*)(XN + (size_t)r * DM))[lane] = (u32x4){0, 0, 0, 0}; ((u32x4*)(XN + (size_t)r * DM))[lane + 64] = (u32x4){0, 0, 0, 0}; } }
        }
        for (int i = gt; i < LP * 16; i += NGT) rope_entry((float*)(ws + WS_ROPE), i);
        { const float* cl = p.in[2]; bf16_t* CLAT = (bf16_t*)(ws + WS_CLAT);
          for (int c = gt; c < 131072 * 32; c += NGT) { const f32x4 a = ((const f32x4*)cl)[2 * (size_t)c], b2 = ((const f32x4*)cl)[2 * (size_t)c + 1]; ((u32x4*)CLAT)[c] = pack8(a, b2); }
          const float* ck = p.in[3]; bf16_t* CKR = (bf16_t*)(ws + WS_CKR);
          for (int c = gt; c < 131072 * 4; c += NGT) { const f32x4 a = ((const f32x4*)ck)[2 * (size_t)c], b2 = ((const f32x4*)ck)[2 * (size_t)c + 1]; ((u32x4*)CKR)[c] = pack8(a, b2); } }
        for (int g = gw; g < 4096; g += NGW) cache_cum_group(p.in[6], (float*)(ws + WS_CLC), (float*)(ws + WS_CTT), g, lane);
    }
    SEAM(0);
    if (IN(1)) {
        { pg8::Gemm g{(const bf16_t*)(ws + WS_XN), ((bf16_t*)(ws + WS_WIN)), RT, 2304, 1024}; pg8::StaticOrder S; S.init(RT, 2304, G, (int)blockIdx.x);
          EpiG1 E{(bf16_t*)(ws + WS_PROJC), (bf16_t*)(ws + WS_FQ), (bf16_t*)(ws + WS_FKH), (bf16_t*)(ws + WS_FVH), p.out, (unsigned*)(ws + WS_KINF)};
          pg8::gemm_phase<EpiG1, pg8::StaticOrder, false, true>(lds, g, S, E); }
        { pg8::Gemm g{(const bf16_t*)(ws + WS_CLAT), ((bf16_t*)(ws + WS_WUKV)), 131072, 1024, 256}; pg8::StaticOrder S; S.init(131072, 1024, G, (int)blockIdx.x);
          EpiKV E{(bf16_t*)(ws + WS_KNC), (bf16_t*)(ws + WS_VMC), (size_t)131072};
          pg8::gemm_phase<EpiKV, pg8::StaticOrder, false, true>(lds, g, S, E); }
    }
    SEAM(1);
    if (IN(2)) { PHASE_IDS(); for (int gi = gw; gi < NGRP; gi += NGW) p2_group(p, gi, lane); }
    SEAM(2);
    if (IN(3)) {
        { pg8::Gemm g{(const bf16_t*)(ws + WS_CQN), ((bf16_t*)(ws + WS_WUQ)), RT, 768, 384}; pg8::StaticOrder S; S.init(RT, 768, G, (int)blockIdx.x);
          EpiBf16 E{(bf16_t*)(ws + WS_QMLA), 768};
          pg8::gemm_phase<EpiBf16, pg8::StaticOrder, false, true>(lds, g, S, E); }
        { pg8::Gemm g{(const bf16_t*)(ws + WS_LATN), ((bf16_t*)(ws + WS_WUKV)), RT, 1024, 256}; pg8::StaticOrder S; S.init(RT, 1024, G, (int)blockIdx.x);
          EpiKV E{(bf16_t*)(ws + WS_KNH), (bf16_t*)(ws + WS_VMH), (size_t)RT};
          pg8::gemm_phase<EpiKV, pg8::StaticOrder, false, true>(lds, g, S, E); }
    }
    SEAM(3);
    if (IN(4)) {
        const int bx = blockIdx.x;
        if (G == 256) {
#pragma unroll 1
            for (int r = 15; r >= 0; --r) {
                if (r == (bx & 15)) {
#pragma unroll 1
                    for (int k = 0; k < 2; ++k) { const int u = 2 * bx + k, sb = u >> 4, h = u & 7;
                        if ((u >> 3) & 1) attn_sample_unit<true>(p, lds, sb, h); else attn_sample_unit<false>(p, lds, sb, h); }
                }
                const int j = r >> 1, type = (r ^ bx) & 1, bh = (bx >> 1) & 63, q4 = (bx & 1) + 2 * (bx >> 7), qb = 4 * j + ((j & 1) ? 3 - q4 : q4);
                if (type) attn_prompt_unit<true>(p, lds, bh >> 3, (bh + j) & 7, qb); else attn_prompt_unit<false>(p, lds, bh >> 3, bh & 7, qb);
            }
        } else {
            for (int su = 2 * bx; su < 512; su += 2 * G) {
#pragma unroll 1
                for (int k = 0; k < 2; ++k) { const int u = su + k, sb = u >> 4, h = u & 7;
                    if ((u >> 3) & 1) attn_sample_unit<true>(p, lds, sb, h); else attn_sample_unit<false>(p, lds, sb, h); }
            }
            for (int ui = bx; ui < 4096; ui += G) {
                const int qb = 31 - (ui >> 7), c = ui & 127, type = c >> 6, b = (c >> 3) & 7, h = c & 7;
                if (type) attn_prompt_unit<true>(p, lds, b, h, qb); else attn_prompt_unit<false>(p, lds, b, h, qb);
            }
        }
    }
    SEAM(4);
    if (IN(5)) {
        pg8::Gemm g{(const bf16_t*)(ws + WS_MIXED), ((bf16_t*)(ws + WS_WOUT)), RT, 1024, 1024}; pg8::StaticOrder S; S.init(RT, 1024, G, (int)blockIdx.x);
        EpiRes E{p.in[0], p.in[1], (bf16_t*)(ws + WS_HN), (float*)(ws + WS_SS1)};
        pg8::gemm_phase<EpiRes, pg8::StaticOrder, true, true>(lds, g, S, E);
    }
    if (IN(5) && IN(7)) grid.sync();
    if (IN(7)) {
        pg8::Gemm g{(const bf16_t*)(ws + WS_HN), ((bf16_t*)(ws + WS_WGU)), RT, 2 * DFF, 1024}; pg8::StaticOrder S; S.init(RT, 2 * DFF, G, (int)blockIdx.x);
        EpiSwiglu E{(bf16_t*)(ws + WS_ACT), (const float*)(ws + WS_SS1)};
        pg8::gemm_phase<EpiSwiglu, pg8::StaticOrder, true, true>(lds, g, S, E);
    }
    SEAM(7);
    if (IN(8)) {
        pg8::Gemm g{(const bf16_t*)(ws + WS_ACT), ((bf16_t*)(ws + WS_WDN)), RS0, 1024, DFF, 0}; pg8::StaticOrder S; S.init(RS0, 1024, G, (int)blockIdx.x);
        EpiAcc E{(bf16_t*)(ws + WS_HN), (float*)(ws + WS_SS2)};
        pg8::gemm_phase<EpiAcc, pg8::StaticOrder, true, true>(lds, g, S, E);
        { pg8::Gemm g2{(const bf16_t*)(ws + WS_ACT), ((bf16_t*)(ws + WS_WDN)), RT, 1024, 256, DFF}; SplitOrder S2{(int)blockIdx.x};
          EpiPart E2{(float*)(ws + WS_XPART)};
          pg8::gemm_phase<EpiPart, SplitOrder, false, true>(lds, g2, S2, E2); }
    }
    SEAM(8);
    if (IN(9)) {
        PHASE_IDS();
        const bf16_t* x2b = (const bf16_t*)(ws + WS_HN); const float* ss2 = (const float*)(ws + WS_SS2); const float* g = p.in[20];
        f32x4 gg[4];
#pragma unroll
        for (int j = 0; j < 4; ++j) gg[j] = ((const f32x4*)g)[4 * lane + j];
        for (int r = RS0 + gw; r < RM0; r += NGW) {
            const u32x4 w0 = ((const u32x4*)(x2b + (size_t)r * DM))[2 * lane], w1 = ((const u32x4*)(x2b + (size_t)r * DM))[2 * lane + 1];
            f32x4 v[4];
            v[0] = (f32x4){__uint_as_float(w0.x << 16), __uint_as_float(w0.x & 0xffff0000u), __uint_as_float(w0.y << 16), __uint_as_float(w0.y & 0xffff0000u)};
            v[1] = (f32x4){__uint_as_float(w0.z << 16), __uint_as_float(w0.z & 0xffff0000u), __uint_as_float(w0.w << 16), __uint_as_float(w0.w & 0xffff0000u)};
            v[2] = (f32x4){__uint_as_float(w1.x << 16), __uint_as_float(w1.x & 0xffff0000u), __uint_as_float(w1.y << 16), __uint_as_float(w1.y & 0xffff0000u)};
            v[3] = (f32x4){__uint_as_float(w1.z << 16), __uint_as_float(w1.z & 0xffff0000u), __uint_as_float(w1.w << 16), __uint_as_float(w1.w & 0xffff0000u)};
            const float* xp = (const float*)(ws + WS_XPART) + (size_t)(r - RS0) * 1024 + 16 * lane;
#pragma unroll 1
            for (int ks = 0; ks < 11; ++ks) {
#pragma unroll
                for (int j = 0; j < 4; ++j) v[j] = v[j] + ((const f32x4*)(xp + (size_t)ks * 1024 * 1024))[j]; }
            float sq = 0.f;
#pragma unroll
            for (int j = 0; j < 4; ++j) sq += (v[j].x * v[j].x + v[j].y * v[j].y) + (v[j].z * v[j].z + v[j].w * v[j].w);
            const float rstd = 1.0f / sqrtf(wave_sum(sq) * (1.0f / DM) + EPS);
            f32x4* o4 = (f32x4*)(p.out + (size_t)r * DM) + 4 * lane;
#pragma unroll
            for (int j = 0; j < 4; ++j) o4[j] = v[j] * rstd * gg[j];
        }
        for (int rb = gw; rb < RS0; rb += 4 * NGW) {
            u32x4 w0[4], w1[4]; float sr[4];
#pragma unroll
            for (int k = 0; k < 4; ++k) { const int r = rb + k * NGW; const u32x4* src = (const u32x4*)(x2b + (size_t)(r < RS0 ? r : rb) * DM); w0[k] = src[2 * lane]; w1[k] = src[2 * lane + 1]; sr[k] = ss2[r < RS0 ? r : rb]; }
#pragma unroll
            for (int k = 0; k < 4; ++k) { const int r = rb + k * NGW; if (r >= RS0) break;
                const float rstd = 1.0f / sqrtf(sr[k] * (1.0f / DM) + EPS);
                f32x4* o4 = (f32x4*)(p.out + (size_t)r * DM) + 4 * lane;
                o4[0] = (f32x4){__uint_as_float(w0[k].x << 16), __uint_as_float(w0[k].x & 0xffff0000u), __uint_as_float(w0[k].y << 16), __uint_as_float(w0[k].y & 0xffff0000u)} * rstd * gg[0];
                o4[1] = (f32x4){__uint_as_float(w0[k].z << 16), __uint_as_float(w0[k].z & 0xffff0000u), __uint_as_float(w0[k].w << 16), __uint_as_float(w0[k].w & 0xffff0000u)} * rstd * gg[1];
                o4[2] = (f32x4){__uint_as_float(w1[k].x << 16), __uint_as_float(w1[k].x & 0xffff0000u), __uint_as_float(w1[k].y << 16), __uint_as_float(w1[k].y & 0xffff0000u)} * rstd * gg[2];
                o4[3] = (f32x4){__uint_as_float(w1[k].z << 16), __uint_as_float(w1[k].z & 0xffff0000u), __uint_as_float(w1[k].w << 16), __uint_as_float(w1[k].w & 0xffff0000u)} * rstd * gg[3];
            }
        }
    }
#undef IN
#undef SEAM
}

#ifndef MK_N_LAUNCHES
#define MK_N_LAUNCHES 1
#endif
extern "C" void kernel_launch(void* const* d_in, const int* in_sizes, int n_in, void* d_out, int out_size, void* d_ws, size_t ws_size, hipStream_t stream) {
    static int grid = 0;
    if (grid == 0) {
        if (n_in != 21 || (size_t)out_size != O_END || ws_size < WS_END) { fprintf(stderr, "kernel_launch: unexpected shapes n_in %d out %d ws %zu (need %zu)\n", n_in, out_size, ws_size, (size_t)WS_END); grid = -1; return; }
        int dev = 0, cus = 0, per_cu = 0;
        hipGetDevice(&dev); hipDeviceGetAttribute(&cus, hipDeviceAttributeMultiprocessorCount, dev);
        if (hipFuncSetAttribute((const void*)mega_fwd, hipFuncAttributeMaxDynamicSharedMemorySize, LDS_BYTES) != hipSuccess) { fprintf(stderr, "kernel_launch: hipFuncSetAttribute failed\n"); grid = -1; return; }
        if (hipOccupancyMaxActiveBlocksPerMultiprocessor(&per_cu, (const void*)mega_fwd, 512, LDS_BYTES) != hipSuccess || per_cu < 1) { fprintf(stderr, "kernel_launch: occupancy query says %d\n", per_cu); per_cu = 1; }
        (void)hipGetLastError();
        grid = cus;
    }
    if (grid < 0) return;
    Params prm{};
    for (int i = 0; i < 21; ++i) prm.in[i] = (const float*)d_in[i];
    prm.out = (float*)d_out; prm.ws = (unsigned char*)d_ws;
#if MK_N_LAUNCHES == 1
    prm.ph_lo = 0; prm.ph_hi = NPHASE;
    void* args[] = {&prm};
    hipError_t e = hipLaunchCooperativeKernel((const void*)mega_fwd, dim3(grid), dim3(512), args, LDS_BYTES, stream);
    if (e != hipSuccess) fprintf(stderr, "cooperative launch failed: %s (grid %d)\n", hipGetErrorString(e), grid);
#ifdef PROBE_EXTRA_PHASE
    { Params q2 = prm; q2.ph_lo = PROBE_EXTRA_PHASE; q2.ph_hi = PROBE_EXTRA_PHASE + 1; hipLaunchKernelGGL(mega_fwd, dim3(grid), dim3(512), LDS_BYTES, stream, q2); }
#endif
#else
    for (int k = 0; k < NPHASE; ++k) { prm.ph_lo = k; prm.ph_hi = k + 1; hipLaunchKernelGGL(mega_fwd, dim3(grid), dim3(512), LDS_BYTES, stream, prm); }
#endif
}
```

```cpp
#include <hip/hip_runtime.h>
#include <hip/hip_cooperative_groups.h>
#include <cstdio>
#include <cstdint>
namespace cg = cooperative_groups;
namespace pg8 {
#define PG8_LAS __attribute__((address_space(3)))
typedef unsigned short bf16_t;
typedef short bf16x8 __attribute__((ext_vector_type(8)));
typedef float f32x4 __attribute__((ext_vector_type(4)));
typedef unsigned u32x4 __attribute__((ext_vector_type(4)));
constexpr int BM = 256, BK = 64, HALF = 128, HTB = HALF * BK * 2  , STAGE_BYTES = 8 * HTB, NXCD = 8, WGM = 8;

__host__ __device__ __forceinline__ int lds_byte(int r, int c) { const int st = (r >> 4) * 2 + (c >> 5), rr = r & 15, cc = c & 31, ob = rr * 64 + cc * 2; return st * 1024 + (ob ^ (((ob >> 9) & 1) << 5)); }
__host__ __device__ __forceinline__ void stage_rc(int b, int& R, int& C) { const int st = b / 1024, sb = b % 1024, swz = sb ^ (((sb >> 9) & 1) << 5); R = (st >> 1) * 16 + swz / 64; C = (st & 1) * 32 + (swz % 64) / 2; }
__host__ __device__ __forceinline__ int perm32(int rho) { const int n = rho >> 4, i = rho & 15; return 8 * (i >> 2) + 4 * n + (i & 3); }

struct Unit { int pm, pn, ko; };
struct Gemm { const bf16_t* A; const bf16_t* Bt; int M, N, K, ld; };

struct StaticOrder {
    int nM, nN, nwg, G, c;
    __host__ __device__ void init(int M, int N, int G_, int c_) { nM = M / BM; nN = N / BM; nwg = nM * nN; G = G_; c = c_; }
    __host__ __device__ bool next(int i, Unit& u) const {
        const long L = (long)i * G + c; if (L >= nwg) return false;
        int wgid = (int)L; { const int q = nwg / NXCD, r = nwg % NXCD, xcd = wgid % NXCD, off = wgid / NXCD; wgid = (xcd < r ? xcd * (q + 1) : r * (q + 1) + (xcd - r) * q) + off; }
        const int nig = WGM * nN, gid = wgid / nig, fm = gid * WGM, gsz = (nM - fm) < WGM ? (nM - fm) : WGM;
        u.pm = fm + ((wgid % nig) % gsz); u.pn = (wgid % nig) / gsz; u.ko = 0; return true;
    }
    __device__ __forceinline__ void a_ready(const Unit&) const {}
    __device__ __forceinline__ void done(const Unit&) const {}
};

__device__ __forceinline__ unsigned cvt_pk_bf16(float lo, float hi) { unsigned r; asm volatile("v_cvt_pk_bf16_f32 %0, %1, %2" : "=v"(r) : "v"(lo), "v"(hi)); return r; }
template <class Epi, class Sched, bool ALIGN_EPI = false, bool SP2 = false>
__device__ __forceinline__ void gemm_phase(PG8_LAS unsigned char* lds, const Gemm g, const Sched& S, const Epi& E) {
    int tid_o = threadIdx.x; asm volatile("" : "+v"(tid_o));
    const int tid = tid_o, wid = __builtin_amdgcn_readfirstlane(tid >> 6), lane = tid & 63, wr = wid >> 2, wc = wid & 3, fr = lane & 15, fq = lane >> 4;
    const int K = g.K, nt = K / BK, LD = g.ld ? g.ld : g.K;
    unsigned voffA[2], voffB[2];
#pragma unroll
    for (int i = 0; i < 2; ++i) { int R, C; stage_rc(tid * 16 + i * 8192, R, C); const int Rb = Epi::PERM ? ((R & ~31) + perm32(R & 31)) : R;
        voffA[i] = (unsigned)(R * LD + C) * 2u; voffB[i] = (unsigned)(Rb * LD + C) * 2u; }
    const size_t kstep = (size_t)(BK * 2);
    const size_t hstep = (size_t)HALF * LD * 2;
    const size_t tstep = 2 * hstep;
    const unsigned ldsw = (unsigned)wid * 1024u;
    const int aoff = lds_byte(wr * 64 + fr, fq * 8), boff = lds_byte(wc * 32 + fr, fq * 8);
#define PG8_SA(b, h) (((b) * 2 + (h)) * HTB)
#define PG8_SB(b, h) ((4 + (b) * 2 + (h)) * HTB)
#define PG8_STAGE(bufoff, gbase, voff) do { _Pragma("unroll") for (int _i = 0; _i < 2; ++_i) \
        __builtin_amdgcn_global_load_lds((const unsigned*)((const char*)(gbase) + (voff)[_i]), (PG8_LAS unsigned*)(lds + (bufoff) + ldsw + _i * 8192), 16, 0, 0); } while (0)
#define PG8_LDA(dst, b, h) do { _Pragma("unroll") for (int m = 0; m < 4; ++m) _Pragma("unroll") for (int k = 0; k < 2; ++k) dst[m][k] = *(const PG8_LAS bf16x8*)(lds + PG8_SA(b, h) + aoff + m * 2048 + k * 1024); } while (0)
#define PG8_LDB(dst, b, h) do { _Pragma("unroll") for (int n = 0; n < 2; ++n) _Pragma("unroll") for (int k = 0; k < 2; ++k) dst[n][k] = *(const PG8_LAS bf16x8*)(lds + PG8_SB(b, h) + boff + n * 2048 + k * 1024); } while (0)
#define PG8_MMA(ai, bj, At, Bt) do { __builtin_amdgcn_s_setprio(1); _Pragma("unroll") for (int m = 0; m < 4; ++m) _Pragma("unroll") for (int n = 0; n < 2; ++n) _Pragma("unroll") for (int k = 0; k < 2; ++k) \
        acc[ai][bj][m][n] = __builtin_amdgcn_mfma_f32_16x16x32_bf16(Bt[n][k], At[m][k], acc[ai][bj][m][n], 0, 0, 0); __builtin_amdgcn_s_setprio(0); } while (0)
#define PG8_WAIT_V(n) asm volatile("s_waitcnt vmcnt(" #n ")" ::: "memory")
#define PG8_WAIT_L(n) asm volatile("s_waitcnt lgkmcnt(" #n ")" ::: "memory")
#define PG8_BAR __builtin_amdgcn_s_barrier()
#define PG8_SCHED __builtin_amdgcn_sched_barrier(0)
    Unit cur, nxt; int ui = 0;
    if (!S.next(0, cur)) return;
    f32x4 acc[2][2][4][2];
#pragma unroll
    for (int a = 0; a < 2; ++a)
#pragma unroll
        for (int b = 0; b < 2; ++b)
#pragma unroll
            for (int m = 0; m < 4; ++m)
#pragma unroll
                for (int n = 0; n < 2; ++n) acc[a][b][m][n] = (f32x4){0.f, 0.f, 0.f, 0.f};
    bf16x8 At[4][2], B0[2][2], B1[2][2];
    const char* cA = (const char*)g.A + (size_t)cur.pm * tstep + (size_t)cur.ko * 2; const char* cB = (const char*)g.Bt + (size_t)cur.pn * tstep + (size_t)cur.ko * 2;
    S.a_ready(cur);
    if constexpr (SP2) {
        PG8_STAGE(PG8_SB(0, 0), cB, voffB); PG8_STAGE(PG8_SB(0, 1), cB + hstep, voffB); PG8_STAGE(PG8_SA(0, 0), cA, voffA); PG8_STAGE(PG8_SA(0, 1), cA + hstep, voffA);
        if (wr == 1) PG8_BAR;
        PG8_WAIT_V(2); PG8_BAR;
        PG8_STAGE(PG8_SB(1, 0), cB + kstep, voffB); PG8_STAGE(PG8_SA(1, 0), cA + kstep, voffA); PG8_STAGE(PG8_SB(1, 1), cB + hstep + kstep, voffB);
        PG8_WAIT_V(6); PG8_BAR;
    } else {
        PG8_STAGE(PG8_SB(0, 0), cB, voffB); PG8_STAGE(PG8_SA(0, 0), cA, voffA); PG8_STAGE(PG8_SB(0, 1), cB + hstep, voffB); PG8_STAGE(PG8_SA(0, 1), cA + hstep, voffA);
        if (wr == 1) PG8_BAR;
        PG8_WAIT_V(4); PG8_BAR;
        PG8_STAGE(PG8_SB(1, 0), cB + kstep, voffB); PG8_STAGE(PG8_SA(1, 0), cA + kstep, voffA); PG8_STAGE(PG8_SB(1, 1), cB + hstep + kstep, voffB);
        PG8_WAIT_V(6); PG8_BAR;
    }
    for (;;) {
        const bool has_next = S.next(ui + 1, nxt);
        const char* nA = has_next ? (const char*)g.A + (size_t)nxt.pm * tstep + (size_t)nxt.ko * 2 : cA; const char* nB = has_next ? (const char*)g.Bt + (size_t)nxt.pn * tstep + (size_t)nxt.ko * 2 : cB;
        for (int t = 0; t < nt; t += 2) {
            const bool last = (t == nt - 2);
            const char* a1 = cA + (size_t)(t + 1) * kstep;
            const char* a2 = last ? nA : cA + (size_t)(t + 2) * kstep; const char* b2 = last ? nB : cB + (size_t)(t + 2) * kstep;
            const char* a3 = a2 + kstep; const char* b3 = b2 + kstep;
            if (last && has_next) S.a_ready(nxt);
            if constexpr (SP2) {
            PG8_LDB(B0, 0, 0); PG8_LDB(B1, 0, 1); PG8_SCHED; PG8_LDA(At, 0, 0); PG8_STAGE(PG8_SA(1, 1), a1 + hstep, voffA);
            PG8_WAIT_V(8); PG8_WAIT_L(0); PG8_BAR; PG8_MMA(0, 0, At, B0); PG8_MMA(0, 1, At, B1); PG8_BAR; PG8_SCHED;
            PG8_LDA(At, 0, 1); PG8_STAGE(PG8_SB(0, 0), b2, voffB); PG8_STAGE(PG8_SB(0, 1), b2 + hstep, voffB); PG8_STAGE(PG8_SA(0, 0), a2, voffA);
            PG8_WAIT_V(8); PG8_WAIT_L(0); PG8_BAR; PG8_MMA(1, 0, At, B0); PG8_MMA(1, 1, At, B1); PG8_BAR; PG8_SCHED;
            PG8_LDB(B0, 1, 0); PG8_LDB(B1, 1, 1); PG8_SCHED; PG8_LDA(At, 1, 0); PG8_STAGE(PG8_SA(0, 1), a2 + hstep, voffA);
            PG8_WAIT_V(8); PG8_WAIT_L(0); PG8_BAR; PG8_MMA(0, 0, At, B0); PG8_MMA(0, 1, At, B1); PG8_BAR; PG8_SCHED;
            PG8_LDA(At, 1, 1); PG8_STAGE(PG8_SB(1, 0), b3, voffB); PG8_STAGE(PG8_SB(1, 1), b3 + hstep, voffB); PG8_STAGE(PG8_SA(1, 0), a3, voffA);
            PG8_WAIT_V(8); PG8_WAIT_L(0); PG8_BAR; PG8_MMA(1, 0, At, B0); PG8_MMA(1, 1, At, B1); PG8_BAR; PG8_SCHED;
            } else {
            PG8_LDB(B0, 0, 0); PG8_SCHED; PG8_LDA(At, 0, 0); PG8_STAGE(PG8_SA(1, 1), a1 + hstep, voffA);
            PG8_WAIT_L(8); PG8_BAR; PG8_WAIT_L(0); PG8_MMA(0, 0, At, B0); PG8_BAR; PG8_SCHED;
            PG8_LDB(B1, 0, 1); PG8_STAGE(PG8_SB(0, 0), b2, voffB);
            PG8_BAR; PG8_WAIT_L(0); PG8_MMA(0, 1, At, B1); PG8_BAR;
            PG8_LDA(At, 0, 1); PG8_STAGE(PG8_SA(0, 0), a2, voffA);
            PG8_BAR; PG8_WAIT_L(0); PG8_MMA(1, 0, At, B0); PG8_BAR; PG8_SCHED;
            PG8_STAGE(PG8_SB(0, 1), b2 + hstep, voffB);
            PG8_WAIT_V(6); PG8_BAR; PG8_MMA(1, 1, At, B1); PG8_BAR;
            PG8_LDB(B0, 1, 0); PG8_SCHED; PG8_LDA(At, 1, 0); PG8_STAGE(PG8_SA(0, 1), a2 + hstep, voffA);
            PG8_WAIT_L(8); PG8_BAR; PG8_WAIT_L(0); PG8_MMA(0, 0, At, B0); PG8_BAR; PG8_SCHED;
            PG8_LDB(B1, 1, 1); PG8_STAGE(PG8_SB(1, 0), b3, voffB);
            PG8_BAR; PG8_WAIT_L(0); PG8_MMA(0, 1, At, B1); PG8_BAR;
            PG8_LDA(At, 1, 1); PG8_STAGE(PG8_SA(1, 0), a3, voffA);
            PG8_BAR; PG8_WAIT_L(0); PG8_MMA(1, 0, At, B0); PG8_BAR; PG8_SCHED;
            PG8_STAGE(PG8_SB(1, 1), b3 + hstep, voffB);
            PG8_WAIT_V(6); PG8_BAR; PG8_MMA(1, 1, At, B1); PG8_BAR;
            }
        }
        if constexpr (ALIGN_EPI) { if (wr == 0) PG8_BAR; }
        if constexpr (!Epi::AFTER_DRAIN) { E(acc, cur, wr, wc, fr, fq); S.done(cur); }
        if (!has_next) break;
#pragma unroll
        for (int a = 0; a < 2; ++a)
#pragma unroll
            for (int b = 0; b < 2; ++b)
#pragma unroll
                for (int m = 0; m < 4; ++m)
#pragma unroll
                    for (int n = 0; n < 2; ++n) acc[a][b][m][n] = (f32x4){0.f, 0.f, 0.f, 0.f};
        cur = nxt; cA = nA; cB = nB; ++ui;
        if constexpr (ALIGN_EPI) { if (wr == 1) PG8_BAR; }
    }
    PG8_WAIT_V(0);
    if constexpr (!ALIGN_EPI) { if (wr == 0) PG8_BAR; }
    PG8_BAR;
    if constexpr (Epi::AFTER_DRAIN) { E.fused(acc, cur, wr, wc, fr, fq, lds, wid, lane); S.done(cur); }
#undef PG8_SA
#undef PG8_SB
#undef PG8_STAGE
#undef PG8_LDA
#undef PG8_LDB
#undef PG8_MMA
#undef PG8_WAIT_V
#undef PG8_WAIT_L
#undef PG8_BAR
#undef PG8_SCHED
}
}

#define DI __device__ __forceinline__
#define LAS __attribute__((address_space(3)))
typedef unsigned short bf16_t;
typedef short bf16x8 __attribute__((ext_vector_type(8)));
typedef short s16x4 __attribute__((ext_vector_type(4)));
typedef float f32x4 __attribute__((ext_vector_type(4)));
typedef float f32x16 __attribute__((ext_vector_type(16)));
typedef unsigned u32x4 __attribute__((ext_vector_type(4)));
typedef unsigned u32x2 __attribute__((ext_vector_type(2)));
typedef float f32x2_t __attribute__((ext_vector_type(2)));
typedef __bf16 bf16x2_t __attribute__((ext_vector_type(2)));
typedef short v4i16_t __attribute__((ext_vector_type(4)));
typedef int i32x4 __attribute__((ext_vector_type(4)));

constexpr int DM = 1024, NB = 8, SEQ = 8192, NMETA = 16, LP = 8208, SBN = 32, SSN = 32, PAST = 4096;
constexpr int RS0 = 65536, RM0 = 66560, RV = 66576, RT = 66816;
constexpr int DFF = 2816, DIN = 2216;
constexpr int NGRP = 2081;
constexpr float EPS = 1e-6f, LOG2E = 1.4426950408889634f;
constexpr float QS_FOX = 0.125f * LOG2E;
constexpr float QS_MLA = 0.10206207261596577f * LOG2E;
constexpr float NEGF = -1e30f;

constexpr size_t O_YP = 0, O_YS = O_YP + (size_t)NB * SEQ * DM, O_LATP = O_YS + (size_t)SBN * SSN * DM, O_KRP = O_LATP + (size_t)NB * LP * 256,
                 O_FKP = O_KRP + (size_t)NB * LP * 32, O_FVP = O_FKP + (size_t)NB * LP * 512, O_LFP = O_FVP + (size_t)NB * LP * 512,
                 O_LATS = O_LFP + (size_t)NB * LP * 8, O_KRS = O_LATS + (size_t)1024 * 256, O_FKS = O_KRS + (size_t)1024 * 32,
                 O_FVS = O_FKS + (size_t)1024 * 512, O_LFS = O_FVS + (size_t)1024 * 512, O_END = O_LFS + (size_t)1024 * 8;

constexpr size_t MiB = 1u << 20;
constexpr size_t WS_SS2 = 524288;
constexpr size_t WS_SS1 = 4096;
constexpr size_t WS_KINF = 0;
constexpr size_t WS_ROPE = 1 * MiB, WS_LC = 3 * MiB, WS_CLC = 6 * MiB, WS_TT = 10 * MiB, WS_CTT = 10 * MiB + 512 * 1024;
constexpr size_t WS_WIN = 11 * MiB, WS_WUQ = 16 * MiB, WS_WUKV = 17 * MiB, WS_WOUT = 18 * MiB, WS_WGU = 20 * MiB, WS_WDN = 31 * MiB;
constexpr size_t WS_XN = 37 * MiB;
constexpr size_t WS_CQN = WS_XN, WS_LATN = WS_XN + 50 * MiB, WS_MIXED = WS_XN;
constexpr size_t WS_PROJC = 168 * MiB;
constexpr size_t WS_QMLA = WS_PROJC;
constexpr size_t WS_KR = 266 * MiB;
constexpr size_t WS_CKR = 271 * MiB;
constexpr size_t WS_CLAT = 279 * MiB;
constexpr size_t WS_FQKV = 343 * MiB;
constexpr size_t WS_KVX = 539 * MiB;
constexpr size_t WS_KVXC = 670 * MiB;
constexpr size_t WS_XPART = 928 * MiB;
constexpr size_t WS_END = 972 * MiB;
constexpr size_t HM_BYTES = (size_t)RT * 512 * 2;
constexpr size_t WS_FQ = WS_FQKV, WS_FKH = WS_FQKV + HM_BYTES, WS_FVH = WS_FQKV + 2 * HM_BYTES;
constexpr size_t WS_KNH = WS_KVX, WS_VMH = WS_KVX + HM_BYTES;
constexpr size_t WS_KNC = WS_KVXC, WS_VMC = WS_KVXC + 128 * MiB;
static_assert(WS_FVH + HM_BYTES <= WS_KVX && WS_VMH + HM_BYTES <= WS_KVXC, "ws map");
constexpr size_t WS_HN = WS_FQKV;
constexpr size_t WS_ACT = WS_FQKV + 131 * MiB;
static_assert(WS_ACT + (size_t)RT * DFF * 2 <= WS_END, "ws map");
static_assert(WS_LATN + (size_t)RT * 256 * 2 <= WS_PROJC && WS_CQN + (size_t)RT * 384 * 2 <= WS_LATN, "ws map");

constexpr int LDS_BYTES = 147456;

struct Params { const float* in[21]; float* out; unsigned char* ws; int ph_lo, ph_hi; };

DI unsigned pk2(float lo, float hi) { f32x2_t v = {lo, hi}; bf16x2_t b = __builtin_convertvector(v, bf16x2_t); return __builtin_bit_cast(unsigned, b); }
DI float bf2f(unsigned short x) { return __uint_as_float((unsigned)x << 16); }
DI u32x4 pack8(f32x4 a, f32x4 b) { return (u32x4){pk2(a.x, a.y), pk2(a.z, a.w), pk2(b.x, b.y), pk2(b.z, b.w)}; }
DI float wave_sum(float v) {
#pragma unroll
    for (int o = 1; o < 64; o <<= 1) v += __shfl_xor(v, o);
    return v;
}
DI int row_pos(int row) { return row < RS0 ? NMETA + (row & 8191) : (row < RM0 ? PAST + ((row - RS0) & 31) : (row < RV ? row - RM0 : 0)); }
DI const float* x_of_row(const Params& p, int row) {
    return row < RS0 ? p.in[0] + (size_t)row * DM : (row < RM0 ? p.in[1] + (size_t)(row - RS0) * DM : (row < RV ? p.in[7] + (size_t)(row - RM0) * DM : nullptr));
}
DI void out_store8(float* outp, float* outs, int width, int row, int cc, f32x4 v0, f32x4 v1) {
    if (row < RS0) { const int b = row >> 13, t = row & 8191; float* d = outp + (size_t)(b * LP + NMETA + t) * width + cc; *(f32x4*)d = v0; *(f32x4*)(d + 4) = v1; }
    else if (row < RM0) { float* d = outs + (size_t)(row - RS0) * width + cc; *(f32x4*)d = v0; *(f32x4*)(d + 4) = v1; }
    else if (row < RV) { const int m = row - RM0;
#pragma unroll 1
        for (int b = 0; b < NB; ++b) { float* d = outp + (size_t)(b * LP + m) * width + cc; *(f32x4*)d = v0; *(f32x4*)(d + 4) = v1; } }
}

struct EpiG1 {
    static constexpr bool PERM = true, AFTER_DRAIN = false;
    bf16_t* projc; bf16_t* fqp; bf16_t* fkh; bf16_t* fvh; float* out; unsigned* kinf;
    DI void operator()(const f32x4 (&acc)[2][2][4][2], const pg8::Unit& u, int wr, int wc, int fr, int fq) const {
        const int pn = u.pn;
        float kmx[2] = {0.f, 0.f};
#pragma unroll
        for (int ai = 0; ai < 2; ++ai)
#pragma unroll
            for (int m = 0; m < 4; ++m) {
                const int row = u.pm * 256 + ai * 128 + wr * 64 + m * 16 + fr;
#pragma unroll
                for (int bj = 0; bj < 2; ++bj) {
                    const int col8 = bj * 128 + wc * 32 + 8 * fq;
                    f32x4 v0 = acc[ai][bj][m][0], v1 = acc[ai][bj][m][1];
                    if (pn < 3) { *(u32x4*)(projc + (size_t)row * 768 + pn * 256 + col8) = pack8(v0, v1); }
                    else {
                        const int c = (pn - 3) * 256 + col8;
                        if (pn < 5) *(u32x4*)(fqp + (size_t)row * 512 + c) = pack8(v0, v1);
                        else { char* base = (char*)((pn < 7 ? fkh : fvh) + (size_t)(((pn - 5) & 1) * 4 + bj * 2 + (wc >> 1)) * RT * 64);
                               *(u32x4*)(base + (unsigned)(row * 64 + (wc & 1) * 32 + 8 * fq) * 2u) = pack8(v0, v1); }
                        if (pn == 5 || pn == 6) {
                            float q2 = (v0.x * v0.x + v0.y * v0.y) + (v0.z * v0.z + v0.w * v0.w) + (v1.x * v1.x + v1.y * v1.y) + (v1.z * v1.z + v1.w * v1.w);
                            q2 += __shfl_xor(q2, 16); q2 += __shfl_xor(q2, 32);
                            kmx[bj] = fmaxf(kmx[bj], q2); }
                        if (pn >= 5) { const int which = (pn - 5) >> 1, cc = ((pn - 5) & 1) * 256 + col8;
                            out_store8(out + (which ? O_FVP : O_FKP), out + (which ? O_FVS : O_FKS), 512, row, cc, v0, v1); }
                    }
                }
            }
        if (pn == 5 || pn == 6) {
#pragma unroll
            for (int bj = 0; bj < 2; ++bj) { float m = kmx[bj];
#pragma unroll
                for (int o = 1; o < 64; o <<= 1) m = fmaxf(m, __shfl_xor(m, o));
                if ((fr | (fq << 4)) == 0) atomicMax(kinf + ((pn - 5) * 4 + bj * 2 + (wc >> 1)) * 2 + (wc & 1), __float_as_uint(m)); }
        }
    }
};
struct EpiBf16 {
    static constexpr bool PERM = true, AFTER_DRAIN = false;
    bf16_t* O; int ldc;
    DI void operator()(const f32x4 (&acc)[2][2][4][2], const pg8::Unit& u, int wr, int wc, int fr, int fq) const {
#pragma unroll
        for (int ai = 0; ai < 2; ++ai)
#pragma unroll
            for (int m = 0; m < 4; ++m) {
                const int row = u.pm * 256 + ai * 128 + wr * 64 + m * 16 + fr;
#pragma unroll
                for (int bj = 0; bj < 2; ++bj) {
                    const int col = u.pn * 256 + bj * 128 + wc * 32 + 8 * fq;
                    *(u32x4*)(O + (size_t)row * ldc + col) = pack8(acc[ai][bj][m][0], acc[ai][bj][m][1]);
                }
            }
    }
};
struct EpiKV {
    static constexpr bool PERM = true, AFTER_DRAIN = false;
    bf16_t* kn; bf16_t* vm; size_t nrows;
    DI void operator()(const f32x4 (&acc)[2][2][4][2], const pg8::Unit& u, int wr, int wc, int fr, int fq) const {
        const int d = (wc & 1) * 32 + 8 * fq;
#pragma unroll
        for (int bj = 0; bj < 2; ++bj) {
            char* base = (char*)(((wc >> 1) ? vm : kn) + (size_t)(u.pn * 2 + bj) * nrows * 64);
#pragma unroll
            for (int ai = 0; ai < 2; ++ai)
#pragma unroll
                for (int m = 0; m < 4; ++m) {
                    const int row = u.pm * 256 + ai * 128 + wr * 64 + m * 16 + fr;
                    *(u32x4*)(base + (unsigned)(row * 64 + d) * 2u) = pack8(acc[ai][bj][m][0], acc[ai][bj][m][1]);
                }
        }
    }
};
struct EpiQ {
    static constexpr bool PERM = false, AFTER_DRAIN = false;
    bf16_t* O; const float* rope;
    DI void operator()(const f32x4 (&acc)[2][2][4][2], const pg8::Unit& u, int wr, int wc, int fr, int fq) const {
#pragma unroll
        for (int bj = 0; bj < 2; ++bj) {
            const int g = u.pn * 8 + bj * 4 + wc;
            const bool is_rope = (g % 3) == 2;
#pragma unroll
            for (int ai = 0; ai < 2; ++ai)
#pragma unroll
                for (int m = 0; m < 4; ++m) {
                    const int row = u.pm * 256 + ai * 128 + wr * 64 + m * 16 + fr;
                    f32x4 a = acc[ai][bj][m][0], b = acc[ai][bj][m][1];
                    if (is_rope) {
                        const float* t = rope + (size_t)row_pos(row) * 32;
                        const f32x4 c = *(const f32x4*)(t + 4 * fq), s = *(const f32x4*)(t + 16 + 4 * fq);
                        const f32x4 o1 = a * c - b * s, o2 = b * c + a * s; a = o1; b = o2;
                    }
                    a = a * QS_MLA; b = b * QS_MLA;
                    bf16_t* d = O + (size_t)row * 768 + g * 32 + 4 * fq;
                    *(u32x2*)d = (u32x2){pk2(a.x, a.y), pk2(a.z, a.w)};
                    *(u32x2*)(d + 16) = (u32x2){pk2(b.x, b.y), pk2(b.z, b.w)};
                }
        }
    }
};
struct EpiRes {
    static constexpr bool PERM = true, AFTER_DRAIN = false;
    const float* xp; const float* xs; bf16_t* x1b; float* ss;
    DI void operator()(const f32x4 (&acc)[2][2][4][2], const pg8::Unit& u, int wr, int wc, int fr, int fq) const {
#pragma unroll
        for (int ai = 0; ai < 2; ++ai)
#pragma unroll
            for (int m = 0; m < 4; ++m) {
                const int row = u.pm * 256 + ai * 128 + wr * 64 + m * 16 + fr;
                float q = 0.f;
                if (row < RM0) {
                    const float* xr = row < RS0 ? xp + (size_t)row * DM : xs + (size_t)(row - RS0) * DM;
#pragma unroll
                    for (int bj = 0; bj < 2; ++bj) {
                        const int col = u.pn * 256 + bj * 128 + wc * 32 + 8 * fq;
                        const f32x4 y0 = *(const f32x4*)(xr + col) + acc[ai][bj][m][0], y1 = *(const f32x4*)(xr + col + 4) + acc[ai][bj][m][1];
                        q += (y0.x * y0.x + y0.y * y0.y) + (y0.z * y0.z + y0.w * y0.w) + (y1.x * y1.x + y1.y * y1.y) + (y1.z * y1.z + y1.w * y1.w);
                        *(u32x4*)(x1b + (size_t)row * DM + col) = pack8(y0, y1);
                    }
                }
                q += __shfl_xor(q, 16); q += __shfl_xor(q, 32);
                if (fq == 0 && row < RM0) atomicAdd(ss + row, q);
            }
    }
};
struct SplitOrder {
    int c;
    DI bool next(int i, pg8::Unit& u) const { if (i != 0 || c >= 176) return false; u.pm = 256 + c / 44; u.pn = (c / 11) & 3; u.ko = (c % 11) * 256; return true; }
    DI void a_ready(const pg8::Unit&) const {}
    DI void done(const pg8::Unit&) const {}
};
struct EpiPart {
    static constexpr bool PERM = true, AFTER_DRAIN = false;
    float* xp;
    DI void operator()(const f32x4 (&acc)[2][2][4][2], const pg8::Unit& u, int wr, int wc, int fr, int fq) const {
        float* base = xp + (size_t)(u.ko >> 8) * 1024 * 1024;
#pragma unroll
        for (int ai = 0; ai < 2; ++ai)
#pragma unroll
            for (int m = 0; m < 4; ++m) {
                const int rs = (u.pm - 256) * 256 + ai * 128 + wr * 64 + m * 16 + fr;
#pragma unroll
                for (int bj = 0; bj < 2; ++bj) {
                    float* d = base + (size_t)rs * 1024 + u.pn * 256 + bj * 128 + wc * 32 + 8 * fq;
                    *(f32x4*)d = acc[ai][bj][m][0]; *(f32x4*)(d + 4) = acc[ai][bj][m][1];
                }
            }
    }
};
struct EpiAcc {
    static constexpr bool PERM = true, AFTER_DRAIN = false;
    bf16_t* x1b; float* ss;
    DI void operator()(const f32x4 (&acc)[2][2][4][2], const pg8::Unit& u, int wr, int wc, int fr, int fq) const {
#pragma unroll
        for (int ai = 0; ai < 2; ++ai)
#pragma unroll
            for (int m = 0; m < 4; ++m) {
                const int row = u.pm * 256 + ai * 128 + wr * 64 + m * 16 + fr;
                float q = 0.f;
                if (row < RM0) {
#pragma unroll
                    for (int bj = 0; bj < 2; ++bj) {
                        const int col = u.pn * 256 + bj * 128 + wc * 32 + 8 * fq;
                        bf16_t* d = x1b + (size_t)row * DM + col;
                        const u32x4 w = *(const u32x4*)d;
                        const f32x4 y0 = (f32x4){__uint_as_float(w.x << 16), __uint_as_float(w.x & 0xffff0000u), __uint_as_float(w.y << 16), __uint_as_float(w.y & 0xffff0000u)} + acc[ai][bj][m][0];
                        const f32x4 y1 = (f32x4){__uint_as_float(w.z << 16), __uint_as_float(w.z & 0xffff0000u), __uint_as_float(w.w << 16), __uint_as_float(w.w & 0xffff0000u)} + acc[ai][bj][m][1];
                        q += (y0.x * y0.x + y0.y * y0.y) + (y0.z * y0.z + y0.w * y0.w) + (y1.x * y1.x + y1.y * y1.y) + (y1.z * y1.z + y1.w * y1.w);
                        *(u32x4*)d = pack8(y0, y1);
                    }
                }
                q += __shfl_xor(q, 16); q += __shfl_xor(q, 32);
                if (fq == 0 && row < RM0) atomicAdd(ss + row, q);
            }
    }
};
DI float silu_mul(float g, float u) { return g * u * __builtin_amdgcn_rcpf(1.0f + __builtin_amdgcn_exp2f(-g * LOG2E)); }
struct EpiSwiglu {
    static constexpr bool PERM = true, AFTER_DRAIN = false;
    bf16_t* O; const float* ss;
    DI void operator()(const f32x4 (&acc)[2][2][4][2], const pg8::Unit& u, int wr, int wc, int fr, int fq) const {
#pragma unroll
        for (int ai = 0; ai < 2; ++ai)
#pragma unroll
            for (int m = 0; m < 4; ++m) {
                const int row = u.pm * 256 + ai * 128 + wr * 64 + m * 16 + fr;
                const float rstd = 1.0f / sqrtf(ss[row] * (1.0f / DM) + EPS);
                const f32x4 g0 = acc[ai][0][m][0] * rstd, g1 = acc[ai][0][m][1] * rstd, u0 = acc[ai][1][m][0] * rstd, u1 = acc[ai][1][m][1] * rstd;
                f32x4 a0, a1;
#pragma unroll
                for (int i = 0; i < 4; ++i) { a0[i] = silu_mul(g0[i], u0[i]); a1[i] = silu_mul(g1[i], u1[i]); }
                *(u32x4*)(O + (size_t)row * DFF + u.pn * 128 + wc * 32 + 8 * fq) = pack8(a0, a1);
            }
    }
};

DI int wmap(int kind, int n) {
    if (kind == 0 || kind == 4) return n;
    if (kind == 1) return n < 384 ? 256 + n : (n < 640 ? n - 384 : (n < 672 ? n : (n < 2208 ? n + 96 : n - 1536)));
    if (kind == 2) return 256 * (n >> 7) + (n & 127);
    return 256 * (n >> 7) + 128 + (n & 127);
}
DI float wscale(int kind, int n) { return kind == 4 ? QS_MLA : ((kind == 1 && n >= 672 && n < 1184) ? QS_FOX : 1.0f); }
DI void p0_transpose_item(const float* W, int K, int N, bf16_t* WT, int kind, LAS float* scr, int item, int lane, const float* kscale = nullptr) {
    const int nblk = (N + 31) / 32, kb = item / nblk, nb = item % nblk, k0 = 64 * kb, n0 = 32 * nb;
    const int nl = n0 + (lane & 31);
    const float wsc = wscale(kind, nl);
#pragma unroll 8
    for (int i = 0; i < 32; ++i) { const int kk = 2 * i + (lane >> 5); scr[kk * 33 + (lane & 31)] = (nl < N) ? W[(size_t)(k0 + kk) * N + nl] * (kscale ? wsc * kscale[k0 + kk] : wsc) : 0.f; }
    asm volatile("s_waitcnt lgkmcnt(0)" ::: "memory");
    const int c = lane & 7;
#pragma unroll
    for (int j = 0; j < 4; ++j) { const int n = (lane >> 3) + 8 * j; const LAS float* s = scr + (8 * c) * 33 + n;
        u32x4 o; o.x = pk2(s[0 * 33], s[1 * 33]); o.y = pk2(s[2 * 33], s[3 * 33]); o.z = pk2(s[4 * 33], s[5 * 33]); o.w = pk2(s[6 * 33], s[7 * 33]);
        if (n0 + n < N) *(u32x4*)(WT + (size_t)wmap(kind, n0 + n) * K + k0 + 8 * c) = o; }
    asm volatile("s_waitcnt lgkmcnt(0)" ::: "memory");
}
DI void norm_row_to_bf16(const float* xrow, const float* g, bf16_t* orow, int lane) {
    f32x4 v[4]; float s = 0.f;
#pragma unroll
    for (int j = 0; j < 4; ++j) { v[j] = ((const f32x4*)xrow)[lane + 64 * j]; s += (v[j].x * v[j].x + v[j].y * v[j].y) + (v[j].z * v[j].z + v[j].w * v[j].w); }
    const float rstd = 1.0f / sqrtf(wave_sum(s) * (1.0f / DM) + EPS);
#pragma unroll
    for (int j = 0; j < 4; ++j) { const f32x4 gg = ((const f32x4*)g)[lane + 64 * j]; const f32x4 y = v[j] * rstd * gg;
        ((u32x2*)orow)[lane + 64 * j] = (u32x2){pk2(y.x, y.y), pk2(y.z, y.w)}; }
}
DI void norm_rows2_to_bf16(const float* x0, const float* x1, const float* g, bf16_t* o0, bf16_t* o1, int lane) {
    f32x4 v[4], w[4]; float s = 0.f, t = 0.f;
#pragma unroll
    for (int j = 0; j < 4; ++j) { v[j] = ((const f32x4*)x0)[lane + 64 * j]; w[j] = ((const f32x4*)x1)[lane + 64 * j]; }
#pragma unroll
    for (int j = 0; j < 4; ++j) { s += (v[j].x * v[j].x + v[j].y * v[j].y) + (v[j].z * v[j].z + v[j].w * v[j].w); t += (w[j].x * w[j].x + w[j].y * w[j].y) + (w[j].z * w[j].z + w[j].w * w[j].w); }
#pragma unroll
    for (int o = 1; o < 64; o <<= 1) { s += __shfl_xor(s, o); t += __shfl_xor(t, o); }
    const float rs = 1.0f / sqrtf(s * (1.0f / DM) + EPS), rt = 1.0f / sqrtf(t * (1.0f / DM) + EPS);
#pragma unroll
    for (int j = 0; j < 4; ++j) { const f32x4 gg = ((const f32x4*)g)[lane + 64 * j]; const f32x4 y = v[j] * rs * gg, z = w[j] * rt * gg;
        ((u32x2*)o0)[lane + 64 * j] = (u32x2){pk2(y.x, y.y), pk2(y.z, y.w)}; ((u32x2*)o1)[lane + 64 * j] = (u32x2){pk2(z.x, z.y), pk2(z.z, z.w)}; }
}
DI void rope_entry(float* tab, int idx) {
    const int pos = idx >> 4, i = idx & 15;
    double inv = 1.0; for (int k = 0; k < i; ++k) inv *= 0.5623413251903491;
    const double ang = (double)pos * inv;
    const double k2 = __builtin_rint(ang * 0.15915494309189535);
    double r = __builtin_fma(-k2, 6.283185307179586, ang); r = __builtin_fma(-k2, 2.4492935982947064e-16, r);
    const double q = __builtin_rint(r * 0.6366197723675814);
    const double y = __builtin_fma(-q, 1.5707963267948966, r), y2 = y * y;
    double sp = 1.0 / 6227020800.0; sp = sp * y2 - 1.0 / 39916800.0; sp = sp * y2 + 1.0 / 362880.0; sp = sp * y2 - 1.0 / 5040.0; sp = sp * y2 + 1.0 / 120.0; sp = sp * y2 - 1.0 / 6.0; sp = sp * y2 + 1.0;
    const double sn = sp * y;
    double cp = -1.0 / 87178291200.0; cp = cp * y2 + 1.0 / 479001600.0; cp = cp * y2 - 1.0 / 3628800.0; cp = cp * y2 + 1.0 / 40320.0; cp = cp * y2 - 1.0 / 720.0; cp = cp * y2 + 1.0 / 24.0; cp = cp * y2 - 0.5; cp = cp * y2 + 1.0;
    const int qi = ((int)q) & 3;
    const double s = (qi == 0) ? sn : (qi == 1) ? cp : (qi == 2) ? -sn : -cp;
    const double c = (qi == 0) ? cp : (qi == 1) ? -sn : (qi == 2) ? -cp : sn;
    tab[pos * 32 + i] = (float)c; tab[pos * 32 + 16 + i] = (float)s;
}
DI void cache_cum_group(const float* lf, float* clc, float* ctt, int g, int lane) {
    f32x4 v = ((const f32x4*)(lf + (size_t)g * 256))[lane];
#pragma unroll
    for (int off = 2; off < 64; off <<= 1) {
        f32x4 t; t.x = __shfl_up(v.x, off); t.y = __shfl_up(v.y, off); t.z = __shfl_up(v.z, off); t.w = __shfl_up(v.w, off);
        if (lane >= off) v = v + t;
    }
    ((f32x4*)(clc + (size_t)g * 256))[lane] = v;
    if (lane >= 62) *(f32x4*)(ctt + (size_t)g * 8 + 4 * (lane & 1)) = v;
}
DI float log_sigmoid(float z) { return fminf(z, 0.f) - log1pf(expf(-fabsf(z))); }

DI void p2_group(const Params& p, int gi, int lane) {
    unsigned char* ws = p.ws;
    const bf16_t* projc = (const bf16_t*)(ws + WS_PROJC);
    bf16_t* cqn = (bf16_t*)(ws + WS_CQN); bf16_t* latn = (bf16_t*)(ws + WS_LATN); bf16_t* krb = (bf16_t*)(ws + WS_KR);
    const float* rope = (const float*)(ws + WS_ROPE); float* LC = (float*)(ws + WS_LC); float* TT = (float*)(ws + WS_TT);
    const float* qn = p.in[11]; const float* kvn = p.in[13]; const float* bfg = p.in[10];
    const int row0 = gi * 32, nrows = (gi == NGRP - 1) ? 16 : 32;
    f32x4 g0a, g0b, g1a, g1b;
    if (lane < 32) { g0a = *(const f32x4*)(kvn + 8 * lane); g0b = *(const f32x4*)(kvn + 8 * lane + 4); }
    else { g0a = *(const f32x4*)(qn + 8 * (lane - 32)); g0b = *(const f32x4*)(qn + 8 * (lane - 32) + 4); }
    if (lane < 16) { g1a = *(const f32x4*)(qn + 256 + 8 * lane); g1b = *(const f32x4*)(qn + 256 + 8 * lane + 4); } else { g1a = (f32x4){0, 0, 0, 0}; g1b = g1a; }
    const float bfl = bfg[lane & 7];
    float run1 = 0.f;
#pragma unroll 1
    for (int rr0 = 0; rr0 < nrows; rr0 += 4) {
      u32x4 w0s[4], w1s[4];
#pragma unroll
      for (int k = 0; k < 4; ++k) { const bf16_t* pr = projc + (size_t)(row0 + rr0 + k) * 768;
          w0s[k] = *(const u32x4*)(pr + 8 * lane); w1s[k] = (u32x4){0, 0, 0, 0}; if (lane < 32) w1s[k] = *(const u32x4*)(pr + 512 + 8 * lane); }
#pragma unroll
      for (int k = 0; k < 4; ++k) {
        const int row = row0 + rr0 + k;
        const u32x4 w0 = w0s[k], w1 = w1s[k];
        float a[8], b[8];
#pragma unroll
        for (int i = 0; i < 4; ++i) { a[2 * i] = __uint_as_float(w0[i] << 16); a[2 * i + 1] = __uint_as_float(w0[i] & 0xffff0000u);
                                      b[2 * i] = __uint_as_float(w1[i] << 16); b[2 * i + 1] = __uint_as_float(w1[i] & 0xffff0000u); }
        float sa = 0.f, sb = 0.f;
#pragma unroll
        for (int i = 0; i < 8; ++i) { sa += a[i] * a[i]; sb += b[i] * b[i]; }
        float skv = (lane < 32) ? sa : 0.f, sq = ((lane >= 32) ? sa : 0.f) + ((lane < 16) ? sb : 0.f);
        skv = wave_sum(skv); sq = wave_sum(sq);
        const float rkv = 1.0f / sqrtf(skv * (1.0f / 256.0f) + EPS), rq = 1.0f / sqrtf(sq * (1.0f / 384.0f) + EPS);
        const float r0 = (lane < 32) ? rkv : rq;
        f32x4 y0 = (f32x4){a[0], a[1], a[2], a[3]} * r0 * g0a, y1 = (f32x4){a[4], a[5], a[6], a[7]} * r0 * g0b;
        if (lane < 32) { *(u32x4*)(latn + (size_t)row * 256 + 8 * lane) = pack8(y0, y1);
            out_store8(p.out + O_LATP, p.out + O_LATS, 256, row, 8 * lane, y0, y1); }
        else { *(u32x4*)(cqn + (size_t)row * 384 + 8 * (lane - 32)) = pack8(y0, y1); }
        if (lane < 16) { f32x4 z0 = (f32x4){b[0], b[1], b[2], b[3]} * rq * g1a, z1 = (f32x4){b[4], b[5], b[6], b[7]} * rq * g1b;
            *(u32x4*)(cqn + (size_t)row * 384 + 256 + 8 * lane) = pack8(z0, z1); }
        float ob[8];
#pragma unroll
        for (int i = 0; i < 8; ++i) ob[i] = __shfl_xor(b[i], 2);
        if (lane >= 16 && lane < 20) {
            const int pos = row_pos(row); const bool first = lane < 18; const int j0 = 8 * (lane - (first ? 16 : 18));
            const float* t = rope + (size_t)pos * 32 + j0;
            const f32x4 c0 = *(const f32x4*)t, c1 = *(const f32x4*)(t + 4), s0 = *(const f32x4*)(t + 16), s1 = *(const f32x4*)(t + 20);
            float cc[8] = {c0.x, c0.y, c0.z, c0.w, c1.x, c1.y, c1.z, c1.w}, ss[8] = {s0.x, s0.y, s0.z, s0.w, s1.x, s1.y, s1.z, s1.w};
            float o[8];
#pragma unroll
            for (int i = 0; i < 8; ++i) o[i] = first ? (b[i] * cc[i] - ob[i] * ss[i]) : (b[i] * cc[i] + ob[i] * ss[i]);
            const f32x4 o0 = (f32x4){o[0], o[1], o[2], o[3]}, o1 = (f32x4){o[4], o[5], o[6], o[7]};
            *(u32x4*)(krb + (size_t)row * 32 + 8 * (lane - 16)) = pack8(o0, o1);
            out_store8(p.out + O_KRP, p.out + O_KRS, 32, row, 8 * (lane - 16), o0, o1);
        }
        {
            float z = 0.f;
#pragma unroll
            for (int i = 0; i < 8; ++i) { const float t = __shfl(b[i], 20); if ((lane & 7) == i) z = t; }
            const float lf = log_sigmoid(z + bfl);
            run1 += lf;
            if (lane < 8) {
                LC[(size_t)row * 8 + lane] = run1;
                if (row < RS0) { const int bb = row >> 13, t = row & 8191; p.out[O_LFP + (size_t)(bb * LP + NMETA + t) * 8 + lane] = lf; }
                else if (row < RM0) { p.out[O_LFS + (size_t)(row - RS0) * 8 + lane] = lf; }
                else { const int m = row - RM0;
#pragma unroll 1
                    for (int bb = 0; bb < NB; ++bb) p.out[O_LFP + (size_t)(bb * LP + m) * 8 + lane] = lf; }
            }
        }
      }
    }
    if (lane < 8) TT[(size_t)gi * 8 + lane] = run1;
}

template <int DK> struct ACfg { static constexpr int NK = (DK == 64) ? 5 : 6, KP = (DK == 64) ? 176 : 208; };
constexpr int VP = 192;
constexpr float THR = 8.0f;
#define MFMA32(a, b, c) __builtin_amdgcn_mfma_f32_32x32x16_bf16((a), (b), (c), 0, 0, 0)
DI int crow(int r, int hi) { return (r & 3) + 8 * (r >> 2) + 4 * hi; }
DI s16x4 vtr(const LAS unsigned char* p) { return __builtin_bit_cast(s16x4, __builtin_amdgcn_ds_read_tr16_b64_v4i16((LAS v4i16_t*)p)); }
DI float bf16_round(float x) { return __uint_as_float(pk2(x, 0.f) << 16); }
DI u32x4 bias_chunk(float bv) {
    const unsigned h = pk2(bv, 0.f) & 0xffffu; const float r1 = bv - __uint_as_float(h << 16);
    const unsigned m = pk2(r1, 0.f) & 0xffffu; const float r2 = r1 - __uint_as_float(m << 16);
    const unsigned l = pk2(r2, 0.f) & 0xffffu;
    return (u32x4){0x3F80u | (h << 16), m | (l << 16), 0u, 0u};
}
DI void rope_qfrag(bf16x8& x1, bf16x8& x2, const float* t) {
    const f32x4 c0 = *(const f32x4*)t, c1 = *(const f32x4*)(t + 4), s0 = *(const f32x4*)(t + 16), s1 = *(const f32x4*)(t + 20);
    const float cc[8] = {c0.x, c0.y, c0.z, c0.w, c1.x, c1.y, c1.z, c1.w}, ss[8] = {s0.x, s0.y, s0.z, s0.w, s1.x, s1.y, s1.z, s1.w};
    float o1[8], o2[8];
#pragma unroll
    for (int i = 0; i < 8; ++i) { const float a = bf2f((unsigned short)x1[i]), b = bf2f((unsigned short)x2[i]); o1[i] = a * cc[i] - b * ss[i]; o2[i] = b * cc[i] + a * ss[i]; }
    const u32x4 w1 = (u32x4){pk2(o1[0], o1[1]), pk2(o1[2], o1[3]), pk2(o1[4], o1[5]), pk2(o1[6], o1[7])};
    const u32x4 w2 = (u32x4){pk2(o2[0], o2[1]), pk2(o2[2], o2[3]), pk2(o2[4], o2[5]), pk2(o2[6], o2[7])};
    x1 = __builtin_bit_cast(bf16x8, w1); x2 = __builtin_bit_cast(bf16x8, w2);
}
template <int DK, bool FOX>
DI void load_qfrags(const Params& p, int qrow0  , int r32, int h, int hi, bf16x8 (&qf)[DK / 16 + 1]) {
    unsigned char* ws = p.ws;
    const char* qb_ = FOX ? (const char*)((const bf16_t*)(ws + WS_FQ) + (size_t)qrow0 * 512 + h * 64) : (const char*)((const bf16_t*)(ws + WS_QMLA) + (size_t)qrow0 * 768 + h * 96);
    const unsigned qo = (unsigned)(r32 * (FOX ? 512 : 768) + 8 * hi) * 2u;
#pragma unroll
    for (int d0 = 0; d0 < DK / 16; ++d0) qf[d0] = *(const bf16x8*)(qb_ + qo + 32 * d0);
    if (!FOX) { const char* rt_ = (const char*)((const float*)(ws + WS_ROPE) + (size_t)row_pos(qrow0) * 32); rope_qfrag(qf[DK / 16 - 2], qf[DK / 16 - 1], (const float*)(rt_ + (unsigned)(r32 * 32 + 8 * hi) * 4u)); }
    const u32x4 ex = hi == 0 ? (u32x4){0x3F800000u, 0x3F803F80u, 0u, 0u} : (u32x4){0u, 0u, 0u, 0u};
    qf[DK / 16] = __builtin_bit_cast(bf16x8, ex);
}
template <int DK, int NKB>
DI void attn_qk(const LAS unsigned char* Kb, const bf16x8 (&qf)[DK / 16 + 1], f32x16 (&s)[NKB], int lane, const f32x16& negm) {
    constexpr int NK = ACfg<DK>::NK, KP = ACfg<DK>::KP;
    const LAS unsigned char* kp = Kb + (lane & 31) * KP + (lane >> 5) * 16;
    f32x16 z;
#pragma unroll
    for (int r = 0; r < 16; ++r) z[r] = (DK == 64) ? 0.f : negm[r];
#pragma unroll
    for (int d0 = 0; d0 < NK; ++d0)
#pragma unroll
        for (int blk = 0; blk < NKB; ++blk) {
            const bf16x8 kf = *(const LAS bf16x8*)(kp + blk * 32 * KP + d0 * 32);
            s[blk] = MFMA32(kf, qf[d0], d0 == 0 ? z : s[blk]);
        }
}
template <int NKB, bool CINIT>
DI void attn_sm_a(f32x16 (&s)[NKB], f32x16 (&o)[2], float& rref, float& l, bf16x8& qfx, bool first, int maskmode, int mparam, int lane, float& rmin, f32x16& negm) {
    const int r32 = lane & 31, hi = lane >> 5;
    if (CINIT && maskmode == 1) {
#pragma unroll
        for (int blk = 0; blk < NKB; ++blk)
#pragma unroll
            for (int r = 0; r < 16; ++r) if (blk * 32 + crow(r, hi) < 48) s[blk][r] = NEGF;
    }
    if (maskmode == 2) {
        const int lim = mparam + r32;
#pragma unroll
        for (int blk = 0; blk < NKB; ++blk)
#pragma unroll
            for (int r = 0; r < 16; ++r) if (blk * 32 + crow(r, hi) > lim) s[blk][r] = NEGF;
    }
    float mx = s[0][0];
#pragma unroll
    for (int blk = 0; blk < NKB; ++blk)
#pragma unroll
        for (int r = 0; r < 16; ++r) mx = fmaxf(mx, s[blk][r]);
    mx = fmaxf(mx, __shfl_xor(mx, 32));
    const bool need = first || (mx > THR);
    if (__any(need)) {
        const float rn = need ? bf16_round(rref + mx) : rref;
        const float d = rn - rref; rref = rn;
#pragma unroll
        for (int blk = 0; blk < NKB; ++blk)
#pragma unroll
            for (int r = 0; r < 16; ++r) s[blk][r] -= d;
        const float f = __builtin_amdgcn_exp2f(-d);
        l *= f;
#pragma unroll
        for (int dd = 0; dd < 2; ++dd)
#pragma unroll
            for (int r = 0; r < 16; ++r) o[dd][r] *= f;
        if (CINIT) {
#pragma unroll
            for (int r = 0; r < 16; ++r) negm[r] = -rref;
        } else if (hi == 0) qfx[0] = (short)(pk2(-rref, 0.f) & 0xffffu);
        float mn = rref;
#pragma unroll
        for (int off = 1; off < 64; off <<= 1) mn = fminf(mn, __shfl_xor(mn, off));
        rmin = mn;
    }
}
template <int NKB>
DI void attn_sm_b(f32x16 (&s)[NKB], float& l, bf16x8 (&pf)[NKB][2]) {
    float ls = 0.f;
#pragma unroll
    for (int blk = 0; blk < NKB; ++blk)
#pragma unroll
        for (int r = 0; r < 16; ++r) { s[blk][r] = __builtin_amdgcn_exp2f(s[blk][r]); ls += s[blk][r]; }
    l += ls;
#pragma unroll
    for (int blk = 0; blk < NKB; ++blk)
#pragma unroll
        for (int s2 = 0; s2 < 2; ++s2) {
            const u32x4 w = (u32x4){pk2(s[blk][8 * s2 + 0], s[blk][8 * s2 + 1]), pk2(s[blk][8 * s2 + 2], s[blk][8 * s2 + 3]),
                                    pk2(s[blk][8 * s2 + 4], s[blk][8 * s2 + 5]), pk2(s[blk][8 * s2 + 6], s[blk][8 * s2 + 7])};
            pf[blk][s2] = __builtin_bit_cast(bf16x8, w);
        }
}
template <int NKB>
DI void attn_pv(const LAS unsigned char* Vb, const bf16x8 (&pf)[NKB][2], f32x16 (&o)[2], int lane) {
    const int hi = lane >> 5, q4 = (lane & 15) >> 2, p4 = lane & 3, gb = (lane >> 4) & 1;
    const LAS unsigned char* vp = Vb + (4 * hi + q4) * VP + 32 * gb + 8 * p4;
#pragma unroll
    for (int blk = 0; blk < NKB; ++blk)
#pragma unroll
        for (int s2 = 0; s2 < 2; ++s2)
#pragma unroll
            for (int d = 0; d < 2; ++d) {
                const LAS unsigned char* a = vp + (blk * 32 + 16 * s2) * VP + d * 64;
                const s16x4 lo = vtr(a), hi4 = vtr(a + 8 * VP);
                const bf16x8 vf = __builtin_shufflevector(lo, hi4, 0, 1, 2, 3, 4, 5, 6, 7);
                o[d] = MFMA32(vf, pf[blk][s2], o[d]);
            }
}
template <int NKB>
DI void attn_sm_pv(f32x16 (&s)[NKB], float& l, const LAS unsigned char* Vb, f32x16 (&o)[2], int lane) {
    const int hi = lane >> 5, q4 = (lane & 15) >> 2, p4 = lane & 3, gb = (lane >> 4) & 1;
    const LAS unsigned char* vp = Vb + (4 * hi + q4) * VP + 32 * gb + 8 * p4;
    float ls0 = 0.f, ls1 = 0.f;
#pragma unroll
    for (int blk = 0; blk < NKB; ++blk) {
#pragma unroll
        for (int r = 0; r < 16; r += 2) { s[blk][r] = __builtin_amdgcn_exp2f(s[blk][r]); s[blk][r + 1] = __builtin_amdgcn_exp2f(s[blk][r + 1]); ls0 += s[blk][r]; ls1 += s[blk][r + 1]; }
#pragma unroll
        for (int s2 = 0; s2 < 2; ++s2) {
            const u32x4 w = (u32x4){pk2(s[blk][8 * s2 + 0], s[blk][8 * s2 + 1]), pk2(s[blk][8 * s2 + 2], s[blk][8 * s2 + 3]),
                                    pk2(s[blk][8 * s2 + 4], s[blk][8 * s2 + 5]), pk2(s[blk][8 * s2 + 6], s[blk][8 * s2 + 7])};
            const bf16x8 pfr = __builtin_bit_cast(bf16x8, w);
#pragma unroll
            for (int d = 0; d < 2; ++d) {
                const LAS unsigned char* a = vp + (blk * 32 + 16 * s2) * VP + d * 64;
                const s16x4 lo = vtr(a), hi4 = vtr(a + 8 * VP);
                const bf16x8 vf = __builtin_shufflevector(lo, hi4, 0, 1, 2, 3, 4, 5, 6, 7);
                o[d] = MFMA32(vf, pfr, o[d]);
            }
        }
    }
    l += ls0 + ls1;
}
DI void attn_store_o(bf16_t* orow, const f32x16 (&o)[2], float l, int hi) {
    l = l + __shfl_xor(l, 32);
    const float inv = 1.0f / l;
#pragma unroll
    for (int d = 0; d < 2; ++d)
#pragma unroll
        for (int g = 0; g < 4; ++g)
            *(u32x2*)(orow + d * 32 + 8 * g + 4 * hi) = (u32x2){pk2(o[d][4 * g] * inv, o[d][4 * g + 1] * inv), pk2(o[d][4 * g + 2] * inv, o[d][4 * g + 3] * inv)};
}

constexpr int A_K0 = 0, A_KSZ = 2 * 15360, A_V0 = 2 * A_KSZ, A_VSZ = 2 * 64 * VP, A_TP = A_V0 + 2 * A_VSZ, A_CBN = A_TP + 1024, A_FLG = A_CBN + 64;
template <bool FOX>
DI void attn_prompt_unit(const Params& p, LAS unsigned char* lds, int b, int h, int qb) {
    constexpr int DK = FOX ? 64 : 96, CPR = DK / 8, NK = ACfg<DK>::NK, KP = ACfg<DK>::KP;
    unsigned char* ws = p.ws;
    int tid_o = threadIdx.x; asm volatile("" : "+v"(tid_o));
    const int tid = tid_o, lane = tid & 63, wid = __builtin_amdgcn_readfirstlane(tid >> 6), r32 = lane & 31, hi = lane >> 5;
    const bf16_t* kh = (const bf16_t*)(ws + (FOX ? WS_FKH : WS_KNH)) + (size_t)h * RT * 64; const bf16_t* vh = (const bf16_t*)(ws + (FOX ? WS_FVH : WS_VMH)) + (size_t)h * RT * 64;
    const bf16_t* krb = (const bf16_t*)(ws + WS_KR); const float* LC = (const float*)(ws + WS_LC); const float* TT = (const float*)(ws + WS_TT);
    bf16_t* mixed = (bf16_t*)(ws + WS_MIXED);
    LAS float* TPs = (LAS float*)(lds + A_TP);
    __syncthreads();
    if (FOX && wid == 0) {
        float t[4];
#pragma unroll
        for (int i = 0; i < 4; ++i) t[i] = TT[(size_t)(b * 256 + 4 * lane + i) * 8 + h];
        float e[4]; e[0] = 0.f; e[1] = t[0]; e[2] = t[0] + t[1]; e[3] = e[2] + t[2]; const float tot = e[3] + t[3];
        float inc = tot;
#pragma unroll
        for (int off = 1; off < 64; off <<= 1) { const float v = __shfl_up(inc, off); if (lane >= off) inc += v; }
        const float ex = inc - tot;
#pragma unroll
        for (int i = 0; i < 4; ++i) TPs[4 * lane + i] = ex + e[i];
    }
    __syncthreads();
    const float ref = FOX ? TPs[8 * qb] : 0.f;
    const float tpmeta = FOX ? -TT[(size_t)(NGRP - 1) * 8 + h] : 0.f;
    const int qrow = b * SEQ + 256 * qb + 32 * wid + r32;
    bf16x8 qf[DK / 16 + 1];
    f32x16 o[2];
#pragma unroll
    for (int r = 0; r < 16; ++r) { o[0][r] = 0.f; o[1][r] = 0.f; }
    float rref = 0.f, l = 0.f, rmin = 0.f, qkb = 0.f;
    f32x16 negm;
#pragma unroll
    for (int r = 0; r < 16; ++r) negm[r] = 0.f;
    LAS float* CBN = (LAS float*)(lds + A_CBN); LAS int* FLG = (LAS int*)(lds + A_FLG);
    bool done = false;
    const int ktmax = 4 * qb + 3, mykt = 4 * qb + (wid >> 1);
    const int vj = tid >> 3, vp = tid & 7, rj = tid >> 2, rp = tid & 3;
    u32x4 rk0_0, rk0_1, rk1_0 = (u32x4){0, 0, 0, 0}, rk1_1 = (u32x4){0, 0, 0, 0}, rv_0, rv_1; float rb_0 = 0.f, rb_1 = 0.f;
#define TROW0(kt) ((kt) < 0 ? RM0 : b * SEQ + 64 * (kt))
#define JOFF(kt, j) ((kt) < 0 ? ((j) >= 48 ? (j) - 48 : 0) : (j))
#define LOADKV(kt, U) do { const int r0_ = TROW0(kt); \
        { const unsigned of_ = (unsigned)(JOFF(kt, vj) * 64 + vp * 8) * 2u; \
          rk0_##U = *(const u32x4*)((const char*)(kh + (size_t)r0_ * 64) + of_); rv_##U = *(const u32x4*)((const char*)(vh + (size_t)r0_ * 64) + of_); } \
        if (!FOX) { \
               if (tid < 256) { const char* rb_ = (const char*)(krb + (size_t)r0_ * 32); rk1_##U = *(const u32x4*)(rb_ + (unsigned)(JOFF(kt, rj) * 32 + rp * 8) * 2u); } } \
        if (tid < 64) { rb_##U = 0.f; \
          if (FOX) { const float tp = (kt) < 0 ? tpmeta : TPs[2 * (kt) + (tid >> 5)]; rb_##U = -(*(const float*)((const char*)(LC + (size_t)r0_ * 8 + h) + (unsigned)JOFF(kt, tid) * 32u) + tp - ref) * LOG2E; } \
          if ((kt) < 0 && tid < 48) rb_##U = NEGF; } \
    } while (0)
#define STOREKV(slot, U) do { LAS unsigned char* B_ = lds + A_K0 + (slot) * A_KSZ + (U) * 64 * KP; \
        *(LAS u32x4*)(B_ + vj * KP + vp * 16) = rk0_##U; \
        if (!FOX && tid < 256) *(LAS u32x4*)(B_ + rj * KP + (8 + rp) * 16) = rk1_##U; \
        if (FOX && tid < 64) { *(LAS u32x4*)(B_ + tid * KP + DK * 2) = bias_chunk(rb_##U); *(LAS u32x4*)(B_ + tid * KP + DK * 2 + 16) = (u32x4){0u, 0u, 0u, 0u}; } \
        *(LAS u32x4*)(lds + A_V0 + (slot) * A_VSZ + (U) * 64 * VP + vj * VP + vp * 16) = rv_##U; \
        if (FOX && tid == 63) CBN[(slot) * 2 + (U)] = rb_##U; \
    } while (0)
#define COMPUTE(kt, slot, U) do { \
        if (FOX && !first && !done && CBN[(slot) * 2 + (U)] + qkb - rmin < -130.0f) done = true;     \
        if ((kt) <= mykt && !done) { \
            const int mm = (FOX && (kt) == mykt) ? 2 : ((!FOX && (kt) < 0) ? 1 : 0); \
            attn_qk<DK, 2>(lds + A_K0 + (slot) * A_KSZ + (U) * 64 * KP, qf, sA, lane, negm); \
            attn_sm_a<2, !FOX>(sA, o, rref, l, qf[DK / 16], first, mm, 32 * (wid & 1), lane, rmin, negm); \
            first = false; \
            attn_sm_pv<2>(sA, l, lds + A_V0 + (slot) * A_VSZ + (U) * 64 * VP, o, lane); } } while (0)
    const int Smax = 2 * qb + 1;
    LOADKV(2 * Smax + 1, 0); LOADKV(2 * Smax, 1);
    load_qfrags<DK, FOX>(p, b * SEQ + 256 * qb + 32 * wid, r32, h, hi, qf);
    if (FOX) {
        float a = 0.f, c = 0.f;
#pragma unroll
        for (int i = 0; i < 8; ++i) { const float x0 = bf2f((unsigned short)qf[0][i]), x1 = bf2f((unsigned short)qf[1][i]), x2 = bf2f((unsigned short)qf[2][i]), x3 = bf2f((unsigned short)qf[3][i]);
            a += x0 * x0 + x1 * x1; c += x2 * x2 + x3 * x3; }
        a += __shfl_xor(a, 32); c += __shfl_xor(c, 32);
#pragma unroll
        for (int off = 1; off < 32; off <<= 1) { a = fmaxf(a, __shfl_xor(a, off)); c = fmaxf(c, __shfl_xor(c, off)); }
        const unsigned* kn2 = (const unsigned*)(ws + WS_KINF) + 2 * h;
        qkb = 1.02f * (sqrtf(a * __uint_as_float(kn2[0])) + sqrtf(c * __uint_as_float(kn2[1])));
    }
    STOREKV(Smax & 1, 0); STOREKV(Smax & 1, 1);
    __syncthreads();
    f32x16 sA[2];
    bool first = true;
    if (wid >= 4) __builtin_amdgcn_s_setprio(1);
#pragma unroll 1
    for (int S = Smax; S >= -1; --S) {
        const int slot = S & 1;
        if (S >= 1) { LOADKV(2 * S - 1, 0); LOADKV(2 * S - 2, 1); } else if (S == 0) { LOADKV(-1, 0); }
        if (S >= 0) { COMPUTE(2 * S + 1, slot, 0); COMPUTE(2 * S, slot, 1); } else { COMPUTE(-1, slot, 0); }
        if (S >= 1) { STOREKV(slot ^ 1, 0); STOREKV(slot ^ 1, 1); } else if (S == 0) { STOREKV(slot ^ 1, 0); }
        if (FOX && lane == 0) FLG[slot * 8 + wid] = done ? 1 : 0;
        __syncthreads();
        if (FOX) { const i32x4 f0 = *(const LAS i32x4*)(FLG + slot * 8), f1 = *(const LAS i32x4*)(FLG + slot * 8 + 4);
            if ((f0.x & f0.y & f0.z & f0.w & f1.x & f1.y & f1.z & f1.w) != 0) break; }
    }
    __builtin_amdgcn_s_setprio(0);
#undef LOADKV
#undef STOREKV
#undef COMPUTE
#undef TROW0
#undef JOFF
    attn_store_o(mixed + (size_t)qrow * 1024 + (FOX ? 512 : 0) + h * 64, o, l, hi);
}

constexpr int SWB = 14336, S_V = 7680, S_TP = S_V + 32 * VP;
constexpr int M_O = 0, M_ML = 65536;
template <bool FOX>
DI void attn_sample_unit(const Params& p, LAS unsigned char* lds0, int sb, int h) {
    constexpr int DK = FOX ? 64 : 96, CPR = DK / 8, NK = ACfg<DK>::NK, KP = ACfg<DK>::KP, NKC = 32 * CPR / 64;
    unsigned char* ws = p.ws;
    int tid_o = threadIdx.x; asm volatile("" : "+v"(tid_o));
    const int tid = tid_o, lane = tid & 63, wid = __builtin_amdgcn_readfirstlane(tid >> 6), r32 = lane & 31, hi = lane >> 5;
    LAS unsigned char* lds = lds0 + wid * SWB;
    const bf16_t* kh = (const bf16_t*)(ws + (FOX ? WS_FKH : WS_KNH)) + (size_t)h * RT * 64; const bf16_t* vh = (const bf16_t*)(ws + (FOX ? WS_FVH : WS_VMH)) + (size_t)h * RT * 64;
    const bf16_t* knc = (const bf16_t*)(ws + WS_KNC) + (size_t)h * 131072 * 64; const bf16_t* vmc = (const bf16_t*)(ws + WS_VMC) + (size_t)h * 131072 * 64;
    const bf16_t* krb = (const bf16_t*)(ws + WS_KR); const bf16_t* ckr = (const bf16_t*)(ws + WS_CKR);
    const float* LC = (const float*)(ws + WS_LC); const float* CLC = (const float*)(ws + WS_CLC); const float* CTT = (const float*)(ws + WS_CTT);
    const float* cfk = p.in[4]; const float* cfv = p.in[5];
    bf16_t* mixed = (bf16_t*)(ws + WS_MIXED);
    LAS float* TPs = (LAS float*)(lds + S_TP);
    __syncthreads();
    float tall = 0.f;
    if (FOX) {
        const float t0 = CTT[(size_t)(sb * 128 + 2 * lane) * 8 + h], t1 = CTT[(size_t)(sb * 128 + 2 * lane + 1) * 8 + h];
        const float tot = t0 + t1; float inc = tot;
#pragma unroll
        for (int off = 1; off < 64; off <<= 1) { const float v = __shfl_up(inc, off); if (lane >= off) inc += v; }
        const float ex = inc - tot;
        TPs[2 * lane] = ex; TPs[2 * lane + 1] = ex + t0;
        tall = __shfl(inc, 63);
    }
    const int row0 = RS0 + sb * 32, qrow = row0 + r32;
    bf16x8 qf[DK / 16 + 1];
    load_qfrags<DK, FOX>(p, row0, r32, h, hi, qf);
    f32x16 o[2];
#pragma unroll
    for (int r = 0; r < 16; ++r) { o[0][r] = 0.f; o[1][r] = 0.f; }
    float rref = 0.f, l = 0.f, rmin = 0.f;
    f32x16 negm;
#pragma unroll
    for (int r = 0; r < 16; ++r) negm[r] = 0.f;
    f32x16 s1[1];
    bool first = true;
    if (wid == 0) {
        const char* nk_ = (const char*)(kh + (size_t)row0 * 64); const char* nv_ = (const char*)(vh + (size_t)row0 * 64);
#pragma unroll
        for (int i = 0; i < 4; ++i) { const unsigned off = (unsigned)(((lane >> 3) + 8 * i) * 64 + (lane & 7) * 8) * 2u;
            *(LAS u32x4*)(lds + (lane >> 3) * KP + (lane & 7) * 16 + i * 8 * KP) = *(const u32x4*)(nk_ + off); *(LAS u32x4*)(lds + S_V + (lane >> 3) * VP + (lane & 7) * 16 + i * 8 * VP) = *(const u32x4*)(nv_ + off); }
        if (!FOX) { const char* nr_ = (const char*)(krb + (size_t)row0 * 32);
#pragma unroll
            for (int i = 0; i < 2; ++i) *(LAS u32x4*)(lds + (lane >> 2) * KP + (8 + (lane & 3)) * 16 + i * 16 * KP) = *(const u32x4*)(nr_ + (unsigned)((lane >> 2) * 32 + (lane & 3) * 8) * 2u + i * 16 * 64); }
        if (FOX && lane < 32) { const float bv = FOX ? -(*(const float*)((const char*)(LC + (size_t)row0 * 8 + h) + (unsigned)lane * 32u)) * LOG2E : 0.f;
            *(LAS u32x4*)(lds + lane * KP + DK * 2) = bias_chunk(bv); *(LAS u32x4*)(lds + lane * KP + DK * 2 + 16) = (u32x4){0u, 0u, 0u, 0u}; }
        asm volatile("s_waitcnt lgkmcnt(0)" ::: "memory");
        attn_qk<DK, 1>(lds, qf, s1, lane, negm);
        attn_sm_a<1, !FOX>(s1, o, rref, l, qf[DK / 16], true, FOX ? 2 : 0, 0, lane, rmin, negm);
        attn_sm_pv<1>(s1, l, lds + S_V, o, lane);
        first = false;
    }
    const size_t crow0 = (size_t)sb * PAST;
    const unsigned ldk0 = (lane >> 3) * KP + (lane & 7) * 16, ldv0 = S_V + (lane >> 3) * VP + (lane & 7) * 16;
    const unsigned so0 = FOX ? (unsigned)((lane >> 3) * 512 + h * 64 + (lane & 7) * 8) * 4u : (unsigned)((lane >> 3) * 64 + (lane & 7) * 8) * 2u;
    constexpr unsigned SROW8 = FOX ? 8u * 512u * 4u : 8u * 64u * 2u;
    if (FOX) {
        f32x4 rk[4][2], rv[4][2]; float rc = 0.f;
#define LOADC(tt) do { const char* kb_ = (const char*)(cfk + (crow0 + 32 * (tt)) * 512); const char* vb_ = (const char*)(cfv + (crow0 + 32 * (tt)) * 512); \
            _Pragma("unroll") for (int i = 0; i < 4; ++i) { const unsigned so_ = so0 + i * SROW8; rk[i][0] = *(const f32x4*)(kb_ + so_); rk[i][1] = *(const f32x4*)(kb_ + so_ + 16); rv[i][0] = *(const f32x4*)(vb_ + so_); rv[i][1] = *(const f32x4*)(vb_ + so_ + 16); } \
            if (lane < 32) rc = *(const float*)((const char*)(CLC + (crow0 + 32 * (tt)) * 8 + h) + (unsigned)lane * 32u); } while (0)
        LOADC(127 - wid);
#pragma unroll 1
        for (int t = 127 - wid; t >= 0; t -= 8) {
#if 0
            for (int i = 0; i < 4; ++i) { const unsigned so_ = so0 + i * SROW8; rk[i][0] = *(const f32x4*)(kb_ + so_); rk[i][1] = *(const f32x4*)(kb_ + so_ + 16); rv[i][0] = *(const f32x4*)(vb_ + so_); rv[i][1] = *(const f32x4*)(vb_ + so_ + 16); }
#endif
#pragma unroll
            for (int i = 0; i < 4; ++i) { *(LAS u32x4*)(lds + ldk0 + i * 8 * KP) = pack8(rk[i][0], rk[i][1]); *(LAS u32x4*)(lds + ldv0 + i * 8 * VP) = pack8(rv[i][0], rv[i][1]); }
            if (lane < 32) { *(LAS u32x4*)(lds + lane * KP + DK * 2) = bias_chunk(-(rc + TPs[t] - tall) * LOG2E); *(LAS u32x4*)(lds + lane * KP + DK * 2 + 16) = (u32x4){0u, 0u, 0u, 0u}; }
            if (t >= 8) LOADC(t - 8);
            asm volatile("s_waitcnt lgkmcnt(0)" ::: "memory");
            attn_qk<DK, 1>(lds, qf, s1, lane, negm);
            attn_sm_a<1, !FOX>(s1, o, rref, l, qf[DK / 16], first, 0, 0, lane, rmin, negm);
            attn_sm_pv<1>(s1, l, lds + S_V, o, lane);
            first = false;
        }
#undef LOADC
    } else {
        const unsigned ro0 = (unsigned)((lane >> 2) * 32 + (lane & 3) * 8) * 2u, rld0 = (lane >> 2) * KP + (8 + (lane & 3)) * 16;
        u32x4 rk[4], rr[2], rv[4];
#define LOADC(tt) do { const char* kb_ = (const char*)(knc + (crow0 + 32 * (tt)) * 64); const char* vb_ = (const char*)(vmc + (crow0 + 32 * (tt)) * 64); const char* rb_ = (const char*)(ckr + (crow0 + 32 * (tt)) * 32); \
            _Pragma("unroll") for (int i = 0; i < 4; ++i) { const unsigned so_ = so0 + i * SROW8; rk[i] = *(const u32x4*)(kb_ + so_); rv[i] = *(const u32x4*)(vb_ + so_); } \
            _Pragma("unroll") for (int i = 0; i < 2; ++i) rr[i] = *(const u32x4*)(rb_ + ro0 + i * 16 * 64); } while (0)
        LOADC(127 - wid);
#pragma unroll 1
        for (int t = 127 - wid; t >= 0; t -= 8) {
#pragma unroll
            for (int i = 0; i < 4; ++i) { *(LAS u32x4*)(lds + ldk0 + i * 8 * KP) = rk[i]; *(LAS u32x4*)(lds + ldv0 + i * 8 * VP) = rv[i]; }
#pragma unroll
            for (int i = 0; i < 2; ++i) *(LAS u32x4*)(lds + rld0 + i * 16 * KP) = rr[i];
            if (t >= 8) LOADC(t - 8);
            asm volatile("s_waitcnt lgkmcnt(0)" ::: "memory");
            attn_qk<DK, 1>(lds, qf, s1, lane, negm);
            attn_sm_a<1, !FOX>(s1, o, rref, l, qf[DK / 16], first, 0, 0, lane, rmin, negm);
            attn_sm_pv<1>(s1, l, lds + S_V, o, lane);
            first = false;
        }
#undef LOADC
    }
    l = l + __shfl_xor(l, 32);
    __syncthreads();
    {
        LAS float* MO = (LAS float*)(lds0 + M_O) + (size_t)(wid * 32 + r32) * 64; LAS float* ML = (LAS float*)(lds0 + M_ML) + (wid * 32 + r32) * 2;
#pragma unroll
        for (int d = 0; d < 2; ++d)
#pragma unroll
            for (int g = 0; g < 4; ++g) *(LAS f32x4*)(MO + d * 32 + 8 * g + 4 * hi) = (f32x4){o[d][4 * g], o[d][4 * g + 1], o[d][4 * g + 2], o[d][4 * g + 3]};
        if (hi == 0) { ML[0] = rref; ML[1] = l; }
    }
    __syncthreads();
    {
        const int q = tid >> 4, c4 = (tid & 15) * 4;
        const LAS float* ML = (const LAS float*)(lds0 + M_ML) + q * 2; const LAS float* MO = (const LAS float*)(lds0 + M_O) + q * 64 + c4;
        float M = ML[0];
#pragma unroll
        for (int w = 1; w < 8; ++w) M = fmaxf(M, ML[w * 64]);
        float L = 0.f; f32x4 acc = (f32x4){0.f, 0.f, 0.f, 0.f};
#pragma unroll
        for (int w = 0; w < 8; ++w) { const float f = __builtin_amdgcn_exp2f(ML[w * 64] - M); L += ML[w * 64 + 1] * f; acc = acc + *(const LAS f32x4*)(MO + w * 2048) * f; }
        const float inv = 1.0f / L;
        *(u32x2*)((char*)(mixed + (size_t)row0 * 1024 + (FOX ? 512 : 0) + h * 64) + (unsigned)(q * 1024 + c4) * 2u) = (u32x2){pk2(acc.x * inv, acc.y * inv), pk2(acc.z * inv, acc.w * inv)};
    }
}

constexpr int NPHASE = 10;
__global__ void __launch_bounds__(512, 2) mega_fwd(Params p) {
    extern __shared__ __attribute__((aligned(16))) unsigned char lds_raw[];
    LAS unsigned char* lds = (LAS unsigned char*)lds_raw;
    __builtin_assume(__builtin_amdgcn_workitem_id_y() == 0); __builtin_assume(__builtin_amdgcn_workitem_id_z() == 0);
    cg::grid_group grid = cg::this_grid();
    unsigned char* ws = p.ws;
    const int tid = threadIdx.x, lane = tid & 63, wid = __builtin_amdgcn_readfirstlane(tid >> 6);
    const int G = gridDim.x, gw = blockIdx.x * 8 + wid, NGW = G * 8, gt = blockIdx.x * 512 + tid, NGT = G * 512;
    const int lo = p.ph_lo, hi = p.ph_hi;
#ifdef PH_ONLY
#define IN(k) ((k) == PH_ONLY && lo <= (k) && (k) < hi)
#else
#define IN(k) (lo <= (k) && (k) < hi)
#endif
#define SEAM(k) do { if (IN(k) && IN((k) + 1)) grid.sync(); } while (0)
#define PHASE_IDS() int tid_q = threadIdx.x; asm volatile("" : "+v"(tid_q)); const int lane = tid_q & 63, gt = blockIdx.x * 512 + tid_q; (void)gt; (void)lane

    if (IN(0)) {
        PHASE_IDS();
        LAS float* scr = (LAS float*)(lds + wid * 8448);
        constexpr int I_IN = 16 * 70, I_UQ = 6 * 24, I_UKV = 4 * 32, I_OUT = 16 * 32, I_G = 16 * 88, I_D = 44 * 32;
        constexpr int NITEMS = I_IN + I_UQ + I_UKV + I_OUT + 2 * I_G + I_D;
        for (int it = gw; it < NITEMS; it += NGW) {
            int r = it;
            if (r < I_IN) { p0_transpose_item(p.in[9], 1024, DIN, ((bf16_t*)(ws + WS_WIN)), 1, scr, r, lane); continue; } r -= I_IN;
            if (r < I_UQ) { p0_transpose_item(p.in[12], 384, 768, ((bf16_t*)(ws + WS_WUQ)), 4, scr, r, lane); continue; } r -= I_UQ;
            if (r < I_UKV) { p0_transpose_item(p.in[14], 256, 1024, ((bf16_t*)(ws + WS_WUKV)), 0, scr, r, lane); continue; } r -= I_UKV;
            if (r < I_OUT) { p0_transpose_item(p.in[15], 1024, 1024, ((bf16_t*)(ws + WS_WOUT)), 0, scr, r, lane); continue; } r -= I_OUT;
            if (r < I_G) { p0_transpose_item(p.in[17], 1024, DFF, ((bf16_t*)(ws + WS_WGU)), 2, scr, r, lane, p.in[16]); continue; } r -= I_G;
            if (r < I_G) { p0_transpose_item(p.in[18], 1024, DFF, ((bf16_t*)(ws + WS_WGU)), 3, scr, r, lane, p.in[16]); continue; } r -= I_G;
            p0_transpose_item(p.in[19], DFF, 1024, ((bf16_t*)(ws + WS_WDN)), 0, scr, r, lane);
        }
        if (gt < 16) ((unsigned*)(ws + WS_KINF))[gt] = 0u;
        for (int c = gt; c < RT; c += NGT) { ((float*)(ws + WS_SS1))[c] = 0.f; ((float*)(ws + WS_SS2))[c] = 0.f; }
        for (int c = gt; c < 88 * 128; c += NGT) ((u32x4*)(((bf16_t*)(ws + WS_WIN)) + (size_t)680 * 1024))[c] = (u32x4){0, 0, 0, 0};
        bf16_t* XN = (bf16_t*)(ws + WS_XN);
        for (int r0 = gw; r0 < RT; r0 += 2 * NGW) {
            const int r1 = r0 + NGW;
            const float* xa = x_of_row(p, r0); const float* xb = r1 < RT ? x_of_row(p, r1) : nullptr;
            if (xa && xb) { norm_rows2_to_bf16(xa, xb, p.in[8], XN + (size_t)r0 * DM, XN + (size_t)r1 * DM, lane); continue; }
#pragma unroll 1
            for (int k = 0; k < 2; ++k) { const int r = k ? r1 : r0; if (r >= RT) break; const float* xr = k ? xb : xa;
                if (xr) norm_row_to_bf16(xr, p.in[8], XN + (size_t)r * DM, lane);
                else { ((u32x4*)(XN + (size_t)r * DM))[lane] = (u32x4){0, 0, 0, 0}; ((u32x4*)(XN + (size_t)r * DM))[lane + 64] = (u32x4){0, 0, 0, 0}; } }
        }
        for (int i = gt; i < LP * 16; i += NGT) rope_entry((float*)(ws + WS_ROPE), i);
        { const float* cl = p.in[2]; bf16_t* CLAT = (bf16_t*)(ws + WS_CLAT);
          for (int c = gt; c < 131072 * 32; c += NGT) { const f32x4 a = ((const f32x4*)cl)[2 * (size_t)c], b2 = ((const f32x4*)cl)[2 * (size_t)c + 1]; ((u32x4*)CLAT)[c] = pack8(a, b2); }
          const float* ck = p.in[3]; bf16_t* CKR = (bf16_t*)(ws + WS_CKR);
          for (int c = gt; c < 131072 * 4; c += NGT) { const f32x4 a = ((const f32x4*)ck)[2 * (size_t)c], b2 = ((const f32x4*)ck)[2 * (size_t)c + 1]; ((u32x4*)CKR)[c] = pack8(a, b2); } }
        for (int g = gw; g < 4096; g += NGW) cache_cum_group(p.in[6], (float*)(ws + WS_CLC), (float*)(ws + WS_CTT), g, lane);
    }
    SEAM(0);
    if (IN(1)) {
        { pg8::Gemm g{(const bf16_t*)(ws + WS_XN), ((bf16_t*)(ws + WS_WIN)), RT, 2304, 1024}; pg8::StaticOrder S; S.init(RT, 2304, G, (int)blockIdx.x);
          EpiG1 E{(bf16_t*)(ws + WS_PROJC), (bf16_t*)(ws + WS_FQ), (bf16_t*)(ws + WS_FKH), (bf16_t*)(ws + WS_FVH), p.out, (unsigned*)(ws + WS_KINF)};
          pg8::gemm_phase<EpiG1, pg8::StaticOrder, false, true>(lds, g, S, E); }
        { pg8::Gemm g{(const bf16_t*)(ws + WS_CLAT), ((bf16_t*)(ws + WS_WUKV)), 131072, 1024, 256}; pg8::StaticOrder S; S.init(131072, 1024, G, (int)blockIdx.x);
          EpiKV E{(bf16_t*)(ws + WS_KNC), (bf16_t*)(ws + WS_VMC), (size_t)131072};
          pg8::gemm_phase<EpiKV, pg8::StaticOrder, false, true>(lds, g, S, E); }
    }
    SEAM(1);
    if (IN(2)) { PHASE_IDS(); for (int gi = gw; gi < NGRP; gi += NGW) p2_group(p, gi, lane); }
    SEAM(2);
    if (IN(3)) {
        { pg8::Gemm g{(const bf16_t*)(ws + WS_CQN), ((bf16_t*)(ws + WS_WUQ)), RT, 768, 384}; pg8::StaticOrder S; S.init(RT, 768, G, (int)blockIdx.x);
          EpiBf16 E{(bf16_t*)(ws + WS_QMLA), 768};
          pg8::gemm_phase<EpiBf16, pg8::StaticOrder, false, true>(lds, g, S, E); }
        { pg8::Gemm g{(const bf16_t*)(ws + WS_LATN), ((bf16_t*)(ws + WS_WUKV)), RT, 1024, 256}; pg8::StaticOrder S; S.init(RT, 1024, G, (int)blockIdx.x);
          EpiKV E{(bf16_t*)(ws + WS_KNH), (bf16_t*)(ws + WS_VMH), (size_t)RT};
          pg8::gemm_phase<EpiKV, pg8::StaticOrder, false, true>(lds, g, S, E); }
    }
    SEAM(3);
    if (IN(4)) {
        const int bx = blockIdx.x;
        if (G == 256) {
#pragma unroll 1
            for (int r = 15; r >= 0; --r) {
                if (r == (bx & 15)) {
#pragma unroll 1
                    for (int k = 0; k < 2; ++k) { const int u = 2 * bx + k, sb = u >> 4, h = u & 7;
                        if ((u >> 3) & 1) attn_sample_unit<true>(p, lds, sb, h); else attn_sample_unit<false>(p, lds, sb, h); }
                }
                const int j = r >> 1, type = (r ^ bx) & 1, bh = (bx >> 1) & 63, q4 = (bx & 1) + 2 * (bx >> 7), qb = 4 * j + ((j & 1) ? 3 - q4 : q4);
                if (type) attn_prompt_unit<true>(p, lds, bh >> 3, (bh + j) & 7, qb); else attn_prompt_unit<false>(p, lds, bh >> 3, bh & 7, qb);
            }
        } else {
            for (int su = 2 * bx; su < 512; su += 2 * G) {
#pragma unroll 1
                for (int k = 0; k < 2; ++k) { const int u = su + k, sb = u >> 4, h = u & 7;
                    if ((u >> 3) & 1) attn_sample_unit<true>(p, lds, sb, h); else attn_sample_unit<false>(p, lds, sb, h); }
            }
            for (int ui = bx; ui < 4096; ui += G) {
                const int qb = 31 - (ui >> 7), c = ui & 127, type = c >> 6, b = (c >> 3) & 7, h = c & 7;
                if (type) attn_prompt_unit<true>(p, lds, b, h, qb); else attn_prompt_unit<false>(p, lds, b, h, qb);
            }
        }
    }
    SEAM(4);
    if (IN(5)) {
        pg8::Gemm g{(const bf16_t*)(ws + WS_MIXED), ((bf16_t*)(ws + WS_WOUT)), RT, 1024, 1024}; pg8::StaticOrder S; S.init(RT, 1024, G, (int)blockIdx.x);
        EpiRes E{p.in[0], p.in[1], (bf16_t*)(ws + WS_HN), (float*)(ws + WS_SS1)};
        pg8::gemm_phase<EpiRes, pg8::StaticOrder, true, true>(lds, g, S, E);
    }
    if (IN(5) && IN(7)) grid.sync();
    if (IN(7)) {
        pg8::Gemm g{(const bf16_t*)(ws + WS_HN), ((bf16_t*)(ws + WS_WGU)), RT, 2 * DFF, 1024}; pg8::StaticOrder S; S.init(RT, 2 * DFF, G, (int)blockIdx.x);
        EpiSwiglu E{(bf16_t*)(ws + WS_ACT), (const float*)(ws + WS_SS1)};
        pg8::gemm_phase<EpiSwiglu, pg8::StaticOrder, true, true>(lds, g, S, E);
    }
    SEAM(7);
    if (IN(8)) {
        pg8::Gemm g{(const bf16_t*)(ws + WS_ACT), ((bf16_t*)(ws + WS_WDN)), RS0, 1024, DFF, 0}; pg8::StaticOrder S; S.init(RS0, 1024, G, (int)blockIdx.x);
        EpiAcc E{(bf16_t*)(ws + WS_HN), (float*)(ws + WS_SS2)};
        pg8::gemm_phase<EpiAcc, pg8::StaticOrder, true, true>(lds, g, S, E);
        { pg8::Gemm g2{(const bf16_t*)(ws + WS_ACT), ((bf16_t*)(ws + WS_WDN)), RT, 1024, 256, DFF}; SplitOrder S2{(int)blockIdx.x};
          EpiPart E2{(float*)(ws + WS_XPART)};
          pg8::gemm_phase<EpiPart, SplitOrder, false, true>(lds, g2, S2, E2); }
    }
    SEAM(8);
    if (IN(9)) {
        PHASE_IDS();
        const bf16_t* x2b = (const bf16_t*)(ws + WS_HN); const float* ss2 = (const float*)(ws + WS_SS2); const float* g = p.in[20];
        f32x4 gg[4];
#pragma unroll
        for (int j = 0; j < 4; ++j) gg[j] = ((const f32x4*)g)[4 * lane + j];
        for (int r = RS0 + gw; r < RM0; r += NGW) {
            const u32x4 w0 = ((const u32x4*)(x2b + (size_t)r * DM))[2 * lane], w1 = ((const u32x4*)(x2b + (size_t)r * DM))[2 * lane + 1];
            f32x4 v[4];
            v[0] = (f32x4){__uint_as_float(w0.x << 16), __uint_as_float(w0.x & 0xffff0000u), __uint_as_float(w0.y << 16), __uint_as_float(w0.y & 0xffff0000u)};
            v[1] = (f32x4){__uint_as_float(w0.z << 16), __uint_as_float(w0.z & 0xffff0000u), __uint_as_float(w0.w << 16), __uint_as_float(w0.w & 0xffff0000u)};
            v[2] = (f32x4){__uint_as_float(w1.x << 16), __uint_as_float(w1.x & 0xffff0000u), __uint_as_float(w1.y << 16), __uint_as_float(w1.y & 0xffff0000u)};
            v[3] = (f32x4){__uint_as_float(w1.z << 16), __uint_as_float(w1.z & 0xffff0000u), __uint_as_float(w1.w << 16), __uint_as_float(w1.w & 0xffff0000u)};
            const float* xp = (const float*)(ws + WS_XPART) + (size_t)(r - RS0) * 1024 + 16 * lane;
#pragma unroll 1
            for (int ks = 0; ks < 11; ++ks) {
#pragma unroll
                for (int j = 0; j < 4; ++j) v[j] = v[j] + ((const f32x4*)(xp + (size_t)ks * 1024 * 1024))[j]; }
            float sq = 0.f;
#pragma unroll
            for (int j = 0; j < 4; ++j) sq += (v[j].x * v[j].x + v[j].y * v[j].y) + (v[j].z * v[j].z + v[j].w * v[j].w);
            const float rstd = 1.0f / sqrtf(wave_sum(sq) * (1.0f / DM) + EPS);
            f32x4* o4 = (f32x4*)(p.out + (size_t)r * DM) + 4 * lane;
#pragma unroll
            for (int j = 0; j < 4; ++j) o4[j] = v[j] * rstd * gg[j];
        }
        for (int rb = gw; rb < RS0; rb += 4 * NGW) {
            u32x4 w0[4], w1[4]; float sr[4];
#pragma unroll
            for (int k = 0; k < 4; ++k) { const int r = rb + k * NGW; const u32x4* src = (const u32x4*)(x2b + (size_t)(r < RS0 ? r : rb) * DM); w0[k] = src[2 * lane]; w1[k] = src[2 * lane + 1]; sr[k] = ss2[r < RS0 ? r : rb]; }
#pragma unroll
            for (int k = 0; k < 4; ++k) { const int r = rb + k * NGW; if (r >= RS0) break;
                const float rstd = 1.0f / sqrtf(sr[k] * (1.0f / DM) + EPS);
                f32x4* o4 = (f32x4*)(p.out + (size_t)r * DM) + 4 * lane;
                o4[0] = (f32x4){__uint_as_float(w0[k].x << 16), __uint_as_float(w0[k].x & 0xffff0000u), __uint_as_float(w0[k].y << 16), __uint_as_float(w0[k].y & 0xffff0000u)} * rstd * gg[0];
                o4[1] = (f32x4){__uint_as_float(w0[k].z << 16), __uint_as_float(w0[k].z & 0xffff0000u), __uint_as_float(w0[k].w << 16), __uint_as_float(w0[k].w & 0xffff0000u)} * rstd * gg[1];
                o4[2] = (f32x4){__uint_as_float(w1[k].x << 16), __uint_as_float(w1[k].x & 0xffff0000u), __uint_as_float(w1[k].y << 16), __uint_as_float(w1[k].y & 0xffff0000u)} * rstd * gg[2];
                o4[3] = (f32x4){__uint_as_float(w1[k].z << 16), __uint_as_float(w1[k].z & 0xffff0000u), __uint_as_float(w1[k].w << 16), __uint_as_float(w1[k].w & 0xffff0000u)} * rstd * gg[3];
            }
        }
    }
#undef IN
#undef SEAM
}

#ifndef MK_N_LAUNCHES
#define MK_N_LAUNCHES 1
#endif
extern "C" void kernel_launch(void* const* d_in, const int* in_sizes, int n_in, void* d_out, int out_size, void* d_ws, size_t ws_size, hipStream_t stream) {
    static int grid = 0;
    if (grid == 0) {
        if (n_in != 21 || (size_t)out_size != O_END || ws_size < WS_END) { fprintf(stderr, "kernel_launch: unexpected shapes n_in %d out %d ws %zu (need %zu)\n", n_in, out_size, ws_size, (size_t)WS_END); grid = -1; return; }
        int dev = 0, cus = 0, per_cu = 0;
        hipGetDevice(&dev); hipDeviceGetAttribute(&cus, hipDeviceAttributeMultiprocessorCount, dev);
        if (hipFuncSetAttribute((const void*)mega_fwd, hipFuncAttributeMaxDynamicSharedMemorySize, LDS_BYTES) != hipSuccess) { fprintf(stderr, "kernel_launch: hipFuncSetAttribute failed\n"); grid = -1; return; }
        if (hipOccupancyMaxActiveBlocksPerMultiprocessor(&per_cu, (const void*)mega_fwd, 512, LDS_BYTES) != hipSuccess || per_cu < 1) { fprintf(stderr, "kernel_launch: occupancy query says %d\n", per_cu); per_cu = 1; }
        (void)hipGetLastError();
        grid = cus;
    }
    if (grid < 0) return;
    Params prm{};
    for (int i = 0; i < 21; ++i) prm.in[i] = (const float*)d_in[i];
    prm.out = (float*)d_out; prm.ws = (unsigned char*)d_ws;
#if MK_N_LAUNCHES == 1
    prm.ph_lo = 0; prm.ph_hi = NPHASE;
    void* args[] = {&prm};
    hipError_t e = hipLaunchCooperativeKernel((const void*)mega_fwd, dim3(grid), dim3(512), args, LDS_BYTES, stream);
    if (e != hipSuccess) fprintf(stderr, "cooperative launch failed: %s (grid %d)\n", hipGetErrorString(e), grid);
#ifdef PROBE_EXTRA_PHASE
    { Params q2 = prm; q2.ph_lo = PROBE_EXTRA_PHASE; q2.ph_hi = PROBE_EXTRA_PHASE + 1; hipLaunchKernelGGL(mega_fwd, dim3(grid), dim3(512), LDS_BYTES, stream, q2); }
#endif
#else
    for (int k = 0; k < NPHASE; ++k) { prm.ph_lo = k; prm.ph_hi = k + 1; hipLaunchKernelGGL(mega_fwd, dim3(grid), dim3(512), LDS_BYTES, stream, prm); }
#endif
}
```

```cpp
#include <hip/hip_runtime.h>
#include <hip/hip_cooperative_groups.h>
#include <cstdio>
#include <cstdint>
namespace cg = cooperative_groups;
namespace pg8 {
#define PG8_LAS __attribute__((address_space(3)))
typedef unsigned short bf16_t;
typedef short bf16x8 __attribute__((ext_vector_type(8)));
typedef float f32x4 __attribute__((ext_vector_type(4)));
typedef unsigned u32x4 __attribute__((ext_vector_type(4)));
constexpr int BM = 256, BK = 64, HALF = 128, HTB = HALF * BK * 2  , STAGE_BYTES = 8 * HTB, NXCD = 8, WGM = 8;

__host__ __device__ __forceinline__ int lds_byte(int r, int c) { const int st = (r >> 4) * 2 + (c >> 5), rr = r & 15, cc = c & 31, ob = rr * 64 + cc * 2; return st * 1024 + (ob ^ (((ob >> 9) & 1) << 5)); }
__host__ __device__ __forceinline__ void stage_rc(int b, int& R, int& C) { const int st = b / 1024, sb = b % 1024, swz = sb ^ (((sb >> 9) & 1) << 5); R = (st >> 1) * 16 + swz / 64; C = (st & 1) * 32 + (swz % 64) / 2; }
__host__ __device__ __forceinline__ int perm32(int rho) { const int n = rho >> 4, i = rho & 15; return 8 * (i >> 2) + 4 * n + (i & 3); }

struct Unit { int pm, pn, ko; };
struct Gemm { const bf16_t* A; const bf16_t* Bt; int M, N, K, ld; };

struct StaticOrder {
    int nM, nN, nwg, G, c;
    __host__ __device__ void init(int M, int N, int G_, int c_) { nM = M / BM; nN = N / BM; nwg = nM * nN; G = G_; c = c_; }
    __host__ __device__ bool next(int i, Unit& u) const {
        const long L = (long)i * G + c; if (L >= nwg) return false;
        int wgid = (int)L; { const int q = nwg / NXCD, r = nwg % NXCD, xcd = wgid % NXCD, off = wgid / NXCD; wgid = (xcd < r ? xcd * (q + 1) : r * (q + 1) + (xcd - r) * q) + off; }
        const int nig = WGM * nN, gid = wgid / nig, fm = gid * WGM, gsz = (nM - fm) < WGM ? (nM - fm) : WGM;
        u.pm = fm + ((wgid % nig) % gsz); u.pn = (wgid % nig) / gsz; u.ko = 0; return true;
    }
    __device__ __forceinline__ void a_ready(const Unit&) const {}
    __device__ __forceinline__ void done(const Unit&) const {}
};

__device__ __forceinline__ unsigned cvt_pk_bf16(float lo, float hi) { unsigned r; asm volatile("v_cvt_pk_bf16_f32 %0, %1, %2" : "=v"(r) : "v"(lo), "v"(hi)); return r; }
template <class Epi, class Sched, bool ALIGN_EPI = false, bool SP2 = false>
__device__ __forceinline__ void gemm_phase(PG8_LAS unsigned char* lds, const Gemm g, const Sched& S, const Epi& E) {
    int tid_o = threadIdx.x; asm volatile("" : "+v"(tid_o));
    const int tid = tid_o, wid = __builtin_amdgcn_readfirstlane(tid >> 6), lane = tid & 63, wr = wid >> 2, wc = wid & 3, fr = lane & 15, fq = lane >> 4;
    const int K = g.K, nt = K / BK, LD = g.ld ? g.ld : g.K;
    unsigned voffA[2], voffB[2];
#pragma unroll
    for (int i = 0; i < 2; ++i) { int R, C; stage_rc(tid * 16 + i * 8192, R, C); const int Rb = Epi::PERM ? ((R & ~31) + perm32(R & 31)) : R;
        voffA[i] = (unsigned)(R * LD + C) * 2u; voffB[i] = (unsigned)(Rb * LD + C) * 2u; }
    const size_t kstep = (size_t)(BK * 2);
    const size_t hstep = (size_t)HALF * LD * 2;
    const size_t tstep = 2 * hstep;
    const unsigned ldsw = (unsigned)wid * 1024u;
    const int aoff = lds_byte(wr * 64 + fr, fq * 8), boff = lds_byte(wc * 32 + fr, fq * 8);
#define PG8_SA(b, h) (((b) * 2 + (h)) * HTB)
#define PG8_SB(b, h) ((4 + (b) * 2 + (h)) * HTB)
#define PG8_STAGE(bufoff, gbase, voff) do { _Pragma("unroll") for (int _i = 0; _i < 2; ++_i) \
        __builtin_amdgcn_global_load_lds((const unsigned*)((const char*)(gbase) + (voff)[_i]), (PG8_LAS unsigned*)(lds + (bufoff) + ldsw + _i * 8192), 16, 0, 0); } while (0)
#define PG8_LDA(dst, b, h) do { _Pragma("unroll") for (int m = 0; m < 4; ++m) _Pragma("unroll") for (int k = 0; k < 2; ++k) dst[m][k] = *(const PG8_LAS bf16x8*)(lds + PG8_SA(b, h) + aoff + m * 2048 + k * 1024); } while (0)
#define PG8_LDB(dst, b, h) do { _Pragma("unroll") for (int n = 0; n < 2; ++n) _Pragma("unroll") for (int k = 0; k < 2; ++k) dst[n][k] = *(const PG8_LAS bf16x8*)(lds + PG8_SB(b, h) + boff + n * 2048 + k * 1024); } while (0)
#define PG8_MMA(ai, bj, At, Bt) do { __builtin_amdgcn_s_setprio(1); _Pragma("unroll") for (int m = 0; m < 4; ++m) _Pragma("unroll") for (int n = 0; n < 2; ++n) _Pragma("unroll") for (int k = 0; k < 2; ++k) \
        acc[ai][bj][m][n] = __builtin_amdgcn_mfma_f32_16x16x32_bf16(Bt[n][k], At[m][k], acc[ai][bj][m][n], 0, 0, 0); __builtin_amdgcn_s_setprio(0); } while (0)
#define PG8_WAIT_V(n) asm volatile("s_waitcnt vmcnt(" #n ")" ::: "memory")
#define PG8_WAIT_L(n) asm volatile("s_waitcnt lgkmcnt(" #n ")" ::: "memory")
#define PG8_BAR __builtin_amdgcn_s_barrier()
#define PG8_SCHED __builtin_amdgcn_sched_barrier(0)
    Unit cur, nxt; int ui = 0;
    if (!S.next(0, cur)) return;
    f32x4 acc[2][2][4][2];
#pragma unroll
    for (int a = 0; a < 2; ++a)
#pragma unroll
        for (int b = 0; b < 2; ++b)
#pragma unroll
            for (int m = 0; m < 4; ++m)
#pragma unroll
                for (int n = 0; n < 2; ++n) acc[a][b][m][n] = (f32x4){0.f, 0.f, 0.f, 0.f};
    bf16x8 At[4][2], B0[2][2], B1[2][2];
    const char* cA = (const char*)g.A + (size_t)cur.pm * tstep + (size_t)cur.ko * 2; const char* cB = (const char*)g.Bt + (size_t)cur.pn * tstep + (size_t)cur.ko * 2;
    S.a_ready(cur);
    if constexpr (SP2) {
        PG8_STAGE(PG8_SB(0, 0), cB, voffB); PG8_STAGE(PG8_SB(0, 1), cB + hstep, voffB); PG8_STAGE(PG8_SA(0, 0), cA, voffA); PG8_STAGE(PG8_SA(0, 1), cA + hstep, voffA);
        if (wr == 1) PG8_BAR;
        PG8_WAIT_V(2); PG8_BAR;
        PG8_STAGE(PG8_SB(1, 0), cB + kstep, voffB); PG8_STAGE(PG8_SA(1, 0), cA + kstep, voffA); PG8_STAGE(PG8_SB(1, 1), cB + hstep + kstep, voffB);
        PG8_WAIT_V(6); PG8_BAR;
    } else {
        PG8_STAGE(PG8_SB(0, 0), cB, voffB); PG8_STAGE(PG8_SA(0, 0), cA, voffA); PG8_STAGE(PG8_SB(0, 1), cB + hstep, voffB); PG8_STAGE(PG8_SA(0, 1), cA + hstep, voffA);
        if (wr == 1) PG8_BAR;
        PG8_WAIT_V(4); PG8_BAR;
        PG8_STAGE(PG8_SB(1, 0), cB + kstep, voffB); PG8_STAGE(PG8_SA(1, 0), cA + kstep, voffA); PG8_STAGE(PG8_SB(1, 1), cB + hstep + kstep, voffB);
        PG8_WAIT_V(6); PG8_BAR;
    }
    for (;;) {
        const bool has_next = S.next(ui + 1, nxt);
        const char* nA = has_next ? (const char*)g.A + (size_t)nxt.pm * tstep + (size_t)nxt.ko * 2 : cA; const char* nB = has_next ? (const char*)g.Bt + (size_t)nxt.pn * tstep + (size_t)nxt.ko * 2 : cB;
        for (int t = 0; t < nt; t += 2) {
            const bool last = (t == nt - 2);
            const char* a1 = cA + (size_t)(t + 1) * kstep;
            const char* a2 = last ? nA : cA + (size_t)(t + 2) * kstep; const char* b2 = last ? nB : cB + (size_t)(t + 2) * kstep;
            const char* a3 = a2 + kstep; const char* b3 = b2 + kstep;
            if (last && has_next) S.a_ready(nxt);
            if constexpr (SP2) {
            PG8_LDB(B0, 0, 0); PG8_LDB(B1, 0, 1); PG8_SCHED; PG8_LDA(At, 0, 0); PG8_STAGE(PG8_SA(1, 1), a1 + hstep, voffA);
            PG8_WAIT_V(8); PG8_WAIT_L(0); PG8_BAR; PG8_MMA(0, 0, At, B0); PG8_MMA(0, 1, At, B1); PG8_BAR; PG8_SCHED;
            PG8_LDA(At, 0, 1); PG8_STAGE(PG8_SB(0, 0), b2, voffB); PG8_STAGE(PG8_SB(0, 1), b2 + hstep, voffB); PG8_STAGE(PG8_SA(0, 0), a2, voffA);
            PG8_WAIT_V(8); PG8_WAIT_L(0); PG8_BAR; PG8_MMA(1, 0, At, B0); PG8_MMA(1, 1, At, B1); PG8_BAR; PG8_SCHED;
            PG8_LDB(B0, 1, 0); PG8_LDB(B1, 1, 1); PG8_SCHED; PG8_LDA(At, 1, 0); PG8_STAGE(PG8_SA(0, 1), a2 + hstep, voffA);
            PG8_WAIT_V(8); PG8_WAIT_L(0); PG8_BAR; PG8_MMA(0, 0, At, B0); PG8_MMA(0, 1, At, B1); PG8_BAR; PG8_SCHED;
            PG8_LDA(At, 1, 1); PG8_STAGE(PG8_SB(1, 0), b3, voffB); PG8_STAGE(PG8_SB(1, 1), b3 + hstep, voffB); PG8_STAGE(PG8_SA(1, 0), a3, voffA);
            PG8_WAIT_V(8); PG8_WAIT_L(0); PG8_BAR; PG8_MMA(1, 0, At, B0); PG8_MMA(1, 1, At, B1); PG8_BAR; PG8_SCHED;
            } else {
            PG8_LDB(B0, 0, 0); PG8_SCHED; PG8_LDA(At, 0, 0); PG8_STAGE(PG8_SA(1, 1), a1 + hstep, voffA);
            PG8_WAIT_L(8); PG8_BAR; PG8_WAIT_L(0); PG8_MMA(0, 0, At, B0); PG8_BAR; PG8_SCHED;
            PG8_LDB(B1, 0, 1); PG8_STAGE(PG8_SB(0, 0), b2, voffB);
            PG8_BAR; PG8_WAIT_L(0); PG8_MMA(0, 1, At, B1); PG8_BAR;
            PG8_LDA(At, 0, 1); PG8_STAGE(PG8_SA(0, 0), a2, voffA);
            PG8_BAR; PG8_WAIT_L(0); PG8_MMA(1, 0, At, B0); PG8_BAR; PG8_SCHED;
            PG8_STAGE(PG8_SB(0, 1), b2 + hstep, voffB);
            PG8_WAIT_V(6); PG8_BAR; PG8_MMA(1, 1, At, B1); PG8_BAR;
            PG8_LDB(B0, 1, 0); PG8_SCHED; PG8_LDA(At, 1, 0); PG8_STAGE(PG8_SA(0, 1), a2 + hstep, voffA);
            PG8_WAIT_L(8); PG8_BAR; PG8_WAIT_L(0); PG8_MMA(0, 0, At, B0); PG8_BAR; PG8_SCHED;
            PG8_LDB(B1, 1, 1); PG8_STAGE(PG8_SB(1, 0), b3, voffB);
            PG8_BAR; PG8_WAIT_L(0); PG8_MMA(0, 1, At, B1); PG8_BAR;
            PG8_LDA(At, 1, 1); PG8_STAGE(PG8_SA(1, 0), a3, voffA);
            PG8_BAR; PG8_WAIT_L(0); PG8_MMA(1, 0, At, B0); PG8_BAR; PG8_SCHED;
            PG8_STAGE(PG8_SB(1, 1), b3 + hstep, voffB);
            PG8_WAIT_V(6); PG8_BAR; PG8_MMA(1, 1, At, B1); PG8_BAR;
            }
        }
        if constexpr (ALIGN_EPI) { if (wr == 0) PG8_BAR; }
        if constexpr (!Epi::AFTER_DRAIN) { E(acc, cur, wr, wc, fr, fq); S.done(cur); }
        if (!has_next) break;
#pragma unroll
        for (int a = 0; a < 2; ++a)
#pragma unroll
            for (int b = 0; b < 2; ++b)
#pragma unroll
                for (int m = 0; m < 4; ++m)
#pragma unroll
                    for (int n = 0; n < 2; ++n) acc[a][b][m][n] = (f32x4){0.f, 0.f, 0.f, 0.f};
        cur = nxt; cA = nA; cB = nB; ++ui;
        if constexpr (ALIGN_EPI) { if (wr == 1) PG8_BAR; }
    }
    PG8_WAIT_V(0);
    if constexpr (!ALIGN_EPI) { if (wr == 0) PG8_BAR; }
    PG8_BAR;
    if constexpr (Epi::AFTER_DRAIN) { E.fused(acc, cur, wr, wc, fr, fq, lds, wid, lane); S.done(cur); }
#undef PG8_SA
#undef PG8_SB
#undef PG8_STAGE
#undef PG8_LDA
#undef PG8_LDB
#undef PG8_MMA
#undef PG8_WAIT_V
#undef PG8_WAIT_L
#undef PG8_BAR
#undef PG8_SCHED
}
}

#define DI __device__ __forceinline__
#define LAS __attribute__((address_space(3)))
typedef unsigned short bf16_t;
typedef short bf16x8 __attribute__((ext_vector_type(8)));
typedef short s16x4 __attribute__((ext_vector_type(4)));
typedef float f32x4 __attribute__((ext_vector_type(4)));
typedef float f32x16 __attribute__((ext_vector_type(16)));
typedef unsigned u32x4 __attribute__((ext_vector_type(4)));
typedef unsigned u32x2 __attribute__((ext_vector_type(2)));
typedef float f32x2_t __attribute__((ext_vector_type(2)));
typedef __bf16 bf16x2_t __attribute__((ext_vector_type(2)));
typedef short v4i16_t __attribute__((ext_vector_type(4)));
typedef int i32x4 __attribute__((ext_vector_type(4)));

constexpr int DM = 1024, NB = 8, SEQ = 8192, NMETA = 16, LP = 8208, SBN = 32, SSN = 32, PAST = 4096;
constexpr int RS0 = 65536, RM0 = 66560, RV = 66576, RT = 66816;
constexpr int DFF = 2816, DIN = 2216;
constexpr int NGRP = 2081;
constexpr float EPS = 1e-6f, LOG2E = 1.4426950408889634f;
constexpr float QS_FOX = 0.125f * LOG2E;
constexpr float QS_MLA = 0.10206207261596577f * LOG2E;
constexpr float NEGF = -1e30f;

constexpr size_t O_YP = 0, O_YS = O_YP + (size_t)NB * SEQ * DM, O_LATP = O_YS + (size_t)SBN * SSN * DM, O_KRP = O_LATP + (size_t)NB * LP * 256,
                 O_FKP = O_KRP + (size_t)NB * LP * 32, O_FVP = O_FKP + (size_t)NB * LP * 512, O_LFP = O_FVP + (size_t)NB * LP * 512,
                 O_LATS = O_LFP + (size_t)NB * LP * 8, O_KRS = O_LATS + (size_t)1024 * 256, O_FKS = O_KRS + (size_t)1024 * 32,
                 O_FVS = O_FKS + (size_t)1024 * 512, O_LFS = O_FVS + (size_t)1024 * 512, O_END = O_LFS + (size_t)1024 * 8;

constexpr size_t MiB = 1u << 20;
constexpr size_t WS_SS2 = 524288;
constexpr size_t WS_SS1 = 4096;
constexpr size_t WS_KINF = 0;
constexpr size_t WS_ROPE = 1 * MiB, WS_LC = 3 * MiB, WS_CLC = 6 * MiB, WS_TT = 10 * MiB, WS_CTT = 10 * MiB + 512 * 1024;
constexpr size_t WS_WIN = 11 * MiB, WS_WUQ = 16 * MiB, WS_WUKV = 17 * MiB, WS_WOUT = 18 * MiB, WS_WGU = 20 * MiB, WS_WDN = 31 * MiB;
constexpr size_t WS_XN = 37 * MiB;
constexpr size_t WS_CQN = WS_XN, WS_LATN = WS_XN + 50 * MiB, WS_MIXED = WS_XN;
constexpr size_t WS_PROJC = 168 * MiB;
constexpr size_t WS_QMLA = WS_PROJC;
constexpr size_t WS_KR = 266 * MiB;
constexpr size_t WS_CKR = 271 * MiB;
constexpr size_t WS_CLAT = 279 * MiB;
constexpr size_t WS_FQKV = 343 * MiB;
constexpr size_t WS_KVX = 539 * MiB;
constexpr size_t WS_KVXC = 670 * MiB;
constexpr size_t WS_XPART = 928 * MiB;
constexpr size_t WS_END = 972 * MiB;
constexpr size_t HM_BYTES = (size_t)RT * 512 * 2;
constexpr size_t WS_FQ = WS_FQKV, WS_FKH = WS_FQKV + HM_BYTES, WS_FVH = WS_FQKV + 2 * HM_BYTES;
constexpr size_t WS_KNH = WS_KVX, WS_VMH = WS_KVX + HM_BYTES;
constexpr size_t WS_KNC = WS_KVXC, WS_VMC = WS_KVXC + 128 * MiB;
static_assert(WS_FVH + HM_BYTES <= WS_KVX && WS_VMH + HM_BYTES <= WS_KVXC, "ws map");
constexpr size_t WS_HN = WS_FQKV;
constexpr size_t WS_ACT = WS_FQKV + 131 * MiB;
static_assert(WS_ACT + (size_t)RT * DFF * 2 <= WS_END, "ws map");
static_assert(WS_LATN + (size_t)RT * 256 * 2 <= WS_PROJC && WS_CQN + (size_t)RT * 384 * 2 <= WS_LATN, "ws map");

constexpr int LDS_BYTES = 147456;

struct Params { const float* in[21]; float* out; unsigned char* ws; int ph_lo, ph_hi; };

DI unsigned pk2(float lo, float hi) { f32x2_t v = {lo, hi}; bf16x2_t b = __builtin_convertvector(v, bf16x2_t); return __builtin_bit_cast(unsigned, b); }
DI float bf2f(unsigned short x) { return __uint_as_float((unsigned)x << 16); }
DI u32x4 pack8(f32x4 a, f32x4 b) { return (u32x4){pk2(a.x, a.y), pk2(a.z, a.w), pk2(b.x, b.y), pk2(b.z, b.w)}; }
DI float wave_sum(float v) {
#pragma unroll
    for (int o = 1; o < 64; o <<= 1) v += __shfl_xor(v, o);
    return v;
}
DI int row_pos(int row) { return row < RS0 ? NMETA + (row & 8191) : (row < RM0 ? PAST + ((row - RS0) & 31) : (row < RV ? row - RM0 : 0)); }
DI const float* x_of_row(const Params& p, int row) {
    return row < RS0 ? p.in[0] + (size_t)row * DM : (row < RM0 ? p.in[1] + (size_t)(row - RS0) * DM : (row < RV ? p.in[7] + (size_t)(row - RM0) * DM : nullptr));
}
DI void out_store8(float* outp, float* outs, int width, int row, int cc, f32x4 v0, f32x4 v1) {
    if (row < RS0) { const int b = row >> 13, t = row & 8191; float* d = outp + (size_t)(b * LP + NMETA + t) * width + cc; *(f32x4*)d = v0; *(f32x4*)(d + 4) = v1; }
    else if (row < RM0) { float* d = outs + (size_t)(row - RS0) * width + cc; *(f32x4*)d = v0; *(f32x4*)(d + 4) = v1; }
    else if (row < RV) { const int m = row - RM0;
#pragma unroll 1
        for (int b = 0; b < NB; ++b) { float* d = outp + (size_t)(b * LP + m) * width + cc; *(f32x4*)d = v0; *(f32x4*)(d + 4) = v1; } }
}

struct EpiG1 {
    static constexpr bool PERM = true, AFTER_DRAIN = false;
    bf16_t* projc; bf16_t* fqp; bf16_t* fkh; bf16_t* fvh; float* out; unsigned* kinf;
    DI void operator()(const f32x4 (&acc)[2][2][4][2], const pg8::Unit& u, int wr, int wc, int fr, int fq) const {
        const int pn = u.pn;
        float kmx[2] = {0.f, 0.f};
#pragma unroll
        for (int ai = 0; ai < 2; ++ai)
#pragma unroll
            for (int m = 0; m < 4; ++m) {
                const int row = u.pm * 256 + ai * 128 + wr * 64 + m * 16 + fr;
#pragma unroll
                for (int bj = 0; bj < 2; ++bj) {
                    const int col8 = bj * 128 + wc * 32 + 8 * fq;
                    f32x4 v0 = acc[ai][bj][m][0], v1 = acc[ai][bj][m][1];
                    if (pn < 3) { *(u32x4*)(projc + (size_t)row * 768 + pn * 256 + col8) = pack8(v0, v1); }
                    else {
                        const int c = (pn - 3) * 256 + col8;
                        if (pn < 5) *(u32x4*)(fqp + (size_t)row * 512 + c) = pack8(v0, v1);
                        else { char* base = (char*)((pn < 7 ? fkh : fvh) + (size_t)(((pn - 5) & 1) * 4 + bj * 2 + (wc >> 1)) * RT * 64);
                               *(u32x4*)(base + (unsigned)(row * 64 + (wc & 1) * 32 + 8 * fq) * 2u) = pack8(v0, v1); }
                        if (pn == 5 || pn == 6) {
                            float q2 = (v0.x * v0.x + v0.y * v0.y) + (v0.z * v0.z + v0.w * v0.w) + (v1.x * v1.x + v1.y * v1.y) + (v1.z * v1.z + v1.w * v1.w);
                            q2 += __shfl_xor(q2, 16); q2 += __shfl_xor(q2, 32);
                            kmx[bj] = fmaxf(kmx[bj], q2); }
                        if (pn >= 5) { const int which = (pn - 5) >> 1, cc = ((pn - 5) & 1) * 256 + col8;
                            out_store8(out + (which ? O_FVP : O_FKP), out + (which ? O_FVS : O_FKS), 512, row, cc, v0, v1); }
                    }
                }
            }
        if (pn == 5 || pn == 6) {
#pragma unroll
            for (int bj = 0; bj < 2; ++bj) { float m = kmx[bj];
#pragma unroll
                for (int o = 1; o < 64; o <<= 1) m = fmaxf(m, __shfl_xor(m, o));
                if ((fr | (fq << 4)) == 0) atomicMax(kinf + ((pn - 5) * 4 + bj * 2 + (wc >> 1)) * 2 + (wc & 1), __float_as_uint(m)); }
        }
    }
};
struct EpiBf16 {
    static constexpr bool PERM = true, AFTER_DRAIN = false;
    bf16_t* O; int ldc;
    DI void operator()(const f32x4 (&acc)[2][2][4][2], const pg8::Unit& u, int wr, int wc, int fr, int fq) const {
#pragma unroll
        for (int ai = 0; ai < 2; ++ai)
#pragma unroll
            for (int m = 0; m < 4; ++m) {
                const int row = u.pm * 256 + ai * 128 + wr * 64 + m * 16 + fr;
#pragma unroll
                for (int bj = 0; bj < 2; ++bj) {
                    const int col = u.pn * 256 + bj * 128 + wc * 32 + 8 * fq;
                    *(u32x4*)(O + (size_t)row * ldc + col) = pack8(acc[ai][bj][m][0], acc[ai][bj][m][1]);
                }
            }
    }
};
struct EpiKV {
    static constexpr bool PERM = true, AFTER_DRAIN = false;
    bf16_t* kn; bf16_t* vm; size_t nrows;
    DI void operator()(const f32x4 (&acc)[2][2][4][2], const pg8::Unit& u, int wr, int wc, int fr, int fq) const {
        const int d = (wc & 1) * 32 + 8 * fq;
#pragma unroll
        for (int bj = 0; bj < 2; ++bj) {
            char* base = (char*)(((wc >> 1) ? vm : kn) + (size_t)(u.pn * 2 + bj) * nrows * 64);
#pragma unroll
            for (int ai = 0; ai < 2; ++ai)
#pragma unroll
                for (int m = 0; m < 4; ++m) {
                    const int row = u.pm * 256 + ai * 128 + wr * 64 + m * 16 + fr;
                    *(u32x4*)(base + (unsigned)(row * 64 + d) * 2u) = pack8(acc[ai][bj][m][0], acc[ai][bj][m][1]);
                }
        }
    }
};
struct EpiQ {
    static constexpr bool PERM = false, AFTER_DRAIN = false;
    bf16_t* O; const float* rope;
    DI void operator()(const f32x4 (&acc)[2][2][4][2], const pg8::Unit& u, int wr, int wc, int fr, int fq) const {
#pragma unroll
        for (int bj = 0; bj < 2; ++bj) {
            const int g = u.pn * 8 + bj * 4 + wc;
            const bool is_rope = (g % 3) == 2;
#pragma unroll
            for (int ai = 0; ai < 2; ++ai)
#pragma unroll
                for (int m = 0; m < 4; ++m) {
                    const int row = u.pm * 256 + ai * 128 + wr * 64 + m * 16 + fr;
                    f32x4 a = acc[ai][bj][m][0], b = acc[ai][bj][m][1];
                    if (is_rope) {
                        const float* t = rope + (size_t)row_pos(row) * 32;
                        const f32x4 c = *(const f32x4*)(t + 4 * fq), s = *(const f32x4*)(t + 16 + 4 * fq);
                        const f32x4 o1 = a * c - b * s, o2 = b * c + a * s; a = o1; b = o2;
                    }
                    a = a * QS_MLA; b = b * QS_MLA;
                    bf16_t* d = O + (size_t)row * 768 + g * 32 + 4 * fq;
                    *(u32x2*)d = (u32x2){pk2(a.x, a.y), pk2(a.z, a.w)};
                    *(u32x2*)(d + 16) = (u32x2){pk2(b.x, b.y), pk2(b.z, b.w)};
                }
        }
    }
};
struct EpiRes {
    static constexpr bool PERM = true, AFTER_DRAIN = false;
    const float* xp; const float* xs; bf16_t* x1b; float* ss;
    DI void operator()(const f32x4 (&acc)[2][2][4][2], const pg8::Unit& u, int wr, int wc, int fr, int fq) const {
#pragma unroll
        for (int ai = 0; ai < 2; ++ai)
#pragma unroll
            for (int m = 0; m < 4; ++m) {
                const int row = u.pm * 256 + ai * 128 + wr * 64 + m * 16 + fr;
                float q = 0.f;
                if (row < RM0) {
                    const float* xr = row < RS0 ? xp + (size_t)row * DM : xs + (size_t)(row - RS0) * DM;
#pragma unroll
                    for (int bj = 0; bj < 2; ++bj) {
                        const int col = u.pn * 256 + bj * 128 + wc * 32 + 8 * fq;
                        const f32x4 y0 = *(const f32x4*)(xr + col) + acc[ai][bj][m][0], y1 = *(const f32x4*)(xr + col + 4) + acc[ai][bj][m][1];
                        q += (y0.x * y0.x + y0.y * y0.y) + (y0.z * y0.z + y0.w * y0.w) + (y1.x * y1.x + y1.y * y1.y) + (y1.z * y1.z + y1.w * y1.w);
                        *(u32x4*)(x1b + (size_t)row * DM + col) = pack8(y0, y1);
                    }
                }
                q += __shfl_xor(q, 16); q += __shfl_xor(q, 32);
                if (fq == 0 && row < RM0) atomicAdd(ss + row, q);
            }
    }
};
struct SplitOrder {
    int c;
    DI bool next(int i, pg8::Unit& u) const { if (i != 0 || c >= 176) return false; u.pm = 256 + c / 44; u.pn = (c / 11) & 3; u.ko = (c % 11) * 256; return true; }
    DI void a_ready(const pg8::Unit&) const {}
    DI void done(const pg8::Unit&) const {}
};
struct EpiPart {
    static constexpr bool PERM = true, AFTER_DRAIN = false;
    float* xp;
    DI void operator()(const f32x4 (&acc)[2][2][4][2], const pg8::Unit& u, int wr, int wc, int fr, int fq) const {
        float* base = xp + (size_t)(u.ko >> 8) * 1024 * 1024;
#pragma unroll
        for (int ai = 0; ai < 2; ++ai)
#pragma unroll
            for (int m = 0; m < 4; ++m) {
                const int rs = (u.pm - 256) * 256 + ai * 128 + wr * 64 + m * 16 + fr;
#pragma unroll
                for (int bj = 0; bj < 2; ++bj) {
                    float* d = base + (size_t)rs * 1024 + u.pn * 256 + bj * 128 + wc * 32 + 8 * fq;
                    *(f32x4*)d = acc[ai][bj][m][0]; *(f32x4*)(d + 4) = acc[ai][bj][m][1];
                }
            }
    }
};
struct EpiAcc {
    static constexpr bool PERM = true, AFTER_DRAIN = false;
    bf16_t* x1b; float* ss;
    DI void operator()(const f32x4 (&acc)[2][2][4][2], const pg8::Unit& u, int wr, int wc, int fr, int fq) const {
#pragma unroll
        for (int ai = 0; ai < 2; ++ai)
#pragma unroll
            for (int m = 0; m < 4; ++m) {
                const int row = u.pm * 256 + ai * 128 + wr * 64 + m * 16 + fr;
                float q = 0.f;
                if (row < RM0) {
#pragma unroll
                    for (int bj = 0; bj < 2; ++bj) {
                        const int col = u.pn * 256 + bj * 128 + wc * 32 + 8 * fq;
                        bf16_t* d = x1b + (size_t)row * DM + col;
                        const u32x4 w = *(const u32x4*)d;
                        const f32x4 y0 = (f32x4){__uint_as_float(w.x << 16), __uint_as_float(w.x & 0xffff0000u), __uint_as_float(w.y << 16), __uint_as_float(w.y & 0xffff0000u)} + acc[ai][bj][m][0];
                        const f32x4 y1 = (f32x4){__uint_as_float(w.z << 16), __uint_as_float(w.z & 0xffff0000u), __uint_as_float(w.w << 16), __uint_as_float(w.w & 0xffff0000u)} + acc[ai][bj][m][1];
                        q += (y0.x * y0.x + y0.y * y0.y) + (y0.z * y0.z + y0.w * y0.w) + (y1.x * y1.x + y1.y * y1.y) + (y1.z * y1.z + y1.w * y1.w);
                        *(u32x4*)d = pack8(y0, y1);
                    }
                }
                q += __shfl_xor(q, 16); q += __shfl_xor(q, 32);
                if (fq == 0 && row < RM0) atomicAdd(ss + row, q);
            }
    }
};
DI float silu_mul(float g, float u) { return g * u * __builtin_amdgcn_rcpf(1.0f + __builtin_amdgcn_exp2f(-g * LOG2E)); }
struct EpiSwiglu {
    static constexpr bool PERM = true, AFTER_DRAIN = false;
    bf16_t* O; const float* ss;
    DI void operator()(const f32x4 (&acc)[2][2][4][2], const pg8::Unit& u, int wr, int wc, int fr, int fq) const {
#pragma unroll
        for (int ai = 0; ai < 2; ++ai)
#pragma unroll
            for (int m = 0; m < 4; ++m) {
                const int row = u.pm * 256 + ai * 128 + wr * 64 + m * 16 + fr;
                const float rstd = 1.0f / sqrtf(ss[row] * (1.0f / DM) + EPS);
                const f32x4 g0 = acc[ai][0][m][0] * rstd, g1 = acc[ai][0][m][1] * rstd, u0 = acc[ai][1][m][0] * rstd, u1 = acc[ai][1][m][1] * rstd;
                f32x4 a0, a1;
#pragma unroll
                for (int i = 0; i < 4; ++i) { a0[i] = silu_mul(g0[i], u0[i]); a1[i] = silu_mul(g1[i], u1[i]); }
                *(u32x4*)(O + (size_t)row * DFF + u.pn * 128 + wc * 32 + 8 * fq) = pack8(a0, a1);
            }
    }
};

DI int wmap(int kind, int n) {
    if (kind == 0 || kind == 4) return n;
    if (kind == 1) return n < 384 ? 256 + n : (n < 640 ? n - 384 : (n < 672 ? n : (n < 2208 ? n + 96 : n - 1536)));
    if (kind == 2) return 256 * (n >> 7) + (n & 127);
    return 256 * (n >> 7) + 128 + (n & 127);
}
DI float wscale(int kind, int n) { return kind == 4 ? QS_MLA : ((kind == 1 && n >= 672 && n < 1184) ? QS_FOX : 1.0f); }
DI void p0_transpose_item(const float* W, int K, int N, bf16_t* WT, int kind, LAS float* scr, int item, int lane, const float* kscale = nullptr) {
    const int nblk = (N + 31) / 32, kb = item / nblk, nb = item % nblk, k0 = 64 * kb, n0 = 32 * nb;
    const int nl = n0 + (lane & 31);
    const float wsc = wscale(kind, nl);
#pragma unroll 8
    for (int i = 0; i < 32; ++i) { const int kk = 2 * i + (lane >> 5); scr[kk * 33 + (lane & 31)] = (nl < N) ? W[(size_t)(k0 + kk) * N + nl] * (kscale ? wsc * kscale[k0 + kk] : wsc) : 0.f; }
    asm volatile("s_waitcnt lgkmcnt(0)" ::: "memory");
    const int c = lane & 7;
#pragma unroll
    for (int j = 0; j < 4; ++j) { const int n = (lane >> 3) + 8 * j; const LAS float* s = scr + (8 * c) * 33 + n;
        u32x4 o; o.x = pk2(s[0 * 33], s[1 * 33]); o.y = pk2(s[2 * 33], s[3 * 33]); o.z = pk2(s[4 * 33], s[5 * 33]); o.w = pk2(s[6 * 33], s[7 * 33]);
        if (n0 + n < N) *(u32x4*)(WT + (size_t)wmap(kind, n0 + n) * K + k0 + 8 * c) = o; }
    asm volatile("s_waitcnt lgkmcnt(0)" ::: "memory");
}
DI void norm_row_to_bf16(const float* xrow, const float* g, bf16_t* orow, int lane) {
    f32x4 v[4]; float s = 0.f;
#pragma unroll
    for (int j = 0; j < 4; ++j) { v[j] = ((const f32x4*)xrow)[lane + 64 * j]; s += (v[j].x * v[j].x + v[j].y * v[j].y) + (v[j].z * v[j].z + v[j].w * v[j].w); }
    const float rstd = 1.0f / sqrtf(wave_sum(s) * (1.0f / DM) + EPS);
#pragma unroll
    for (int j = 0; j < 4; ++j) { const f32x4 gg = ((const f32x4*)g)[lane + 64 * j]; const f32x4 y = v[j] * rstd * gg;
        ((u32x2*)orow)[lane + 64 * j] = (u32x2){pk2(y.x, y.y), pk2(y.z, y.w)}; }
}
DI void norm_rows2_to_bf16(const float* x0, const float* x1, const float* g, bf16_t* o0, bf16_t* o1, int lane) {
    f32x4 v[4], w[4]; float s = 0.f, t = 0.f;
#pragma unroll
    for (int j = 0; j < 4; ++j) { v[j] = ((const f32x4*)x0)[lane + 64 * j]; w[j] = ((const f32x4*)x1)[lane + 64 * j]; }
#pragma unroll
    for (int j = 0; j < 4; ++j) { s += (v[j].x * v[j].x + v[j].y * v[j].y) + (v[j].z * v[j].z + v[j].w * v[j].w); t += (w[j].x * w[j].x + w[j].y * w[j].y) + (w[j].z * w[j].z + w[j].w * w[j].w); }
#pragma unroll
    for (int o = 1; o < 64; o <<= 1) { s += __shfl_xor(s, o); t += __shfl_xor(t, o); }
    const float rs = 1.0f / sqrtf(s * (1.0f / DM) + EPS), rt = 1.0f / sqrtf(t * (1.0f / DM) + EPS);
#pragma unroll
    for (int j = 0; j < 4; ++j) { const f32x4 gg = ((const f32x4*)g)[lane + 64 * j]; const f32x4 y = v[j] * rs * gg, z = w[j] * rt * gg;
        ((u32x2*)o0)[lane + 64 * j] = (u32x2){pk2(y.x, y.y), pk2(y.z, y.w)}; ((u32x2*)o1)[lane + 64 * j] = (u32x2){pk2(z.x, z.y), pk2(z.z, z.w)}; }
}
DI void rope_entry(float* tab, int idx) {
    const int pos = idx >> 4, i = idx & 15;
    double inv = 1.0; for (int k = 0; k < i; ++k) inv *= 0.5623413251903491;
    const double ang = (double)pos * inv;
    const double k2 = __builtin_rint(ang * 0.15915494309189535);
    double r = __builtin_fma(-k2, 6.283185307179586, ang); r = __builtin_fma(-k2, 2.4492935982947064e-16, r);
    const double q = __builtin_rint(r * 0.6366197723675814);
    const double y = __builtin_fma(-q, 1.5707963267948966, r), y2 = y * y;
    double sp = 1.0 / 6227020800.0; sp = sp * y2 - 1.0 / 39916800.0; sp = sp * y2 + 1.0 / 362880.0; sp = sp * y2 - 1.0 / 5040.0; sp = sp * y2 + 1.0 / 120.0; sp = sp * y2 - 1.0 / 6.0; sp = sp * y2 + 1.0;
    const double sn = sp * y;
    double cp = -1.0 / 87178291200.0; cp = cp * y2 + 1.0 / 479001600.0; cp = cp * y2 - 1.0 / 3628800.0; cp = cp * y2 + 1.0 / 40320.0; cp = cp * y2 - 1.0 / 720.0; cp = cp * y2 + 1.0 / 24.0; cp = cp * y2 - 0.5; cp = cp * y2 + 1.0;
    const int qi = ((int)q) & 3;
    const double s = (qi == 0) ? sn : (qi == 1) ? cp : (qi == 2) ? -sn : -cp;
    const double c = (qi == 0) ? cp : (qi == 1) ? -sn : (qi == 2) ? -cp : sn;
    tab[pos * 32 + i] = (float)c; tab[pos * 32 + 16 + i] = (float)s;
}
DI void cache_cum_group(const float* lf, float* clc, float* ctt, int g, int lane) {
    f32x4 v = ((const f32x4*)(lf + (size_t)g * 256))[lane];
#pragma unroll
    for (int off = 2; off < 64; off <<= 1) {
        f32x4 t; t.x = __shfl_up(v.x, off); t.y = __shfl_up(v.y, off); t.z = __shfl_up(v.z, off); t.w = __shfl_up(v.w, off);
        if (lane >= off) v = v + t;
    }
    ((f32x4*)(clc + (size_t)g * 256))[lane] = v;
    if (lane >= 62) *(f32x4*)(ctt + (size_t)g * 8 + 4 * (lane & 1)) = v;
}
DI float log_sigmoid(float z) { return fminf(z, 0.f) - log1pf(expf(-fabsf(z))); }

DI void p2_group(const Params& p, int gi, int lane) {
    unsigned char* ws = p.ws;
    const bf16_t* projc = (const bf16_t*)(ws + WS_PROJC);
    bf16_t* cqn = (bf16_t*)(ws + WS_CQN); bf16_t* latn = (bf16_t*)(ws + WS_LATN); bf16_t* krb = (bf16_t*)(ws + WS_KR);
    const float* rope = (const float*)(ws + WS_ROPE); float* LC = (float*)(ws + WS_LC); float* TT = (float*)(ws + WS_TT);
    const float* qn = p.in[11]; const float* kvn = p.in[13]; const float* bfg = p.in[10];
    const int row0 = gi * 32, nrows = (gi == NGRP - 1) ? 16 : 32;
    f32x4 g0a, g0b, g1a, g1b;
    if (lane < 32) { g0a = *(const f32x4*)(kvn + 8 * lane); g0b = *(const f32x4*)(kvn + 8 * lane + 4); }
    else { g0a = *(const f32x4*)(qn + 8 * (lane - 32)); g0b = *(const f32x4*)(qn + 8 * (lane - 32) + 4); }
    if (lane < 16) { g1a = *(const f32x4*)(qn + 256 + 8 * lane); g1b = *(const f32x4*)(qn + 256 + 8 * lane + 4); } else { g1a = (f32x4){0, 0, 0, 0}; g1b = g1a; }
    const float bfl = bfg[lane & 7];
    float run1 = 0.f;
#pragma unroll 1
    for (int rr0 = 0; rr0 < nrows; rr0 += 4) {
      u32x4 w0s[4], w1s[4];
#pragma unroll
      for (int k = 0; k < 4; ++k) { const bf16_t* pr = projc + (size_t)(row0 + rr0 + k) * 768;
          w0s[k] = *(const u32x4*)(pr + 8 * lane); w1s[k] = (u32x4){0, 0, 0, 0}; if (lane < 32) w1s[k] = *(const u32x4*)(pr + 512 + 8 * lane); }
#pragma unroll
      for (int k = 0; k < 4; ++k) {
        const int row = row0 + rr0 + k;
        const u32x4 w0 = w0s[k], w1 = w1s[k];
        float a[8], b[8];
#pragma unroll
        for (int i = 0; i < 4; ++i) { a[2 * i] = __uint_as_float(w0[i] << 16); a[2 * i + 1] = __uint_as_float(w0[i] & 0xffff0000u);
                                      b[2 * i] = __uint_as_float(w1[i] << 16); b[2 * i + 1] = __uint_as_float(w1[i] & 0xffff0000u); }
        float sa = 0.f, sb = 0.f;
#pragma unroll
        for (int i = 0; i < 8; ++i) { sa += a[i] * a[i]; sb += b[i] * b[i]; }
        float skv = (lane < 32) ? sa : 0.f, sq = ((lane >= 32) ? sa : 0.f) + ((lane < 16) ? sb : 0.f);
        skv = wave_sum(skv); sq = wave_sum(sq);
        const float rkv = 1.0f / sqrtf(skv * (1.0f / 256.0f) + EPS), rq = 1.0f / sqrtf(sq * (1.0f / 384.0f) + EPS);
        const float r0 = (lane < 32) ? rkv : rq;
        f32x4 y0 = (f32x4){a[0], a[1], a[2], a[3]} * r0 * g0a, y1 = (f32x4){a[4], a[5], a[6], a[7]} * r0 * g0b;
        if (lane < 32) { *(u32x4*)(latn + (size_t)row * 256 + 8 * lane) = pack8(y0, y1);
            out_store8(p.out + O_LATP, p.out + O_LATS, 256, row, 8 * lane, y0, y1); }
        else { *(u32x4*)(cqn + (size_t)row * 384 + 8 * (lane - 32)) = pack8(y0, y1); }
        if (lane < 16) { f32x4 z0 = (f32x4){b[0], b[1], b[2], b[3]} * rq * g1a, z1 = (f32x4){b[4], b[5], b[6], b[7]} * rq * g1b;
            *(u32x4*)(cqn + (size_t)row * 384 + 256 + 8 * lane) = pack8(z0, z1); }
        float ob[8];
#pragma unroll
        for (int i = 0; i < 8; ++i) ob[i] = __shfl_xor(b[i], 2);
        if (lane >= 16 && lane < 20) {
            const int pos = row_pos(row); const bool first = lane < 18; const int j0 = 8 * (lane - (first ? 16 : 18));
            const float* t = rope + (size_t)pos * 32 + j0;
            const f32x4 c0 = *(const f32x4*)t, c1 = *(const f32x4*)(t + 4), s0 = *(const f32x4*)(t + 16), s1 = *(const f32x4*)(t + 20);
            float cc[8] = {c0.x, c0.y, c0.z, c0.w, c1.x, c1.y, c1.z, c1.w}, ss[8] = {s0.x, s0.y, s0.z, s0.w, s1.x, s1.y, s1.z, s1.w};
            float o[8];
#pragma unroll
            for (int i = 0; i < 8; ++i) o[i] = first ? (b[i] * cc[i] - ob[i] * ss[i]) : (b[i] * cc[i] + ob[i] * ss[i]);
            const f32x4 o0 = (f32x4){o[0], o[1], o[2], o[3]}, o1 = (f32x4){o[4], o[5], o[6], o[7]};
            *(u32x4*)(krb + (size_t)row * 32 + 8 * (lane - 16)) = pack8(o0, o1);
            out_store8(p.out + O_KRP, p.out + O_KRS, 32, row, 8 * (lane - 16), o0, o1);
        }
        {
            float z = 0.f;
#pragma unroll
            for (int i = 0; i < 8; ++i) { const float t = __shfl(b[i], 20); if ((lane & 7) == i) z = t; }
            const float lf = log_sigmoid(z + bfl);
            run1 += lf;
            if (lane < 8) {
                LC[(size_t)row * 8 + lane] = run1;
                if (row < RS0) { const int bb = row >> 13, t = row & 8191; p.out[O_LFP + (size_t)(bb * LP + NMETA + t) * 8 + lane] = lf; }
                else if (row < RM0) { p.out[O_LFS + (size_t)(row - RS0) * 8 + lane] = lf; }
                else { const int m = row - RM0;
#pragma unroll 1
                    for (int bb = 0; bb < NB; ++bb) p.out[O_LFP + (size_t)(bb * LP + m) * 8 + lane] = lf; }
            }
        }
      }
    }
    if (lane < 8) TT[(size_t)gi * 8 + lane] = run1;
}

template <int DK> struct ACfg { static constexpr int NK = (DK == 64) ? 5 : 6, KP = (DK == 64) ? 176 : 208; };
constexpr int VP = 192;
constexpr float THR = 8.0f;
#define MFMA32(a, b, c) __builtin_amdgcn_mfma_f32_32x32x16_bf16((a), (b), (c), 0, 0, 0)
DI int crow(int r, int hi) { return (r & 3) + 8 * (r >> 2) + 4 * hi; }
DI s16x4 vtr(const LAS unsigned char* p) { return __builtin_bit_cast(s16x4, __builtin_amdgcn_ds_read_tr16_b64_v4i16((LAS v4i16_t*)p)); }
DI float bf16_round(float x) { return __uint_as_float(pk2(x, 0.f) << 16); }
DI u32x4 bias_chunk(float bv) {
    const unsigned h = pk2(bv, 0.f) & 0xffffu; const float r1 = bv - __uint_as_float(h << 16);
    const unsigned m = pk2(r1, 0.f) & 0xffffu; const float r2 = r1 - __uint_as_float(m << 16);
    const unsigned l = pk2(r2, 0.f) & 0xffffu;
    return (u32x4){0x3F80u | (h << 16), m | (l << 16), 0u, 0u};
}
DI void rope_qfrag(bf16x8& x1, bf16x8& x2, const float* t) {
    const f32x4 c0 = *(const f32x4*)t, c1 = *(const f32x4*)(t + 4), s0 = *(const f32x4*)(t + 16), s1 = *(const f32x4*)(t + 20);
    const float cc[8] = {c0.x, c0.y, c0.z, c0.w, c1.x, c1.y, c1.z, c1.w}, ss[8] = {s0.x, s0.y, s0.z, s0.w, s1.x, s1.y, s1.z, s1.w};
    float o1[8], o2[8];
#pragma unroll
    for (int i = 0; i < 8; ++i) { const float a = bf2f((unsigned short)x1[i]), b = bf2f((unsigned short)x2[i]); o1[i] = a * cc[i] - b * ss[i]; o2[i] = b * cc[i] + a * ss[i]; }
    const u32x4 w1 = (u32x4){pk2(o1[0], o1[1]), pk2(o1[2], o1[3]), pk2(o1[4], o1[5]), pk2(o1[6], o1[7])};
    const u32x4 w2 = (u32x4){pk2(o2[0], o2[1]), pk2(o2[2], o2[3]), pk2(o2[4], o2[5]), pk2(o2[6], o2[7])};
    x1 = __builtin_bit_cast(bf16x8, w1); x2 = __builtin_bit_cast(bf16x8, w2);
}
template <int DK, bool FOX>
DI void load_qfrags(const Params& p, int qrow0  , int r32, int h, int hi, bf16x8 (&qf)[DK / 16 + 1]) {
    unsigned char* ws = p.ws;
    const char* qb_ = FOX ? (const char*)((const bf16_t*)(ws + WS_FQ) + (size_t)qrow0 * 512 + h * 64) : (const char*)((const bf16_t*)(ws + WS_QMLA) + (size_t)qrow0 * 768 + h * 96);
    const unsigned qo = (unsigned)(r32 * (FOX ? 512 : 768) + 8 * hi) * 2u;
#pragma unroll
    for (int d0 = 0; d0 < DK / 16; ++d0) qf[d0] = *(const bf16x8*)(qb_ + qo + 32 * d0);
    if (!FOX) { const char* rt_ = (const char*)((const float*)(ws + WS_ROPE) + (size_t)row_pos(qrow0) * 32); rope_qfrag(qf[DK / 16 - 2], qf[DK / 16 - 1], (const float*)(rt_ + (unsigned)(r32 * 32 + 8 * hi) * 4u)); }
    const u32x4 ex = hi == 0 ? (u32x4){0x3F800000u, 0x3F803F80u, 0u, 0u} : (u32x4){0u, 0u, 0u, 0u};
    qf[DK / 16] = __builtin_bit_cast(bf16x8, ex);
}
template <int DK, int NKB>
DI void attn_qk(const LAS unsigned char* Kb, const bf16x8 (&qf)[DK / 16 + 1], f32x16 (&s)[NKB], int lane, const f32x16& negm) {
    constexpr int NK = ACfg<DK>::NK, KP = ACfg<DK>::KP;
    const LAS unsigned char* kp = Kb + (lane & 31) * KP + (lane >> 5) * 16;
    f32x16 z;
#pragma unroll
    for (int r = 0; r < 16; ++r) z[r] = (DK == 64) ? 0.f : negm[r];
#pragma unroll
    for (int d0 = 0; d0 < NK; ++d0)
#pragma unroll
        for (int blk = 0; blk < NKB; ++blk) {
            const bf16x8 kf = *(const LAS bf16x8*)(kp + blk * 32 * KP + d0 * 32);
            s[blk] = MFMA32(kf, qf[d0], d0 == 0 ? z : s[blk]);
        }
}
template <int NKB, bool CINIT>
DI void attn_sm_a(f32x16 (&s)[NKB], f32x16 (&o)[2], float& rref, float& l, bf16x8& qfx, bool first, int maskmode, int mparam, int lane, float& rmin, f32x16& negm) {
    const int r32 = lane & 31, hi = lane >> 5;
    if (CINIT && maskmode == 1) {
#pragma unroll
        for (int blk = 0; blk < NKB; ++blk)
#pragma unroll
            for (int r = 0; r < 16; ++r) if (blk * 32 + crow(r, hi) < 48) s[blk][r] = NEGF;
    }
    if (maskmode == 2) {
        const int lim = mparam + r32;
#pragma unroll
        for (int blk = 0; blk < NKB; ++blk)
#pragma unroll
            for (int r = 0; r < 16; ++r) if (blk * 32 + crow(r, hi) > lim) s[blk][r] = NEGF;
    }
    float mx = s[0][0];
#pragma unroll
    for (int blk = 0; blk < NKB; ++blk)
#pragma unroll
        for (int r = 0; r < 16; ++r) mx = fmaxf(mx, s[blk][r]);
    mx = fmaxf(mx, __shfl_xor(mx, 32));
    const bool need = first || (mx > THR);
    if (__any(need)) {
        const float rn = need ? bf16_round(rref + mx) : rref;
        const float d = rn - rref; rref = rn;
#pragma unroll
        for (int blk = 0; blk < NKB; ++blk)
#pragma unroll
            for (int r = 0; r < 16; ++r) s[blk][r] -= d;
        const float f = __builtin_amdgcn_exp2f(-d);
        l *= f;
#pragma unroll
        for (int dd = 0; dd < 2; ++dd)
#pragma unroll
            for (int r = 0; r < 16; ++r) o[dd][r] *= f;
        if (CINIT) {
#pragma unroll
            for (int r = 0; r < 16; ++r) negm[r] = -rref;
        } else if (hi == 0) qfx[0] = (short)(pk2(-rref, 0.f) & 0xffffu);
        float mn = rref;
#pragma unroll
        for (int off = 1; off < 64; off <<= 1) mn = fminf(mn, __shfl_xor(mn, off));
        rmin = mn;
    }
}
template <int NKB>
DI void attn_sm_b(f32x16 (&s)[NKB], float& l, bf16x8 (&pf)[NKB][2]) {
    float ls = 0.f;
#pragma unroll
    for (int blk = 0; blk < NKB; ++blk)
#pragma unroll
        for (int r = 0; r < 16; ++r) { s[blk][r] = __builtin_amdgcn_exp2f(s[blk][r]); ls += s[blk][r]; }
    l += ls;
#pragma unroll
    for (int blk = 0; blk < NKB; ++blk)
#pragma unroll
        for (int s2 = 0; s2 < 2; ++s2) {
            const u32x4 w = (u32x4){pk2(s[blk][8 * s2 + 0], s[blk][8 * s2 + 1]), pk2(s[blk][8 * s2 + 2], s[blk][8 * s2 + 3]),
                                    pk2(s[blk][8 * s2 + 4], s[blk][8 * s2 + 5]), pk2(s[blk][8 * s2 + 6], s[blk][8 * s2 + 7])};
            pf[blk][s2] = __builtin_bit_cast(bf16x8, w);
        }
}
template <int NKB>
DI void attn_pv(const LAS unsigned char* Vb, const bf16x8 (&pf)[NKB][2], f32x16 (&o)[2], int lane) {
    const int hi = lane >> 5, q4 = (lane & 15) >> 2, p4 = lane & 3, gb = (lane >> 4) & 1;
    const LAS unsigned char* vp = Vb + (4 * hi + q4) * VP + 32 * gb + 8 * p4;
#pragma unroll
    for (int blk = 0; blk < NKB; ++blk)
#pragma unroll
        for (int s2 = 0; s2 < 2; ++s2)
#pragma unroll
            for (int d = 0; d < 2; ++d) {
                const LAS unsigned char* a = vp + (blk * 32 + 16 * s2) * VP + d * 64;
                const s16x4 lo = vtr(a), hi4 = vtr(a + 8 * VP);
                const bf16x8 vf = __builtin_shufflevector(lo, hi4, 0, 1, 2, 3, 4, 5, 6, 7);
                o[d] = MFMA32(vf, pf[blk][s2], o[d]);
            }
}
template <int NKB>
DI void attn_sm_pv(f32x16 (&s)[NKB], float& l, const LAS unsigned char* Vb, f32x16 (&o)[2], int lane) {
    const int hi = lane >> 5, q4 = (lane & 15) >> 2, p4 = lane & 3, gb = (lane >> 4) & 1;
    const LAS unsigned char* vp = Vb + (4 * hi + q4) * VP + 32 * gb + 8 * p4;
    float ls0 = 0.f, ls1 = 0.f;
#pragma unroll
    for (int blk = 0; blk < NKB; ++blk) {
#pragma unroll
        for (int r = 0; r < 16; r += 2) { s[blk][r] = __builtin_amdgcn_exp2f(s[blk][r]); s[blk][r + 1] = __builtin_amdgcn_exp2f(s[blk][r + 1]); ls0 += s[blk][r]; ls1 += s[blk][r + 1]; }
#pragma unroll
        for (int s2 = 0; s2 < 2; ++s2) {
            const u32x4 w = (u32x4){pk2(s[blk][8 * s2 + 0], s[blk][8 * s2 + 1]), pk2(s[blk][8 * s2 + 2], s[blk][8 * s2 + 3]),
                                    pk2(s[blk][8 * s2 + 4], s[blk][8 * s2 + 5]), pk2(s[blk][8 * s2 + 6], s[blk][8 * s2 + 7])};
            const bf16x8 pfr = __builtin_bit_cast(bf16x8, w);
#pragma unroll
            for (int d = 0; d < 2; ++d) {
                const LAS unsigned char* a = vp + (blk * 32 + 16 * s2) * VP + d * 64;
                const s16x4 lo = vtr(a), hi4 = vtr(a + 8 * VP);
                const bf16x8 vf = __builtin_shufflevector(lo, hi4, 0, 1, 2, 3, 4, 5, 6, 7);
                o[d] = MFMA32(vf, pfr, o[d]);
            }
        }
    }
    l += ls0 + ls1;
}
DI void attn_store_o(bf16_t* orow, const f32x16 (&o)[2], float l, int hi) {
    l = l + __shfl_xor(l, 32);
    const float inv = 1.0f / l;
#pragma unroll
    for (int d = 0; d < 2; ++d)
#pragma unroll
        for (int g = 0; g < 4; ++g)
            *(u32x2*)(orow + d * 32 + 8 * g + 4 * hi) = (u32x2){pk2(o[d][4 * g] * inv, o[d][4 * g + 1] * inv), pk2(o[d][4 * g + 2] * inv, o[d][4 * g + 3] * inv)};
}

constexpr int A_K0 = 0, A_KSZ = 2 * 15360, A_V0 = 2 * A_KSZ, A_VSZ = 2 * 64 * VP, A_TP = A_V0 + 2 * A_VSZ, A_CBN = A_TP + 1024, A_FLG = A_CBN + 64;
template <bool FOX>
DI void attn_prompt_unit(const Params& p, LAS unsigned char* lds, int b, int h, int qb) {
    constexpr int DK = FOX ? 64 : 96, CPR = DK / 8, NK = ACfg<DK>::NK, KP = ACfg<DK>::KP;
    unsigned char* ws = p.ws;
    int tid_o = threadIdx.x; asm volatile("" : "+v"(tid_o));
    const int tid = tid_o, lane = tid & 63, wid = __builtin_amdgcn_readfirstlane(tid >> 6), r32 = lane & 31, hi = lane >> 5;
    const bf16_t* kh = (const bf16_t*)(ws + (FOX ? WS_FKH : WS_KNH)) + (size_t)h * RT * 64; const bf16_t* vh = (const bf16_t*)(ws + (FOX ? WS_FVH : WS_VMH)) + (size_t)h * RT * 64;
    const bf16_t* krb = (const bf16_t*)(ws + WS_KR); const float* LC = (const float*)(ws + WS_LC); const float* TT = (const float*)(ws + WS_TT);
    bf16_t* mixed = (bf16_t*)(ws + WS_MIXED);
    LAS float* TPs = (LAS float*)(lds + A_TP);
    __syncthreads();
    if (FOX && wid == 0) {
        float t[4];
#pragma unroll
        for (int i = 0; i < 4; ++i) t[i] = TT[(size_t)(b * 256 + 4 * lane + i) * 8 + h];
        float e[4]; e[0] = 0.f; e[1] = t[0]; e[2] = t[0] + t[1]; e[3] = e[2] + t[2]; const float tot = e[3] + t[3];
        float inc = tot;
#pragma unroll
        for (int off = 1; off < 64; off <<= 1) { const float v = __shfl_up(inc, off); if (lane >= off) inc += v; }
        const float ex = inc - tot;
#pragma unroll
        for (int i = 0; i < 4; ++i) TPs[4 * lane + i] = ex + e[i];
    }
    __syncthreads();
    const float ref = FOX ? TPs[8 * qb] : 0.f;
    const float tpmeta = FOX ? -TT[(size_t)(NGRP - 1) * 8 + h] : 0.f;
    const int qrow = b * SEQ + 256 * qb + 32 * wid + r32;
    bf16x8 qf[DK / 16 + 1];
    f32x16 o[2];
#pragma unroll
    for (int r = 0; r < 16; ++r) { o[0][r] = 0.f; o[1][r] = 0.f; }
    float rref = 0.f, l = 0.f, rmin = 0.f, qkb = 0.f;
    f32x16 negm;
#pragma unroll
    for (int r = 0; r < 16; ++r) negm[r] = 0.f;
    LAS float* CBN = (LAS float*)(lds + A_CBN); LAS int* FLG = (LAS int*)(lds + A_FLG);
    bool done = false;
    const int ktmax = 4 * qb + 3, mykt = 4 * qb + (wid >> 1);
    const int vj = tid >> 3, vp = tid & 7, rj = tid >> 2, rp = tid & 3;
    u32x4 rk0_0, rk0_1, rk1_0 = (u32x4){0, 0, 0, 0}, rk1_1 = (u32x4){0, 0, 0, 0}, rv_0, rv_1; float rb_0 = 0.f, rb_1 = 0.f;
#define TROW0(kt) ((kt) < 0 ? RM0 : b * SEQ + 64 * (kt))
#define JOFF(kt, j) ((kt) < 0 ? ((j) >= 48 ? (j) - 48 : 0) : (j))
#define LOADKV(kt, U) do { const int r0_ = TROW0(kt); \
        { const unsigned of_ = (unsigned)(JOFF(kt, vj) * 64 + vp * 8) * 2u; \
          rk0_##U = *(const u32x4*)((const char*)(kh + (size_t)r0_ * 64) + of_); rv_##U = *(const u32x4*)((const char*)(vh + (size_t)r0_ * 64) + of_); } \
        if (!FOX) { \
               if (tid < 256) { const char* rb_ = (const char*)(krb + (size_t)r0_ * 32); rk1_##U = *(const u32x4*)(rb_ + (unsigned)(JOFF(kt, rj) * 32 + rp * 8) * 2u); } } \
        if (tid < 64) { rb_##U = 0.f; \
          if (FOX) { const float tp = (kt) < 0 ? tpmeta : TPs[2 * (kt) + (tid >> 5)]; rb_##U = -(*(const float*)((const char*)(LC + (size_t)r0_ * 8 + h) + (unsigned)JOFF(kt, tid) * 32u) + tp - ref) * LOG2E; } \
          if ((kt) < 0 && tid < 48) rb_##U = NEGF; } \
    } while (0)
#define STOREKV(slot, U) do { LAS unsigned char* B_ = lds + A_K0 + (slot) * A_KSZ + (U) * 64 * KP; \
        *(LAS u32x4*)(B_ + vj * KP + vp * 16) = rk0_##U; \
        if (!FOX && tid < 256) *(LAS u32x4*)(B_ + rj * KP + (8 + rp) * 16) = rk1_##U; \
        if (FOX && tid < 64) { *(LAS u32x4*)(B_ + tid * KP + DK * 2) = bias_chunk(rb_##U); *(LAS u32x4*)(B_ + tid * KP + DK * 2 + 16) = (u32x4){0u, 0u, 0u, 0u}; } \
        *(LAS u32x4*)(lds + A_V0 + (slot) * A_VSZ + (U) * 64 * VP + vj * VP + vp * 16) = rv_##U; \
        if (FOX && tid == 63) CBN[(slot) * 2 + (U)] = rb_##U; \
    } while (0)
#define COMPUTE(kt, slot, U) do { \
        if (FOX && !first && !done && CBN[(slot) * 2 + (U)] + qkb - rmin < -130.0f) done = true;     \
        if ((kt) <= mykt && !done) { \
            const int mm = (FOX && (kt) == mykt) ? 2 : ((!FOX && (kt) < 0) ? 1 : 0); \
            attn_qk<DK, 2>(lds + A_K0 + (slot) * A_KSZ + (U) * 64 * KP, qf, sA, lane, negm); \
            attn_sm_a<2, !FOX>(sA, o, rref, l, qf[DK / 16], first, mm, 32 * (wid & 1), lane, rmin, negm); \
            first = false; \
            attn_sm_pv<2>(sA, l, lds + A_V0 + (slot) * A_VSZ + (U) * 64 * VP, o, lane); } } while (0)
    const int Smax = 2 * qb + 1;
    LOADKV(2 * Smax + 1, 0); LOADKV(2 * Smax, 1);
    load_qfrags<DK, FOX>(p, b * SEQ + 256 * qb + 32 * wid, r32, h, hi, qf);
    if (FOX) {
        float a = 0.f, c = 0.f;
#pragma unroll
        for (int i = 0; i < 8; ++i) { const float x0 = bf2f((unsigned short)qf[0][i]), x1 = bf2f((unsigned short)qf[1][i]), x2 = bf2f((unsigned short)qf[2][i]), x3 = bf2f((unsigned short)qf[3][i]);
            a += x0 * x0 + x1 * x1; c += x2 * x2 + x3 * x3; }
        a += __shfl_xor(a, 32); c += __shfl_xor(c, 32);
#pragma unroll
        for (int off = 1; off < 32; off <<= 1) { a = fmaxf(a, __shfl_xor(a, off)); c = fmaxf(c, __shfl_xor(c, off)); }
        const unsigned* kn2 = (const unsigned*)(ws + WS_KINF) + 2 * h;
        qkb = 1.02f * (sqrtf(a * __uint_as_float(kn2[0])) + sqrtf(c * __uint_as_float(kn2[1])));
    }
    STOREKV(Smax & 1, 0); STOREKV(Smax & 1, 1);
    __syncthreads();
    f32x16 sA[2];
    bool first = true;
    if (wid >= 4) __builtin_amdgcn_s_setprio(1);
#pragma unroll 1
    for (int S = Smax; S >= -1; --S) {
        const int slot = S & 1;
        if (S >= 1) { LOADKV(2 * S - 1, 0); LOADKV(2 * S - 2, 1); } else if (S == 0) { LOADKV(-1, 0); }
        if (S >= 0) { COMPUTE(2 * S + 1, slot, 0); COMPUTE(2 * S, slot, 1); } else { COMPUTE(-1, slot, 0); }
        if (S >= 1) { STOREKV(slot ^ 1, 0); STOREKV(slot ^ 1, 1); } else if (S == 0) { STOREKV(slot ^ 1, 0); }
        if (FOX && lane == 0) FLG[slot * 8 + wid] = done ? 1 : 0;
        __syncthreads();
        if (FOX) { const i32x4 f0 = *(const LAS i32x4*)(FLG + slot * 8), f1 = *(const LAS i32x4*)(FLG + slot * 8 + 4);
            if ((f0.x & f0.y & f0.z & f0.w & f1.x & f1.y & f1.z & f1.w) != 0) break; }
    }
    __builtin_amdgcn_s_setprio(0);
#undef LOADKV
#undef STOREKV
#undef COMPUTE
#undef TROW0
#undef JOFF
    attn_store_o(mixed + (size_t)qrow * 1024 + (FOX ? 512 : 0) + h * 64, o, l, hi);
}

constexpr int SWB = 14336, S_V = 7680, S_TP = S_V + 32 * VP;
constexpr int M_O = 0, M_ML = 65536;
template <bool FOX>
DI void attn_sample_unit(const Params& p, LAS unsigned char* lds0, int sb, int h) {
    constexpr int DK = FOX ? 64 : 96, CPR = DK / 8, NK = ACfg<DK>::NK, KP = ACfg<DK>::KP, NKC = 32 * CPR / 64;
    unsigned char* ws = p.ws;
    int tid_o = threadIdx.x; asm volatile("" : "+v"(tid_o));
    const int tid = tid_o, lane = tid & 63, wid = __builtin_amdgcn_readfirstlane(tid >> 6), r32 = lane & 31, hi = lane >> 5;
    LAS unsigned char* lds = lds0 + wid * SWB;
    const bf16_t* kh = (const bf16_t*)(ws + (FOX ? WS_FKH : WS_KNH)) + (size_t)h * RT * 64; const bf16_t* vh = (const bf16_t*)(ws + (FOX ? WS_FVH : WS_VMH)) + (size_t)h * RT * 64;
    const bf16_t* knc = (const bf16_t*)(ws + WS_KNC) + (size_t)h * 131072 * 64; const bf16_t* vmc = (const bf16_t*)(ws + WS_VMC) + (size_t)h * 131072 * 64;
    const bf16_t* krb = (const bf16_t*)(ws + WS_KR); const bf16_t* ckr = (const bf16_t*)(ws + WS_CKR);
    const float* LC = (const float*)(ws + WS_LC); const float* CLC = (const float*)(ws + WS_CLC); const float* CTT = (const float*)(ws + WS_CTT);
    const float* cfk = p.in[4]; const float* cfv = p.in[5];
    bf16_t* mixed = (bf16_t*)(ws + WS_MIXED);
    LAS float* TPs = (LAS float*)(lds + S_TP);
    __syncthreads();
    float tall = 0.f;
    if (FOX) {
        const float t0 = CTT[(size_t)(sb * 128 + 2 * lane) * 8 + h], t1 = CTT[(size_t)(sb * 128 + 2 * lane + 1) * 8 + h];
        const float tot = t0 + t1; float inc = tot;
#pragma unroll
        for (int off = 1; off < 64; off <<= 1) { const float v = __shfl_up(inc, off); if (lane >= off) inc += v; }
        const float ex = inc - tot;
        TPs[2 * lane] = ex; TPs[2 * lane + 1] = ex + t0;
        tall = __shfl(inc, 63);
    }
    const int row0 = RS0 + sb * 32, qrow = row0 + r32;
    bf16x8 qf[DK / 16 + 1];
    load_qfrags<DK, FOX>(p, row0, r32, h, hi, qf);
    f32x16 o[2];
#pragma unroll
    for (int r = 0; r < 16; ++r) { o[0][r] = 0.f; o[1][r] = 0.f; }
    float rref = 0.f, l = 0.f, rmin = 0.f;
    f32x16 negm;
#pragma unroll
    for (int r = 0; r < 16; ++r) negm[r] = 0.f;
    f32x16 s1[1];
    bool first = true;
    if (wid == 0) {
        const char* nk_ = (const char*)(kh + (size_t)row0 * 64); const char* nv_ = (const char*)(vh + (size_t)row0 * 64);
#pragma unroll
        for (int i = 0; i < 4; ++i) { const unsigned off = (unsigned)(((lane >> 3) + 8 * i) * 64 + (lane & 7) * 8) * 2u;
            *(LAS u32x4*)(lds + (lane >> 3) * KP + (lane & 7) * 16 + i * 8 * KP) = *(const u32x4*)(nk_ + off); *(LAS u32x4*)(lds + S_V + (lane >> 3) * VP + (lane & 7) * 16 + i * 8 * VP) = *(const u32x4*)(nv_ + off); }
        if (!FOX) { const char* nr_ = (const char*)(krb + (size_t)row0 * 32);
#pragma unroll
            for (int i = 0; i < 2; ++i) *(LAS u32x4*)(lds + (lane >> 2) * KP + (8 + (lane & 3)) * 16 + i * 16 * KP) = *(const u32x4*)(nr_ + (unsigned)((lane >> 2) * 32 + (lane & 3) * 8) * 2u + i * 16 * 64); }
        if (FOX && lane < 32) { const float bv = FOX ? -(*(const float*)((const char*)(LC + (size_t)row0 * 8 + h) + (unsigned)lane * 32u)) * LOG2E : 0.f;
            *(LAS u32x4*)(lds + lane * KP + DK * 2) = bias_chunk(bv); *(LAS u32x4*)(lds + lane * KP + DK * 2 + 16) = (u32x4){0u, 0u, 0u, 0u}; }
        asm volatile("s_waitcnt lgkmcnt(0)" ::: "memory");
        attn_qk<DK, 1>(lds, qf, s1, lane, negm);
        attn_sm_a<1, !FOX>(s1, o, rref, l, qf[DK / 16], true, FOX ? 2 : 0, 0, lane, rmin, negm);
        attn_sm_pv<1>(s1, l, lds + S_V, o, lane);
        first = false;
    }
    const size_t crow0 = (size_t)sb * PAST;
    const unsigned ldk0 = (lane >> 3) * KP + (lane & 7) * 16, ldv0 = S_V + (lane >> 3) * VP + (lane & 7) * 16;
    const unsigned so0 = FOX ? (unsigned)((lane >> 3) * 512 + h * 64 + (lane & 7) * 8) * 4u : (unsigned)((lane >> 3) * 64 + (lane & 7) * 8) * 2u;
    constexpr unsigned SROW8 = FOX ? 8u * 512u * 4u : 8u * 64u * 2u;
    if (FOX) {
        f32x4 rk[4][2], rv[4][2]; float rc = 0.f;
#define LOADC(tt) do { const char* kb_ = (const char*)(cfk + (crow0 + 32 * (tt)) * 512); const char* vb_ = (const char*)(cfv + (crow0 + 32 * (tt)) * 512); \
            _Pragma("unroll") for (int i = 0; i < 4; ++i) { const unsigned so_ = so0 + i * SROW8; rk[i][0] = *(const f32x4*)(kb_ + so_); rk[i][1] = *(const f32x4*)(kb_ + so_ + 16); rv[i][0] = *(const f32x4*)(vb_ + so_); rv[i][1] = *(const f32x4*)(vb_ + so_ + 16); } \
            if (lane < 32) rc = *(const float*)((const char*)(CLC + (crow0 + 32 * (tt)) * 8 + h) + (unsigned)lane * 32u); } while (0)
        LOADC(127 - wid);
#pragma unroll 1
        for (int t = 127 - wid; t >= 0; t -= 8) {
#if 0
            for (int i = 0; i < 4; ++i) { const unsigned so_ = so0 + i * SROW8; rk[i][0] = *(const f32x4*)(kb_ + so_); rk[i][1] = *(const f32x4*)(kb_ + so_ + 16); rv[i][0] = *(const f32x4*)(vb_ + so_); rv[i][1] = *(const f32x4*)(vb_ + so_ + 16); }
#endif
#pragma unroll
            for (int i = 0; i < 4; ++i) { *(LAS u32x4*)(lds + ldk0 + i * 8 * KP) = pack8(rk[i][0], rk[i][1]); *(LAS u32x4*)(lds + ldv0 + i * 8 * VP) = pack8(rv[i][0], rv[i][1]); }
            if (lane < 32) { *(LAS u32x4*)(lds + lane * KP + DK * 2) = bias_chunk(-(rc + TPs[t] - tall) * LOG2E); *(LAS u32x4*)(lds + lane * KP + DK * 2 + 16) = (u32x4){0u, 0u, 0u, 0u}; }
            if (t >= 8) LOADC(t - 8);
            asm volatile("s_waitcnt lgkmcnt(0)" ::: "memory");
            attn_qk<DK, 1>(lds, qf, s1, lane, negm);
            attn_sm_a<1, !FOX>(s1, o, rref, l, qf[DK / 16], first, 0, 0, lane, rmin, negm);
            attn_sm_pv<1>(s1, l, lds + S_V, o, lane);
            first = false;
        }
#undef LOADC
    } else {
        const unsigned ro0 = (unsigned)((lane >> 2) * 32 + (lane & 3) * 8) * 2u, rld0 = (lane >> 2) * KP + (8 + (lane & 3)) * 16;
        u32x4 rk[4], rr[2], rv[4];
#define LOADC(tt) do { const char* kb_ = (const char*)(knc + (crow0 + 32 * (tt)) * 64); const char* vb_ = (const char*)(vmc + (crow0 + 32 * (tt)) * 64); const char* rb_ = (const char*)(ckr + (crow0 + 32 * (tt)) * 32); \
            _Pragma("unroll") for (int i = 0; i < 4; ++i) { const unsigned so_ = so0 + i * SROW8; rk[i] = *(const u32x4*)(kb_ + so_); rv[i] = *(const u32x4*)(vb_ + so_); } \
            _Pragma("unroll") for (int i = 0; i < 2; ++i) rr[i] = *(const u32x4*)(rb_ + ro0 + i * 16 * 64); } while (0)
        LOADC(127 - wid);
#pragma unroll 1
        for (int t = 127 - wid; t >= 0; t -= 8) {
#pragma unroll
            for (int i = 0; i < 4; ++i) { *(LAS u32x4*)(lds + ldk0 + i * 8 * KP) = rk[i]; *(LAS u32x4*)(lds + ldv0 + i * 8 * VP) = rv[i]; }
#pragma unroll
            for (int i = 0; i < 2; ++i) *(LAS u32x4*)(lds + rld0 + i * 16 * KP) = rr[i];
            if (t >= 8) LOADC(t - 8);
            asm volatile("s_waitcnt lgkmcnt(0)" ::: "memory");
            attn_qk<DK, 1>(lds, qf, s1, lane, negm);
            attn_sm_a<1, !FOX>(s1, o, rref, l, qf[DK / 16], first, 0, 0, lane, rmin, negm);
            attn_sm_pv<1>(s1, l, lds + S_V, o, lane);
            first = false;
        }
#undef LOADC
    }
    l = l + __shfl_xor(l, 32);
    __syncthreads();
    {
        LAS float* MO = (LAS float*)(lds0 + M_O) + (size_t)(wid * 32 + r32) * 64; LAS float* ML = (LAS float*)(lds0 + M_ML) + (wid * 32 + r32) * 2;
#pragma unroll
        for (int d = 0; d < 2; ++d)
#pragma unroll
            for (int g = 0; g < 4; ++g) *(LAS f32x4*)(MO + d * 32 + 8 * g + 4 * hi) = (f32x4){o[d][4 * g], o[d][4 * g + 1], o[d][4 * g + 2], o[d][4 * g + 3]};
        if (hi == 0) { ML[0] = rref; ML[1] = l; }
    }
    __syncthreads();
    {
        const int q = tid >> 4, c4 = (tid & 15) * 4;
        const LAS float* ML = (const LAS float*)(lds0 + M_ML) + q * 2; const LAS float* MO = (const LAS float*)(lds0 + M_O) + q * 64 + c4;
        float M = ML[0];
#pragma unroll
        for (int w = 1; w < 8; ++w) M = fmaxf(M, ML[w * 64]);
        float L = 0.f; f32x4 acc = (f32x4){0.f, 0.f, 0.f, 0.f};
#pragma unroll
        for (int w = 0; w < 8; ++w) { const float f = __builtin_amdgcn_exp2f(ML[w * 64] - M); L += ML[w * 64 + 1] * f; acc = acc + *(const LAS f32x4*)(MO + w * 2048) * f; }
        const float inv = 1.0f / L;
        *(u32x2*)((char*)(mixed + (size_t)row0 * 1024 + (FOX ? 512 : 0) + h * 64) + (unsigned)(q * 1024 + c4) * 2u) = (u32x2){pk2(acc.x * inv, acc.y * inv), pk2(acc.z * inv, acc.w * inv)};
    }
}

#define XB_TMO      128
#define XB_XCNT(j)  (256  + 64 * (j))
#define XB_XSUB(j)  (1280 + 64 * (j))
#define XB_XGEN(j)  (2304 + 64 * (j))
#define XB_TOP      3328
#define XB_TOPGEN   3392
#define XCD_BAR_WORDS 3456
#define XB_SPIN_CAP (1u << 18)

__device__ __forceinline__ unsigned xb_ld(unsigned* p)              { return __hip_atomic_load(p, __ATOMIC_RELAXED, __HIP_MEMORY_SCOPE_AGENT); }
__device__ __forceinline__ unsigned xb_add(unsigned* p, unsigned v) { return __hip_atomic_fetch_add(p, v, __ATOMIC_RELAXED, __HIP_MEMORY_SCOPE_AGENT); }
__device__ __forceinline__ unsigned xb_xcc_id() { return (unsigned)__builtin_amdgcn_s_getreg((3 << 11) | 20) & 0xFu; }
#define XB_SPIN(cond, bar) do { unsigned _sp = 0; while (cond) { __builtin_amdgcn_s_sleep(1); \
    if ((++_sp & 255u) == 0u) { if (xb_ld(&(bar)[XB_TMO])) break; if (_sp > XB_SPIN_CAP) { atomicAdd(&(bar)[XB_TMO], 1u); break; } } } } while (0)

struct XcdBarrier {
    unsigned* bar; unsigned x;
    volatile LAS unsigned* st;
};

__device__ __forceinline__ XcdBarrier xcd_barrier_post(unsigned* bar, volatile LAS unsigned* st) {
    XcdBarrier b; b.bar = bar; b.x = xb_xcc_id(); b.st = st;
    if (threadIdx.x == 0) (void)xb_add(&bar[XB_XCNT(b.x)], 1u);
    return b;
}
__device__ __forceinline__ void xcd_barrier_complete(unsigned* bar, unsigned x, unsigned& nloc, unsigned& nx) {
    const unsigned G = gridDim.x * gridDim.y * gridDim.z;
    unsigned sum, cnt, mine, sp = 0u;
    for (;;) {
        sum = 0u; cnt = 0u; mine = 0u;
#pragma unroll
        for (unsigned j = 0; j < 16; ++j) { const unsigned c = xb_ld(&bar[XB_XCNT(j)]); sum += c; cnt += (c > 0u) ? 1u : 0u; mine = (j == x) ? c : mine; }
        if (sum == G) break;
        __builtin_amdgcn_s_sleep(1);
        if ((++sp & 255u) == 0u) { if (xb_ld(&bar[XB_TMO])) break; if (sp > XB_SPIN_CAP) { atomicAdd(&bar[XB_TMO], 1u); break; } }
    }
    nloc = mine > 0u ? mine : 1u; nx = cnt > 0u ? cnt : 1u;
}

__device__ __forceinline__ void xcd_barrier(const XcdBarrier& b) {
    asm volatile("s_waitcnt vmcnt(0)" ::: "memory");
    __syncthreads();
    if (threadIdx.x == 0) {
        unsigned* bar = b.bar;
        __builtin_amdgcn_s_waitcnt(0);
        unsigned nloc = b.st[0], nx = b.st[1];
        if (nloc == 0u) { xcd_barrier_complete(bar, b.x, nloc, nx); b.st[0] = nloc; b.st[1] = nx; }
        const unsigned old = xb_add(&bar[XB_XSUB(b.x)], 1u);
        const unsigned gen = old / nloc;
        if (old + 1u == (gen + 1u) * nloc) {
            __builtin_amdgcn_fence(__ATOMIC_RELEASE, "agent");
            asm volatile("s_waitcnt vmcnt(0)" ::: "memory");
            const unsigned og = xb_add(&bar[XB_TOP], 1u);
            const unsigned tg = og / nx;
            if (og + 1u == (tg + 1u) * nx) xb_add(&bar[XB_TOPGEN], 1u);
            else XB_SPIN(xb_ld(&bar[XB_TOPGEN]) == tg, bar);
            __builtin_amdgcn_fence(__ATOMIC_ACQUIRE, "agent");
            xb_add(&bar[XB_XGEN(b.x)], 1u);
            asm volatile("s_waitcnt vmcnt(0)" ::: "memory");
        } else {
            XB_SPIN(xb_ld(&bar[XB_XGEN(b.x)]) == gen, bar);
            __builtin_amdgcn_fence(__ATOMIC_ACQUIRE, "agent");
            asm volatile("s_waitcnt vmcnt(0)" ::: "memory");
        }
    }
    __syncthreads();
}


constexpr size_t WS_XBAR = 800 * 1024;
constexpr int LDS_XB = LDS_BYTES - 64;
constexpr int NPHASE = 10;
__global__ void __launch_bounds__(512, 2) mega_fwd(Params p) {
    extern __shared__ __attribute__((aligned(16))) unsigned char lds_raw[];
    LAS unsigned char* lds = (LAS unsigned char*)lds_raw;
    __builtin_assume(__builtin_amdgcn_workitem_id_y() == 0); __builtin_assume(__builtin_amdgcn_workitem_id_z() == 0);
    cg::grid_group grid = cg::this_grid();
    unsigned char* ws = p.ws;
    const int tid = threadIdx.x, lane = tid & 63, wid = __builtin_amdgcn_readfirstlane(tid >> 6);
    const int G = gridDim.x, gw = blockIdx.x * 8 + wid, NGW = G * 8, gt = blockIdx.x * 512 + tid, NGT = G * 512;
    const int lo = p.ph_lo, hi = p.ph_hi;
    if (threadIdx.x < 2) ((volatile LAS unsigned*)(lds + LDS_XB))[threadIdx.x] = 0u;
    __syncthreads();
    XcdBarrier xbar; xbar.bar = (unsigned*)(ws + WS_XBAR); xbar.x = 0; xbar.st = nullptr;
    if (hi - lo > 1) xbar = xcd_barrier_post((unsigned*)(ws + WS_XBAR), (volatile LAS unsigned*)(lds + LDS_XB));
#ifdef PH_ONLY
#define IN(k) ((k) == PH_ONLY && lo <= (k) && (k) < hi)
#else
#define IN(k) (lo <= (k) && (k) < hi)
#endif
#define SEAM(k) do { if (IN(k) && IN((k) + 1)) { if ((k) == 0) grid.sync(); else xcd_barrier(xbar); } } while (0)
#define PHASE_IDS() int tid_q = threadIdx.x; asm volatile("" : "+v"(tid_q)); const int lane = tid_q & 63, gt = blockIdx.x * 512 + tid_q; (void)gt; (void)lane

    if (IN(0)) {
        PHASE_IDS();
        LAS float* scr = (LAS float*)(lds + wid * 8448);
        constexpr int I_IN = 16 * 70, I_UQ = 6 * 24, I_UKV = 4 * 32, I_OUT = 16 * 32, I_G = 16 * 88, I_D = 44 * 32;
        constexpr int NITEMS = I_IN + I_UQ + I_UKV + I_OUT + 2 * I_G + I_D;
        for (int it = gw; it < NITEMS; it += NGW) {
            int r = it;
            if (r < I_IN) { p0_transpose_item(p.in[9], 1024, DIN, ((bf16_t*)(ws + WS_WIN)), 1, scr, r, lane); continue; } r -= I_IN;
            if (r < I_UQ) { p0_transpose_item(p.in[12], 384, 768, ((bf16_t*)(ws + WS_WUQ)), 4, scr, r, lane); continue; } r -= I_UQ;
            if (r < I_UKV) { p0_transpose_item(p.in[14], 256, 1024, ((bf16_t*)(ws + WS_WUKV)), 0, scr, r, lane); continue; } r -= I_UKV;
            if (r < I_OUT) { p0_transpose_item(p.in[15], 1024, 1024, ((bf16_t*)(ws + WS_WOUT)), 0, scr, r, lane); continue; } r -= I_OUT;
            if (r < I_G) { p0_transpose_item(p.in[17], 1024, DFF, ((bf16_t*)(ws + WS_WGU)), 2, scr, r, lane, p.in[16]); continue; } r -= I_G;
            if (r < I_G) { p0_transpose_item(p.in[18], 1024, DFF, ((bf16_t*)(ws + WS_WGU)), 3, scr, r, lane, p.in[16]); continue; } r -= I_G;
            p0_transpose_item(p.in[19], DFF, 1024, ((bf16_t*)(ws + WS_WDN)), 0, scr, r, lane);
        }
        if (gt < 16) ((unsigned*)(ws + WS_KINF))[gt] = 0u;
        for (int c = gt; c < RT; c += NGT) { ((float*)(ws + WS_SS1))[c] = 0.f; ((float*)(ws + WS_SS2))[c] = 0.f; }
        for (int c = gt; c < 88 * 128; c += NGT) ((u32x4*)(((bf16_t*)(ws + WS_WIN)) + (size_t)680 * 1024))[c] = (u32x4){0, 0, 0, 0};
        bf16_t* XN = (bf16_t*)(ws + WS_XN);
        for (int r0 = gw; r0 < RT; r0 += 2 * NGW) {
            const int r1 = r0 + NGW;
            const float* xa = x_of_row(p, r0); const float* xb = r1 < RT ? x_of_row(p, r1) : nullptr;
            if (xa && xb) { norm_rows2_to_bf16(xa, xb, p.in[8], XN + (size_t)r0 * DM, XN + (size_t)r1 * DM, lane); continue; }
#pragma unroll 1
            for (int k = 0; k < 2; ++k) { const int r = k ? r1 : r0; if (r >= RT) break; const float* xr = k ? xb : xa;
                if (xr) norm_row_to_bf16(xr, p.in[8], XN + (size_t)r * DM, lane);
                else { ((u32x4*)(XN + (size_t)r * DM))[lane] = (u32x4){0, 0, 0, 0}; ((u32x4*)(XN + (size_t)r * DM))[lane + 64] = (u32x4){0, 0, 0, 0}; } }
        }
        for (int i = gt; i < LP * 16; i += NGT) rope_entry((float*)(ws + WS_ROPE), i);
        { const float* cl = p.in[2]; bf16_t* CLAT = (bf16_t*)(ws + WS_CLAT);
          for (int c = gt; c < 131072 * 32; c += NGT) { const f32x4 a = ((const f32x4*)cl)[2 * (size_t)c], b2 = ((const f32x4*)cl)[2 * (size_t)c + 1]; ((u32x4*)CLAT)[c] = pack8(a, b2); }
          const float* ck = p.in[3]; bf16_t* CKR = (bf16_t*)(ws + WS_CKR);
          for (int c = gt; c < 131072 * 4; c += NGT) { const f32x4 a = ((const f32x4*)ck)[2 * (size_t)c], b2 = ((const f32x4*)ck)[2 * (size_t)c + 1]; ((u32x4*)CKR)[c] = pack8(a, b2); } }
        for (int g = gw; g < 4096; g += NGW) cache_cum_group(p.in[6], (float*)(ws + WS_CLC), (float*)(ws + WS_CTT), g, lane);
    }
    SEAM(0);
    if (IN(1)) {
        { pg8::Gemm g{(const bf16_t*)(ws + WS_XN), ((bf16_t*)(ws + WS_WIN)), RT, 2304, 1024}; pg8::StaticOrder S; S.init(RT, 2304, G, (int)blockIdx.x);
          EpiG1 E{(bf16_t*)(ws + WS_PROJC), (bf16_t*)(ws + WS_FQ), (bf16_t*)(ws + WS_FKH), (bf16_t*)(ws + WS_FVH), p.out, (unsigned*)(ws + WS_KINF)};
          pg8::gemm_phase<EpiG1, pg8::StaticOrder, false, true>(lds, g, S, E); }
        { pg8::Gemm g{(const bf16_t*)(ws + WS_CLAT), ((bf16_t*)(ws + WS_WUKV)), 131072, 1024, 256}; pg8::StaticOrder S; S.init(131072, 1024, G, (int)blockIdx.x);
          EpiKV E{(bf16_t*)(ws + WS_KNC), (bf16_t*)(ws + WS_VMC), (size_t)131072};
          pg8::gemm_phase<EpiKV, pg8::StaticOrder, false, true>(lds, g, S, E); }
    }
    SEAM(1);
    if (IN(2)) { PHASE_IDS(); for (int gi = gw; gi < NGRP; gi += NGW) p2_group(p, gi, lane); }
    SEAM(2);
    if (IN(3)) {
        { pg8::Gemm g{(const bf16_t*)(ws + WS_CQN), ((bf16_t*)(ws + WS_WUQ)), RT, 768, 384}; pg8::StaticOrder S; S.init(RT, 768, G, (int)blockIdx.x);
          EpiBf16 E{(bf16_t*)(ws + WS_QMLA), 768};
          pg8::gemm_phase<EpiBf16, pg8::StaticOrder, false, true>(lds, g, S, E); }
        { pg8::Gemm g{(const bf16_t*)(ws + WS_LATN), ((bf16_t*)(ws + WS_WUKV)), RT, 1024, 256}; pg8::StaticOrder S; S.init(RT, 1024, G, (int)blockIdx.x);
          EpiKV E{(bf16_t*)(ws + WS_KNH), (bf16_t*)(ws + WS_VMH), (size_t)RT};
          pg8::gemm_phase<EpiKV, pg8::StaticOrder, false, true>(lds, g, S, E); }
    }
    SEAM(3);
    if (IN(4)) {
        const int bx = blockIdx.x;
        if (G == 256) {
#pragma unroll 1
            for (int r = 15; r >= 0; --r) {
                if (r == (bx & 15)) {
#pragma unroll 1
                    for (int k = 0; k < 2; ++k) { const int u = 2 * bx + k, sb = u >> 4, h = u & 7;
                        if ((u >> 3) & 1) attn_sample_unit<true>(p, lds, sb, h); else attn_sample_unit<false>(p, lds, sb, h); }
                }
                const int j = r >> 1, type = (r ^ bx) & 1, bh = (bx >> 1) & 63, q4 = (bx & 1) + 2 * (bx >> 7), qb = 4 * j + ((j & 1) ? 3 - q4 : q4);
                if (type) attn_prompt_unit<true>(p, lds, bh >> 3, (bh + j) & 7, qb); else attn_prompt_unit<false>(p, lds, bh >> 3, bh & 7, qb);
            }
        } else {
            for (int su = 2 * bx; su < 512; su += 2 * G) {
#pragma unroll 1
                for (int k = 0; k < 2; ++k) { const int u = su + k, sb = u >> 4, h = u & 7;
                    if ((u >> 3) & 1) attn_sample_unit<true>(p, lds, sb, h); else attn_sample_unit<false>(p, lds, sb, h); }
            }
            for (int ui = bx; ui < 4096; ui += G) {
                const int qb = 31 - (ui >> 7), c = ui & 127, type = c >> 6, b = (c >> 3) & 7, h = c & 7;
                if (type) attn_prompt_unit<true>(p, lds, b, h, qb); else attn_prompt_unit<false>(p, lds, b, h, qb);
            }
        }
    }
    SEAM(4);
    if (IN(5)) {
        pg8::Gemm g{(const bf16_t*)(ws + WS_MIXED), ((bf16_t*)(ws + WS_WOUT)), RT, 1024, 1024}; pg8::StaticOrder S; S.init(RT, 1024, G, (int)blockIdx.x);
        EpiRes E{p.in[0], p.in[1], (bf16_t*)(ws + WS_HN), (float*)(ws + WS_SS1)};
        pg8::gemm_phase<EpiRes, pg8::StaticOrder, true, true>(lds, g, S, E);
    }
    if (IN(5) && IN(7)) xcd_barrier(xbar);
    if (IN(7)) {
        pg8::Gemm g{(const bf16_t*)(ws + WS_HN), ((bf16_t*)(ws + WS_WGU)), RT, 2 * DFF, 1024}; pg8::StaticOrder S; S.init(RT, 2 * DFF, G, (int)blockIdx.x);
        EpiSwiglu E{(bf16_t*)(ws + WS_ACT), (const float*)(ws + WS_SS1)};
        pg8::gemm_phase<EpiSwiglu, pg8::StaticOrder, true, true>(lds, g, S, E);
    }
    SEAM(7);
    if (IN(8)) {
        pg8::Gemm g{(const bf16_t*)(ws + WS_ACT), ((bf16_t*)(ws + WS_WDN)), RS0, 1024, DFF, 0}; pg8::StaticOrder S; S.init(RS0, 1024, G, (int)blockIdx.x);
        EpiAcc E{(bf16_t*)(ws + WS_HN), (float*)(ws + WS_SS2)};
        pg8::gemm_phase<EpiAcc, pg8::StaticOrder, true, true>(lds, g, S, E);
        { pg8::Gemm g2{(const bf16_t*)(ws + WS_ACT), ((bf16_t*)(ws + WS_WDN)), RT, 1024, 256, DFF}; SplitOrder S2{(int)blockIdx.x};
          EpiPart E2{(float*)(ws + WS_XPART)};
          pg8::gemm_phase<EpiPart, SplitOrder, false, true>(lds, g2, S2, E2); }
    }
    SEAM(8);
    if (IN(9)) {
        PHASE_IDS();
        const bf16_t* x2b = (const bf16_t*)(ws + WS_HN); const float* ss2 = (const float*)(ws + WS_SS2); const float* g = p.in[20];
        f32x4 gg[4];
#pragma unroll
        for (int j = 0; j < 4; ++j) gg[j] = ((const f32x4*)g)[4 * lane + j];
        for (int r = RS0 + gw; r < RM0; r += NGW) {
            const u32x4 w0 = ((const u32x4*)(x2b + (size_t)r * DM))[2 * lane], w1 = ((const u32x4*)(x2b + (size_t)r * DM))[2 * lane + 1];
            f32x4 v[4];
            v[0] = (f32x4){__uint_as_float(w0.x << 16), __uint_as_float(w0.x & 0xffff0000u), __uint_as_float(w0.y << 16), __uint_as_float(w0.y & 0xffff0000u)};
            v[1] = (f32x4){__uint_as_float(w0.z << 16), __uint_as_float(w0.z & 0xffff0000u), __uint_as_float(w0.w << 16), __uint_as_float(w0.w & 0xffff0000u)};
            v[2] = (f32x4){__uint_as_float(w1.x << 16), __uint_as_float(w1.x & 0xffff0000u), __uint_as_float(w1.y << 16), __uint_as_float(w1.y & 0xffff0000u)};
            v[3] = (f32x4){__uint_as_float(w1.z << 16), __uint_as_float(w1.z & 0xffff0000u), __uint_as_float(w1.w << 16), __uint_as_float(w1.w & 0xffff0000u)};
            const float* xp = (const float*)(ws + WS_XPART) + (size_t)(r - RS0) * 1024 + 16 * lane;
#pragma unroll 1
            for (int ks = 0; ks < 11; ++ks) {
#pragma unroll
                for (int j = 0; j < 4; ++j) v[j] = v[j] + ((const f32x4*)(xp + (size_t)ks * 1024 * 1024))[j]; }
            float sq = 0.f;
#pragma unroll
            for (int j = 0; j < 4; ++j) sq += (v[j].x * v[j].x + v[j].y * v[j].y) + (v[j].z * v[j].z + v[j].w * v[j].w);
            const float rstd = 1.0f / sqrtf(wave_sum(sq) * (1.0f / DM) + EPS);
            f32x4* o4 = (f32x4*)(p.out + (size_t)r * DM) + 4 * lane;
#pragma unroll
            for (int j = 0; j < 4; ++j) o4[j] = v[j] * rstd * gg[j];
        }
        for (int rb = gw; rb < RS0; rb += 4 * NGW) {
            u32x4 w0[4], w1[4]; float sr[4];
#pragma unroll
            for (int k = 0; k < 4; ++k) { const int r = rb + k * NGW; const u32x4* src = (const u32x4*)(x2b + (size_t)(r < RS0 ? r : rb) * DM); w0[k] = src[2 * lane]; w1[k] = src[2 * lane + 1]; sr[k] = ss2[r < RS0 ? r : rb]; }
#pragma unroll
            for (int k = 0; k < 4; ++k) { const int r = rb + k * NGW; if (r >= RS0) break;
                const float rstd = 1.0f / sqrtf(sr[k] * (1.0f / DM) + EPS);
                f32x4* o4 = (f32x4*)(p.out + (size_t)r * DM) + 4 * lane;
                o4[0] = (f32x4){__uint_as_float(w0[k].x << 16), __uint_as_float(w0[k].x & 0xffff0000u), __uint_as_float(w0[k].y << 16), __uint_as_float(w0[k].y & 0xffff0000u)} * rstd * gg[0];
                o4[1] = (f32x4){__uint_as_float(w0[k].z << 16), __uint_as_float(w0[k].z & 0xffff0000u), __uint_as_float(w0[k].w << 16), __uint_as_float(w0[k].w & 0xffff0000u)} * rstd * gg[1];
                o4[2] = (f32x4){__uint_as_float(w1[k].x << 16), __uint_as_float(w1[k].x & 0xffff0000u), __uint_as_float(w1[k].y << 16), __uint_as_float(w1[k].y & 0xffff0000u)} * rstd * gg[2];
                o4[3] = (f32x4){__uint_as_float(w1[k].z << 16), __uint_as_float(w1[k].z & 0xffff0000u), __uint_as_float(w1[k].w << 16), __uint_as_float(w1[k].w & 0xffff0000u)} * rstd * gg[3];
            }
        }
    }
#undef IN
#undef SEAM
}

#ifndef MK_N_LAUNCHES
#define MK_N_LAUNCHES 1
#endif
extern "C" void kernel_launch(void* const* d_in, const int* in_sizes, int n_in, void* d_out, int out_size, void* d_ws, size_t ws_size, hipStream_t stream) {
    static int grid = 0;
    if (grid == 0) {
        if (n_in != 21 || (size_t)out_size != O_END || ws_size < WS_END) { fprintf(stderr, "kernel_launch: unexpected shapes n_in %d out %d ws %zu (need %zu)\n", n_in, out_size, ws_size, (size_t)WS_END); grid = -1; return; }
        int dev = 0, cus = 0, per_cu = 0;
        hipGetDevice(&dev); hipDeviceGetAttribute(&cus, hipDeviceAttributeMultiprocessorCount, dev);
        if (hipFuncSetAttribute((const void*)mega_fwd, hipFuncAttributeMaxDynamicSharedMemorySize, LDS_BYTES) != hipSuccess) { fprintf(stderr, "kernel_launch: hipFuncSetAttribute failed\n"); grid = -1; return; }
        if (hipOccupancyMaxActiveBlocksPerMultiprocessor(&per_cu, (const void*)mega_fwd, 512, LDS_BYTES) != hipSuccess || per_cu < 1) { fprintf(stderr, "kernel_launch: occupancy query says %d\n", per_cu); per_cu = 1; }
        (void)hipGetLastError();
        grid = cus;
    }
    if (grid < 0) return;
    Params prm{};
    for (int i = 0; i < 21; ++i) prm.in[i] = (const float*)d_in[i];
    prm.out = (float*)d_out; prm.ws = (unsigned char*)d_ws;
#if MK_N_LAUNCHES == 1
    (void)hipMemsetAsync((unsigned char*)d_ws + WS_XBAR, 0, 16384, stream);
    prm.ph_lo = 0; prm.ph_hi = NPHASE;
    void* args[] = {&prm};
    hipError_t e = hipLaunchCooperativeKernel((const void*)mega_fwd, dim3(grid), dim3(512), args, LDS_BYTES, stream);
    if (e != hipSuccess) fprintf(stderr, "cooperative launch failed: %s (grid %d)\n", hipGetErrorString(e), grid);
#ifdef PROBE_EXTRA_PHASE
    { Params q2 = prm; q2.ph_lo = PROBE_EXTRA_PHASE; q2.ph_hi = PROBE_EXTRA_PHASE + 1; hipLaunchKernelGGL(mega_fwd, dim3(grid), dim3(512), LDS_BYTES, stream, q2); }
#endif
#else
    for (int k = 0; k < NPHASE; ++k) { prm.ph_lo = k; prm.ph_hi = k + 1; hipLaunchKernelGGL(mega_fwd, dim3(grid), dim3(512), LDS_BYTES, stream, prm); }
#endif
}
```

```cpp
#include <hip/hip_runtime.h>
#include <hip/hip_cooperative_groups.h>
#include <cstdio>
#include <cstdint>
namespace cg = cooperative_groups;
namespace pg8 {
#define PG8_LAS __attribute__((address_space(3)))
typedef unsigned short bf16_t;
typedef short bf16x8 __attribute__((ext_vector_type(8)));
typedef float f32x4 __attribute__((ext_vector_type(4)));
typedef unsigned u32x4 __attribute__((ext_vector_type(4)));
constexpr int BM = 256, BK = 64, HALF = 128, HTB = HALF * BK * 2  , STAGE_BYTES = 8 * HTB, NXCD = 8, WGM = 8;

__host__ __device__ __forceinline__ int lds_byte(int r, int c) { const int st = (r >> 4) * 2 + (c >> 5), rr = r & 15, cc = c & 31, ob = rr * 64 + cc * 2; return st * 1024 + (ob ^ (((ob >> 9) & 1) << 5)); }
__host__ __device__ __forceinline__ void stage_rc(int b, int& R, int& C) { const int st = b / 1024, sb = b % 1024, swz = sb ^ (((sb >> 9) & 1) << 5); R = (st >> 1) * 16 + swz / 64; C = (st & 1) * 32 + (swz % 64) / 2; }
__host__ __device__ __forceinline__ int perm32(int rho) { const int n = rho >> 4, i = rho & 15; return 8 * (i >> 2) + 4 * n + (i & 3); }

struct Unit { int pm, pn, ko; };
struct Gemm { const bf16_t* A; const bf16_t* Bt; int M, N, K, ld; };

struct StaticOrder {
    int nM, nN, nwg, G, c;
    __host__ __device__ void init(int M, int N, int G_, int c_) { nM = M / BM; nN = N / BM; nwg = nM * nN; G = G_; c = c_; }
    __host__ __device__ bool next(int i, Unit& u) const {
        const long L = (long)i * G + c; if (L >= nwg) return false;
        int wgid = (int)L; { const int q = nwg / NXCD, r = nwg % NXCD, xcd = wgid % NXCD, off = wgid / NXCD; wgid = (xcd < r ? xcd * (q + 1) : r * (q + 1) + (xcd - r) * q) + off; }
        const int nig = WGM * nN, gid = wgid / nig, fm = gid * WGM, gsz = (nM - fm) < WGM ? (nM - fm) : WGM;
        u.pm = fm + ((wgid % nig) % gsz); u.pn = (wgid % nig) / gsz; u.ko = 0; return true;
    }
    __device__ __forceinline__ void a_ready(const Unit&) const {}
    __device__ __forceinline__ void done(const Unit&) const {}
};

__device__ __forceinline__ unsigned cvt_pk_bf16(float lo, float hi) { unsigned r; asm volatile("v_cvt_pk_bf16_f32 %0, %1, %2" : "=v"(r) : "v"(lo), "v"(hi)); return r; }
template <class Epi, class Sched, bool ALIGN_EPI = false, bool SP2 = false>
__device__ __forceinline__ void gemm_phase(PG8_LAS unsigned char* lds, const Gemm g, const Sched& S, const Epi& E) {
    int tid_o = threadIdx.x; asm volatile("" : "+v"(tid_o));
    const int tid = tid_o, wid = __builtin_amdgcn_readfirstlane(tid >> 6), lane = tid & 63, wr = wid >> 2, wc = wid & 3, fr = lane & 15, fq = lane >> 4;
    const int K = g.K, nt = K / BK, LD = g.ld ? g.ld : g.K;
    unsigned voffA[2], voffB[2];
#pragma unroll
    for (int i = 0; i < 2; ++i) { int R, C; stage_rc(tid * 16 + i * 8192, R, C); const int Rb = Epi::PERM ? ((R & ~31) + perm32(R & 31)) : R;
        voffA[i] = (unsigned)(R * LD + C) * 2u; voffB[i] = (unsigned)(Rb * LD + C) * 2u; }
    const size_t kstep = (size_t)(BK * 2);
    const size_t hstep = (size_t)HALF * LD * 2;
    const size_t tstep = 2 * hstep;
    const unsigned ldsw = (unsigned)wid * 1024u;
    const int aoff = lds_byte(wr * 64 + fr, fq * 8), boff = lds_byte(wc * 32 + fr, fq * 8);
#define PG8_SA(b, h) (((b) * 2 + (h)) * HTB)
#define PG8_SB(b, h) ((4 + (b) * 2 + (h)) * HTB)
#define PG8_STAGE(bufoff, gbase, voff) do { _Pragma("unroll") for (int _i = 0; _i < 2; ++_i) \
        __builtin_amdgcn_global_load_lds((const unsigned*)((const char*)(gbase) + (voff)[_i]), (PG8_LAS unsigned*)(lds + (bufoff) + ldsw + _i * 8192), 16, 0, 0); } while (0)
#define PG8_LDA(dst, b, h) do { _Pragma("unroll") for (int m = 0; m < 4; ++m) _Pragma("unroll") for (int k = 0; k < 2; ++k) dst[m][k] = *(const PG8_LAS bf16x8*)(lds + PG8_SA(b, h) + aoff + m * 2048 + k * 1024); } while (0)
#define PG8_LDB(dst, b, h) do { _Pragma("unroll") for (int n = 0; n < 2; ++n) _Pragma("unroll") for (int k = 0; k < 2; ++k) dst[n][k] = *(const PG8_LAS bf16x8*)(lds + PG8_SB(b, h) + boff + n * 2048 + k * 1024); } while (0)
#define PG8_MMA(ai, bj, At, Bt) do { __builtin_amdgcn_s_setprio(1); _Pragma("unroll") for (int m = 0; m < 4; ++m) _Pragma("unroll") for (int n = 0; n < 2; ++n) _Pragma("unroll") for (int k = 0; k < 2; ++k) \
        acc[ai][bj][m][n] = __builtin_amdgcn_mfma_f32_16x16x32_bf16(Bt[n][k], At[m][k], acc[ai][bj][m][n], 0, 0, 0); __builtin_amdgcn_s_setprio(0); } while (0)
#define PG8_WAIT_V(n) asm volatile("s_waitcnt vmcnt(" #n ")" ::: "memory")
#define PG8_WAIT_L(n) asm volatile("s_waitcnt lgkmcnt(" #n ")" ::: "memory")
#define PG8_BAR __builtin_amdgcn_s_barrier()
#define PG8_SCHED __builtin_amdgcn_sched_barrier(0)
    Unit cur, nxt; int ui = 0;
    if (!S.next(0, cur)) return;
    f32x4 acc[2][2][4][2];
#pragma unroll
    for (int a = 0; a < 2; ++a)
#pragma unroll
        for (int b = 0; b < 2; ++b)
#pragma unroll
            for (int m = 0; m < 4; ++m)
#pragma unroll
                for (int n = 0; n < 2; ++n) acc[a][b][m][n] = (f32x4){0.f, 0.f, 0.f, 0.f};
    bf16x8 At[4][2], B0[2][2], B1[2][2];
    const char* cA = (const char*)g.A + (size_t)cur.pm * tstep + (size_t)cur.ko * 2; const char* cB = (const char*)g.Bt + (size_t)cur.pn * tstep + (size_t)cur.ko * 2;
    S.a_ready(cur);
    if constexpr (SP2) {
        PG8_STAGE(PG8_SB(0, 0), cB, voffB); PG8_STAGE(PG8_SB(0, 1), cB + hstep, voffB); PG8_STAGE(PG8_SA(0, 0), cA, voffA); PG8_STAGE(PG8_SA(0, 1), cA + hstep, voffA);
        if (wr == 1) PG8_BAR;
        PG8_WAIT_V(2); PG8_BAR;
        PG8_STAGE(PG8_SB(1, 0), cB + kstep, voffB); PG8_STAGE(PG8_SA(1, 0), cA + kstep, voffA); PG8_STAGE(PG8_SB(1, 1), cB + hstep + kstep, voffB);
        PG8_WAIT_V(6); PG8_BAR;
    } else {
        PG8_STAGE(PG8_SB(0, 0), cB, voffB); PG8_STAGE(PG8_SA(0, 0), cA, voffA); PG8_STAGE(PG8_SB(0, 1), cB + hstep, voffB); PG8_STAGE(PG8_SA(0, 1), cA + hstep, voffA);
        if (wr == 1) PG8_BAR;
        PG8_WAIT_V(4); PG8_BAR;
        PG8_STAGE(PG8_SB(1, 0), cB + kstep, voffB); PG8_STAGE(PG8_SA(1, 0), cA + kstep, voffA); PG8_STAGE(PG8_SB(1, 1), cB + hstep + kstep, voffB);
        PG8_WAIT_V(6); PG8_BAR;
    }
    for (;;) {
        const bool has_next = S.next(ui + 1, nxt);
        const char* nA = has_next ? (const char*)g.A + (size_t)nxt.pm * tstep + (size_t)nxt.ko * 2 : cA; const char* nB = has_next ? (const char*)g.Bt + (size_t)nxt.pn * tstep + (size_t)nxt.ko * 2 : cB;
        for (int t = 0; t < nt; t += 2) {
            const bool last = (t == nt - 2);
            const char* a1 = cA + (size_t)(t + 1) * kstep;
            const char* a2 = last ? nA : cA + (size_t)(t + 2) * kstep; const char* b2 = last ? nB : cB + (size_t)(t + 2) * kstep;
            const char* a3 = a2 + kstep; const char* b3 = b2 + kstep;
            if (last && has_next) S.a_ready(nxt);
            if constexpr (SP2) {
            PG8_LDB(B0, 0, 0); PG8_LDB(B1, 0, 1); PG8_SCHED; PG8_LDA(At, 0, 0); PG8_STAGE(PG8_SA(1, 1), a1 + hstep, voffA);
            PG8_WAIT_V(8); PG8_WAIT_L(0); PG8_BAR; PG8_MMA(0, 0, At, B0); PG8_MMA(0, 1, At, B1); PG8_BAR; PG8_SCHED;
            PG8_LDA(At, 0, 1); PG8_STAGE(PG8_SB(0, 0), b2, voffB); PG8_STAGE(PG8_SB(0, 1), b2 + hstep, voffB); PG8_STAGE(PG8_SA(0, 0), a2, voffA);
            PG8_WAIT_V(8); PG8_WAIT_L(0); PG8_BAR; PG8_MMA(1, 0, At, B0); PG8_MMA(1, 1, At, B1); PG8_BAR; PG8_SCHED;
            PG8_LDB(B0, 1, 0); PG8_LDB(B1, 1, 1); PG8_SCHED; PG8_LDA(At, 1, 0); PG8_STAGE(PG8_SA(0, 1), a2 + hstep, voffA);
            PG8_WAIT_V(8); PG8_WAIT_L(0); PG8_BAR; PG8_MMA(0, 0, At, B0); PG8_MMA(0, 1, At, B1); PG8_BAR; PG8_SCHED;
            PG8_LDA(At, 1, 1); PG8_STAGE(PG8_SB(1, 0), b3, voffB); PG8_STAGE(PG8_SB(1, 1), b3 + hstep, voffB); PG8_STAGE(PG8_SA(1, 0), a3, voffA);
            PG8_WAIT_V(8); PG8_WAIT_L(0); PG8_BAR; PG8_MMA(1, 0, At, B0); PG8_MMA(1, 1, At, B1); PG8_BAR; PG8_SCHED;
            } else {
            PG8_LDB(B0, 0, 0); PG8_SCHED; PG8_LDA(At, 0, 0); PG8_STAGE(PG8_SA(1, 1), a1 + hstep, voffA);
            PG8_WAIT_L(8); PG8_BAR; PG8_WAIT_L(0); PG8_MMA(0, 0, At, B0); PG8_BAR; PG8_SCHED;
            PG8_LDB(B1, 0, 1); PG8_STAGE(PG8_SB(0, 0), b2, voffB);
            PG8_BAR; PG8_WAIT_L(0); PG8_MMA(0, 1, At, B1); PG8_BAR;
            PG8_LDA(At, 0, 1); PG8_STAGE(PG8_SA(0, 0), a2, voffA);
            PG8_BAR; PG8_WAIT_L(0); PG8_MMA(1, 0, At, B0); PG8_BAR; PG8_SCHED;
            PG8_STAGE(PG8_SB(0, 1), b2 + hstep, voffB);
            PG8_WAIT_V(6); PG8_BAR; PG8_MMA(1, 1, At, B1); PG8_BAR;
            PG8_LDB(B0, 1, 0); PG8_SCHED; PG8_LDA(At, 1, 0); PG8_STAGE(PG8_SA(0, 1), a2 + hstep, voffA);
            PG8_WAIT_L(8); PG8_BAR; PG8_WAIT_L(0); PG8_MMA(0, 0, At, B0); PG8_BAR; PG8_SCHED;
            PG8_LDB(B1, 1, 1); PG8_STAGE(PG8_SB(1, 0), b3, voffB);
            PG8_BAR; PG8_WAIT_L(0); PG8_MMA(0, 1, At, B1); PG8_BAR;
            PG8_LDA(At, 1, 1); PG8_STAGE(PG8_SA(1, 0), a3, voffA);
            PG8_BAR; PG8_WAIT_L(0); PG8_MMA(1, 0, At, B0); PG8_BAR; PG8_SCHED;
            PG8_STAGE(PG8_SB(1, 1), b3 + hstep, voffB);
            PG8_WAIT_V(6); PG8_BAR; PG8_MMA(1, 1, At, B1); PG8_BAR;
            }
        }
        if constexpr (ALIGN_EPI) { if (wr == 0) PG8_BAR; }
        if constexpr (!Epi::AFTER_DRAIN) { E(acc, cur, wr, wc, fr, fq); S.done(cur); }
        if (!has_next) break;
#pragma unroll
        for (int a = 0; a < 2; ++a)
#pragma unroll
            for (int b = 0; b < 2; ++b)
#pragma unroll
                for (int m = 0; m < 4; ++m)
#pragma unroll
                    for (int n = 0; n < 2; ++n) acc[a][b][m][n] = (f32x4){0.f, 0.f, 0.f, 0.f};
        cur = nxt; cA = nA; cB = nB; ++ui;
        if constexpr (ALIGN_EPI) { if (wr == 1) PG8_BAR; }
    }
    PG8_WAIT_V(0);
    if constexpr (!ALIGN_EPI) { if (wr == 0) PG8_BAR; }
    PG8_BAR;
    if constexpr (Epi::AFTER_DRAIN) { E.fused(acc, cur, wr, wc, fr, fq, lds, wid, lane); S.done(cur); }
#undef PG8_SA
#undef PG8_SB
#undef PG8_STAGE
#undef PG8_LDA
#undef PG8_LDB
#undef PG8_MMA
#undef PG8_WAIT_V
#undef PG8_WAIT_L
#undef PG8_BAR
#undef PG8_SCHED
}
}

#define DI __device__ __forceinline__
#define LAS __attribute__((address_space(3)))
typedef unsigned short bf16_t;
typedef short bf16x8 __attribute__((ext_vector_type(8)));
typedef short s16x4 __attribute__((ext_vector_type(4)));
typedef float f32x4 __attribute__((ext_vector_type(4)));
typedef float f32x16 __attribute__((ext_vector_type(16)));
typedef unsigned u32x4 __attribute__((ext_vector_type(4)));
typedef unsigned u32x2 __attribute__((ext_vector_type(2)));
typedef float f32x2_t __attribute__((ext_vector_type(2)));
typedef __bf16 bf16x2_t __attribute__((ext_vector_type(2)));
typedef short v4i16_t __attribute__((ext_vector_type(4)));
typedef int i32x4 __attribute__((ext_vector_type(4)));

constexpr int DM = 1024, NB = 8, SEQ = 8192, NMETA = 16, LP = 8208, SBN = 32, SSN = 32, PAST = 4096;
constexpr int RS0 = 65536, RM0 = 66560, RV = 66576, RT = 66816;
constexpr int DFF = 2816, DIN = 2216;
constexpr int NGRP = 2081;
constexpr float EPS = 1e-6f, LOG2E = 1.4426950408889634f;
constexpr float QS_FOX = 0.125f * LOG2E;
constexpr float QS_MLA = 0.10206207261596577f * LOG2E;
constexpr float NEGF = -1e30f;

constexpr size_t O_YP = 0, O_YS = O_YP + (size_t)NB * SEQ * DM, O_LATP = O_YS + (size_t)SBN * SSN * DM, O_KRP = O_LATP + (size_t)NB * LP * 256,
                 O_FKP = O_KRP + (size_t)NB * LP * 32, O_FVP = O_FKP + (size_t)NB * LP * 512, O_LFP = O_FVP + (size_t)NB * LP * 512,
                 O_LATS = O_LFP + (size_t)NB * LP * 8, O_KRS = O_LATS + (size_t)1024 * 256, O_FKS = O_KRS + (size_t)1024 * 32,
                 O_FVS = O_FKS + (size_t)1024 * 512, O_LFS = O_FVS + (size_t)1024 * 512, O_END = O_LFS + (size_t)1024 * 8;

constexpr size_t MiB = 1u << 20;
constexpr size_t WS_SS2 = 524288;
constexpr size_t WS_SS1 = 4096;
constexpr size_t WS_KINF = 0;
constexpr size_t WS_ROPE = 1 * MiB, WS_LC = 3 * MiB, WS_CLC = 6 * MiB, WS_TT = 10 * MiB, WS_CTT = 10 * MiB + 512 * 1024;
constexpr size_t WS_WIN = 11 * MiB, WS_WUQ = 16 * MiB, WS_WUKV = 17 * MiB, WS_WOUT = 18 * MiB, WS_WGU = 20 * MiB, WS_WDN = 31 * MiB;
constexpr size_t WS_XN = 37 * MiB;
constexpr size_t WS_CQN = WS_XN, WS_LATN = WS_XN + 50 * MiB, WS_MIXED = WS_XN;
constexpr size_t WS_PROJC = 168 * MiB;
constexpr size_t WS_QMLA = WS_PROJC;
constexpr size_t WS_KR = 266 * MiB;
constexpr size_t WS_CKR = 271 * MiB;
constexpr size_t WS_CLAT = 279 * MiB;
constexpr size_t WS_FQKV = 343 * MiB;
constexpr size_t WS_KVX = 539 * MiB;
constexpr size_t WS_KVXC = 670 * MiB;
constexpr size_t WS_XPART = 928 * MiB;
constexpr size_t WS_END = 972 * MiB;
constexpr size_t HM_BYTES = (size_t)RT * 512 * 2;
constexpr size_t WS_FQ = WS_FQKV, WS_FKH = WS_FQKV + HM_BYTES, WS_FVH = WS_FQKV + 2 * HM_BYTES;
constexpr size_t WS_KNH = WS_KVX, WS_VMH = WS_KVX + HM_BYTES;
constexpr size_t WS_KNC = WS_KVXC, WS_VMC = WS_KVXC + 128 * MiB;
static_assert(WS_FVH + HM_BYTES <= WS_KVX && WS_VMH + HM_BYTES <= WS_KVXC, "ws map");
constexpr size_t WS_HN = WS_FQKV;
constexpr size_t WS_ACT = WS_FQKV + 131 * MiB;
static_assert(WS_ACT + (size_t)RT * DFF * 2 <= WS_END, "ws map");
static_assert(WS_LATN + (size_t)RT * 256 * 2 <= WS_PROJC && WS_CQN + (size_t)RT * 384 * 2 <= WS_LATN, "ws map");

constexpr int LDS_BYTES = 147456;

struct Params { const float* in[21]; float* out; unsigned char* ws; int ph_lo, ph_hi; };

DI unsigned pk2(float lo, float hi) { f32x2_t v = {lo, hi}; bf16x2_t b = __builtin_convertvector(v, bf16x2_t); return __builtin_bit_cast(unsigned, b); }
DI float bf2f(unsigned short x) { return __uint_as_float((unsigned)x << 16); }
DI u32x4 pack8(f32x4 a, f32x4 b) { return (u32x4){pk2(a.x, a.y), pk2(a.z, a.w), pk2(b.x, b.y), pk2(b.z, b.w)}; }
DI float wave_sum(float v) {
#pragma unroll
    for (int o = 1; o < 64; o <<= 1) v += __shfl_xor(v, o);
    return v;
}
DI int row_pos(int row) { return row < RS0 ? NMETA + (row & 8191) : (row < RM0 ? PAST + ((row - RS0) & 31) : (row < RV ? row - RM0 : 0)); }
DI const float* x_of_row(const Params& p, int row) {
    return row < RS0 ? p.in[0] + (size_t)row * DM : (row < RM0 ? p.in[1] + (size_t)(row - RS0) * DM : (row < RV ? p.in[7] + (size_t)(row - RM0) * DM : nullptr));
}
DI void out_store8(float* outp, float* outs, int width, int row, int cc, f32x4 v0, f32x4 v1) {
    if (row < RS0) { const int b = row >> 13, t = row & 8191; float* d = outp + (size_t)(b * LP + NMETA + t) * width + cc; *(f32x4*)d = v0; *(f32x4*)(d + 4) = v1; }
    else if (row < RM0) { float* d = outs + (size_t)(row - RS0) * width + cc; *(f32x4*)d = v0; *(f32x4*)(d + 4) = v1; }
    else if (row < RV) { const int m = row - RM0;
#pragma unroll 1
        for (int b = 0; b < NB; ++b) { float* d = outp + (size_t)(b * LP + m) * width + cc; *(f32x4*)d = v0; *(f32x4*)(d + 4) = v1; } }
}

struct EpiG1 {
    static constexpr bool PERM = true, AFTER_DRAIN = false;
    bf16_t* projc; bf16_t* fqp; bf16_t* fkh; bf16_t* fvh; float* out; unsigned* kinf;
    DI void operator()(const f32x4 (&acc)[2][2][4][2], const pg8::Unit& u, int wr, int wc, int fr, int fq) const {
        const int pn = u.pn;
        float kmx[2] = {0.f, 0.f};
#pragma unroll
        for (int ai = 0; ai < 2; ++ai)
#pragma unroll
            for (int m = 0; m < 4; ++m) {
                const int row = u.pm * 256 + ai * 128 + wr * 64 + m * 16 + fr;
#pragma unroll
                for (int bj = 0; bj < 2; ++bj) {
                    const int col8 = bj * 128 + wc * 32 + 8 * fq;
                    f32x4 v0 = acc[ai][bj][m][0], v1 = acc[ai][bj][m][1];
                    if (pn < 3) { *(u32x4*)(projc + (size_t)row * 768 + pn * 256 + col8) = pack8(v0, v1); }
                    else {
                        const int c = (pn - 3) * 256 + col8;
                        if (pn < 5) *(u32x4*)(fqp + (size_t)row * 512 + c) = pack8(v0, v1);
                        else { char* base = (char*)((pn < 7 ? fkh : fvh) + (size_t)(((pn - 5) & 1) * 4 + bj * 2 + (wc >> 1)) * RT * 64);
                               *(u32x4*)(base + (unsigned)(row * 64 + (wc & 1) * 32 + 8 * fq) * 2u) = pack8(v0, v1); }
                        if (pn == 5 || pn == 6) {
                            float q2 = (v0.x * v0.x + v0.y * v0.y) + (v0.z * v0.z + v0.w * v0.w) + (v1.x * v1.x + v1.y * v1.y) + (v1.z * v1.z + v1.w * v1.w);
                            q2 += __shfl_xor(q2, 16); q2 += __shfl_xor(q2, 32);
                            kmx[bj] = fmaxf(kmx[bj], q2); }
                        if (pn >= 5) { const int which = (pn - 5) >> 1, cc = ((pn - 5) & 1) * 256 + col8;
                            out_store8(out + (which ? O_FVP : O_FKP), out + (which ? O_FVS : O_FKS), 512, row, cc, v0, v1); }
                    }
                }
            }
        if (pn == 5 || pn == 6) {
#pragma unroll
            for (int bj = 0; bj < 2; ++bj) { float m = kmx[bj];
#pragma unroll
                for (int o = 1; o < 64; o <<= 1) m = fmaxf(m, __shfl_xor(m, o));
                if ((fr | (fq << 4)) == 0) atomicMax(kinf + ((pn - 5) * 4 + bj * 2 + (wc >> 1)) * 2 + (wc & 1), __float_as_uint(m)); }
        }
    }
};
struct EpiBf16 {
    static constexpr bool PERM = true, AFTER_DRAIN = false;
    bf16_t* O; int ldc;
    DI void operator()(const f32x4 (&acc)[2][2][4][2], const pg8::Unit& u, int wr, int wc, int fr, int fq) const {
#pragma unroll
        for (int ai = 0; ai < 2; ++ai)
#pragma unroll
            for (int m = 0; m < 4; ++m) {
                const int row = u.pm * 256 + ai * 128 + wr * 64 + m * 16 + fr;
#pragma unroll
                for (int bj = 0; bj < 2; ++bj) {
                    const int col = u.pn * 256 + bj * 128 + wc * 32 + 8 * fq;
                    *(u32x4*)(O + (size_t)row * ldc + col) = pack8(acc[ai][bj][m][0], acc[ai][bj][m][1]);
                }
            }
    }
};
struct EpiKV {
    static constexpr bool PERM = true, AFTER_DRAIN = false;
    bf16_t* kn; bf16_t* vm; size_t nrows;
    DI void operator()(const f32x4 (&acc)[2][2][4][2], const pg8::Unit& u, int wr, int wc, int fr, int fq) const {
        const int d = (wc & 1) * 32 + 8 * fq;
#pragma unroll
        for (int bj = 0; bj < 2; ++bj) {
            char* base = (char*)(((wc >> 1) ? vm : kn) + (size_t)(u.pn * 2 + bj) * nrows * 64);
#pragma unroll
            for (int ai = 0; ai < 2; ++ai)
#pragma unroll
                for (int m = 0; m < 4; ++m) {
                    const int row = u.pm * 256 + ai * 128 + wr * 64 + m * 16 + fr;
                    *(u32x4*)(base + (unsigned)(row * 64 + d) * 2u) = pack8(acc[ai][bj][m][0], acc[ai][bj][m][1]);
                }
        }
    }
};
struct EpiQ {
    static constexpr bool PERM = false, AFTER_DRAIN = false;
    bf16_t* O; const float* rope;
    DI void operator()(const f32x4 (&acc)[2][2][4][2], const pg8::Unit& u, int wr, int wc, int fr, int fq) const {
#pragma unroll
        for (int bj = 0; bj < 2; ++bj) {
            const int g = u.pn * 8 + bj * 4 + wc;
            const bool is_rope = (g % 3) == 2;
#pragma unroll
            for (int ai = 0; ai < 2; ++ai)
#pragma unroll
                for (int m = 0; m < 4; ++m) {
                    const int row = u.pm * 256 + ai * 128 + wr * 64 + m * 16 + fr;
                    f32x4 a = acc[ai][bj][m][0], b = acc[ai][bj][m][1];
                    if (is_rope) {
                        const float* t = rope + (size_t)row_pos(row) * 32;
                        const f32x4 c = *(const f32x4*)(t + 4 * fq), s = *(const f32x4*)(t + 16 + 4 * fq);
                        const f32x4 o1 = a * c - b * s, o2 = b * c + a * s; a = o1; b = o2;
                    }
                    a = a * QS_MLA; b = b * QS_MLA;
                    bf16_t* d = O + (size_t)row * 768 + g * 32 + 4 * fq;
                    *(u32x2*)d = (u32x2){pk2(a.x, a.y), pk2(a.z, a.w)};
                    *(u32x2*)(d + 16) = (u32x2){pk2(b.x, b.y), pk2(b.z, b.w)};
                }
        }
    }
};
struct EpiRes {
    static constexpr bool PERM = true, AFTER_DRAIN = false;
    const float* xp; const float* xs; bf16_t* x1b; float* ss;
    DI void operator()(const f32x4 (&acc)[2][2][4][2], const pg8::Unit& u, int wr, int wc, int fr, int fq) const {
#pragma unroll
        for (int ai = 0; ai < 2; ++ai)
#pragma unroll
            for (int m = 0; m < 4; ++m) {
                const int row = u.pm * 256 + ai * 128 + wr * 64 + m * 16 + fr;
                float q = 0.f;
                if (row < RM0) {
                    const float* xr = row < RS0 ? xp + (size_t)row * DM : xs + (size_t)(row - RS0) * DM;
#pragma unroll
                    for (int bj = 0; bj < 2; ++bj) {
                        const int col = u.pn * 256 + bj * 128 + wc * 32 + 8 * fq;
                        const f32x4 y0 = *(const f32x4*)(xr + col) + acc[ai][bj][m][0], y1 = *(const f32x4*)(xr + col + 4) + acc[ai][bj][m][1];
                        q += (y0.x * y0.x + y0.y * y0.y) + (y0.z * y0.z + y0.w * y0.w) + (y1.x * y1.x + y1.y * y1.y) + (y1.z * y1.z + y1.w * y1.w);
                        *(u32x4*)(x1b + (size_t)row * DM + col) = pack8(y0, y1);
                    }
                }
                q += __shfl_xor(q, 16); q += __shfl_xor(q, 32);
                if (fq == 0 && row < RM0) atomicAdd(ss + row, q);
            }
    }
};
struct SplitOrder {
    int c, nsl;
    DI bool next(int i, pg8::Unit& u) const { if (i != 0 || c >= 16 * nsl) return false; u.pm = 256 + c / (4 * nsl); u.pn = (c / nsl) & 3; u.ko = (c % nsl) * 256; return true; }
    DI void a_ready(const pg8::Unit&) const {}
    DI void done(const pg8::Unit&) const {}
};
struct EpiPart {
    static constexpr bool PERM = true, AFTER_DRAIN = false;
    float* xp;
    DI void operator()(const f32x4 (&acc)[2][2][4][2], const pg8::Unit& u, int wr, int wc, int fr, int fq) const {
        float* base = xp + (size_t)(u.ko >> 8) * 1024 * 1024;
#pragma unroll
        for (int ai = 0; ai < 2; ++ai)
#pragma unroll
            for (int m = 0; m < 4; ++m) {
                const int rs = (u.pm - 256) * 256 + ai * 128 + wr * 64 + m * 16 + fr;
#pragma unroll
                for (int bj = 0; bj < 2; ++bj) {
                    float* d = base + (size_t)rs * 1024 + u.pn * 256 + bj * 128 + wc * 32 + 8 * fq;
                    *(f32x4*)d = acc[ai][bj][m][0]; *(f32x4*)(d + 4) = acc[ai][bj][m][1];
                }
            }
    }
};
struct EpiAcc {
    static constexpr bool PERM = true, AFTER_DRAIN = false;
    bf16_t* x1b; float* ss;
    DI void operator()(const f32x4 (&acc)[2][2][4][2], const pg8::Unit& u, int wr, int wc, int fr, int fq) const {
#pragma unroll
        for (int ai = 0; ai < 2; ++ai)
#pragma unroll
            for (int m = 0; m < 4; ++m) {
                const int row = u.pm * 256 + ai * 128 + wr * 64 + m * 16 + fr;
                float q = 0.f;
                if (row < RM0) {
#pragma unroll
                    for (int bj = 0; bj < 2; ++bj) {
                        const int col = u.pn * 256 + bj * 128 + wc * 32 + 8 * fq;
                        bf16_t* d = x1b + (size_t)row * DM + col;
                        const u32x4 w = *(const u32x4*)d;
                        const f32x4 y0 = (f32x4){__uint_as_float(w.x << 16), __uint_as_float(w.x & 0xffff0000u), __uint_as_float(w.y << 16), __uint_as_float(w.y & 0xffff0000u)} + acc[ai][bj][m][0];
                        const f32x4 y1 = (f32x4){__uint_as_float(w.z << 16), __uint_as_float(w.z & 0xffff0000u), __uint_as_float(w.w << 16), __uint_as_float(w.w & 0xffff0000u)} + acc[ai][bj][m][1];
                        q += (y0.x * y0.x + y0.y * y0.y) + (y0.z * y0.z + y0.w * y0.w) + (y1.x * y1.x + y1.y * y1.y) + (y1.z * y1.z + y1.w * y1.w);
                        *(u32x4*)d = pack8(y0, y1);
                    }
                }
                q += __shfl_xor(q, 16); q += __shfl_xor(q, 32);
                if (fq == 0 && row < RM0) atomicAdd(ss + row, q);
            }
    }
};
DI float silu_mul(float g, float u) { return g * u * __builtin_amdgcn_rcpf(1.0f + __builtin_amdgcn_exp2f(-g * LOG2E)); }
struct EpiSwiglu {
    static constexpr bool PERM = true, AFTER_DRAIN = false;
    bf16_t* O; const float* ss;
    DI void operator()(const f32x4 (&acc)[2][2][4][2], const pg8::Unit& u, int wr, int wc, int fr, int fq) const {
#pragma unroll
        for (int ai = 0; ai < 2; ++ai)
#pragma unroll
            for (int m = 0; m < 4; ++m) {
                const int row = u.pm * 256 + ai * 128 + wr * 64 + m * 16 + fr;
                const float rstd = 1.0f / sqrtf(ss[row] * (1.0f / DM) + EPS);
                const f32x4 g0 = acc[ai][0][m][0] * rstd, g1 = acc[ai][0][m][1] * rstd, u0 = acc[ai][1][m][0] * rstd, u1 = acc[ai][1][m][1] * rstd;
                f32x4 a0, a1;
#pragma unroll
                for (int i = 0; i < 4; ++i) { a0[i] = silu_mul(g0[i], u0[i]); a1[i] = silu_mul(g1[i], u1[i]); }
                *(u32x4*)(O + (size_t)row * DFF + u.pn * 128 + wc * 32 + 8 * fq) = pack8(a0, a1);
            }
    }
};

DI int wmap(int kind, int n) {
    if (kind == 0 || kind == 4) return n;
    if (kind == 1) return n < 384 ? 256 + n : (n < 640 ? n - 384 : (n < 672 ? n : (n < 2208 ? n + 96 : n - 1536)));
    if (kind == 2) return 256 * (n >> 7) + (n & 127);
    return 256 * (n >> 7) + 128 + (n & 127);
}
DI float wscale(int kind, int n) { return kind == 4 ? QS_MLA : ((kind == 1 && n >= 672 && n < 1184) ? QS_FOX : 1.0f); }
DI void p0_transpose_item(const float* W, int K, int N, bf16_t* WT, int kind, LAS float* scr, int item, int lane, const float* kscale = nullptr) {
    const int nblk = (N + 31) / 32, kb = item / nblk, nb = item % nblk, k0 = 64 * kb, n0 = 32 * nb;
    const int nl = n0 + (lane & 31);
    const float wsc = wscale(kind, nl);
#pragma unroll 8
    for (int i = 0; i < 32; ++i) { const int kk = 2 * i + (lane >> 5); scr[kk * 33 + (lane & 31)] = (nl < N) ? W[(size_t)(k0 + kk) * N + nl] * (kscale ? wsc * kscale[k0 + kk] : wsc) : 0.f; }
    asm volatile("s_waitcnt lgkmcnt(0)" ::: "memory");
    const int c = lane & 7;
#pragma unroll
    for (int j = 0; j < 4; ++j) { const int n = (lane >> 3) + 8 * j; const LAS float* s = scr + (8 * c) * 33 + n;
        u32x4 o; o.x = pk2(s[0 * 33], s[1 * 33]); o.y = pk2(s[2 * 33], s[3 * 33]); o.z = pk2(s[4 * 33], s[5 * 33]); o.w = pk2(s[6 * 33], s[7 * 33]);
        if (n0 + n < N) *(u32x4*)(WT + (size_t)wmap(kind, n0 + n) * K + k0 + 8 * c) = o; }
    asm volatile("s_waitcnt lgkmcnt(0)" ::: "memory");
}
DI void norm_row_to_bf16(const float* xrow, const float* g, bf16_t* orow, int lane) {
    f32x4 v[4]; float s = 0.f;
#pragma unroll
    for (int j = 0; j < 4; ++j) { v[j] = ((const f32x4*)xrow)[lane + 64 * j]; s += (v[j].x * v[j].x + v[j].y * v[j].y) + (v[j].z * v[j].z + v[j].w * v[j].w); }
    const float rstd = 1.0f / sqrtf(wave_sum(s) * (1.0f / DM) + EPS);
#pragma unroll
    for (int j = 0; j < 4; ++j) { const f32x4 gg = ((const f32x4*)g)[lane + 64 * j]; const f32x4 y = v[j] * rstd * gg;
        ((u32x2*)orow)[lane + 64 * j] = (u32x2){pk2(y.x, y.y), pk2(y.z, y.w)}; }
}
DI void norm_rows2_to_bf16(const float* x0, const float* x1, const float* g, bf16_t* o0, bf16_t* o1, int lane) {
    f32x4 v[4], w[4]; float s = 0.f, t = 0.f;
#pragma unroll
    for (int j = 0; j < 4; ++j) { v[j] = ((const f32x4*)x0)[lane + 64 * j]; w[j] = ((const f32x4*)x1)[lane + 64 * j]; }
#pragma unroll
    for (int j = 0; j < 4; ++j) { s += (v[j].x * v[j].x + v[j].y * v[j].y) + (v[j].z * v[j].z + v[j].w * v[j].w); t += (w[j].x * w[j].x + w[j].y * w[j].y) + (w[j].z * w[j].z + w[j].w * w[j].w); }
#pragma unroll
    for (int o = 1; o < 64; o <<= 1) { s += __shfl_xor(s, o); t += __shfl_xor(t, o); }
    const float rs = 1.0f / sqrtf(s * (1.0f / DM) + EPS), rt = 1.0f / sqrtf(t * (1.0f / DM) + EPS);
#pragma unroll
    for (int j = 0; j < 4; ++j) { const f32x4 gg = ((const f32x4*)g)[lane + 64 * j]; const f32x4 y = v[j] * rs * gg, z = w[j] * rt * gg;
        ((u32x2*)o0)[lane + 64 * j] = (u32x2){pk2(y.x, y.y), pk2(y.z, y.w)}; ((u32x2*)o1)[lane + 64 * j] = (u32x2){pk2(z.x, z.y), pk2(z.z, z.w)}; }
}
DI void rope_entry(float* tab, int idx) {
    const int pos = idx >> 4, i = idx & 15;
    double inv = 1.0; for (int k = 0; k < i; ++k) inv *= 0.5623413251903491;
    const double ang = (double)pos * inv;
    const double k2 = __builtin_rint(ang * 0.15915494309189535);
    double r = __builtin_fma(-k2, 6.283185307179586, ang); r = __builtin_fma(-k2, 2.4492935982947064e-16, r);
    const double q = __builtin_rint(r * 0.6366197723675814);
    const double y = __builtin_fma(-q, 1.5707963267948966, r), y2 = y * y;
    double sp = 1.0 / 6227020800.0; sp = sp * y2 - 1.0 / 39916800.0; sp = sp * y2 + 1.0 / 362880.0; sp = sp * y2 - 1.0 / 5040.0; sp = sp * y2 + 1.0 / 120.0; sp = sp * y2 - 1.0 / 6.0; sp = sp * y2 + 1.0;
    const double sn = sp * y;
    double cp = -1.0 / 87178291200.0; cp = cp * y2 + 1.0 / 479001600.0; cp = cp * y2 - 1.0 / 3628800.0; cp = cp * y2 + 1.0 / 40320.0; cp = cp * y2 - 1.0 / 720.0; cp = cp * y2 + 1.0 / 24.0; cp = cp * y2 - 0.5; cp = cp * y2 + 1.0;
    const int qi = ((int)q) & 3;
    const double s = (qi == 0) ? sn : (qi == 1) ? cp : (qi == 2) ? -sn : -cp;
    const double c = (qi == 0) ? cp : (qi == 1) ? -sn : (qi == 2) ? -cp : sn;
    tab[pos * 32 + i] = (float)c; tab[pos * 32 + 16 + i] = (float)s;
}
DI void cache_cum_group(const float* lf, float* clc, float* ctt, int g, int lane) {
    f32x4 v = ((const f32x4*)(lf + (size_t)g * 256))[lane];
#pragma unroll
    for (int off = 2; off < 64; off <<= 1) {
        f32x4 t; t.x = __shfl_up(v.x, off); t.y = __shfl_up(v.y, off); t.z = __shfl_up(v.z, off); t.w = __shfl_up(v.w, off);
        if (lane >= off) v = v + t;
    }
    ((f32x4*)(clc + (size_t)g * 256))[lane] = v;
    if (lane >= 62) *(f32x4*)(ctt + (size_t)g * 8 + 4 * (lane & 1)) = v;
}
DI float log_sigmoid(float z) { return fminf(z, 0.f) - log1pf(expf(-fabsf(z))); }

DI void p2_group(const Params& p, int gi, int lane) {
    unsigned char* ws = p.ws;
    const bf16_t* projc = (const bf16_t*)(ws + WS_PROJC);
    bf16_t* cqn = (bf16_t*)(ws + WS_CQN); bf16_t* latn = (bf16_t*)(ws + WS_LATN); bf16_t* krb = (bf16_t*)(ws + WS_KR);
    const float* rope = (const float*)(ws + WS_ROPE); float* LC = (float*)(ws + WS_LC); float* TT = (float*)(ws + WS_TT);
    const float* qn = p.in[11]; const float* kvn = p.in[13]; const float* bfg = p.in[10];
    const int row0 = gi * 32, nrows = (gi == NGRP - 1) ? 16 : 32;
    f32x4 g0a, g0b, g1a, g1b;
    if (lane < 32) { g0a = *(const f32x4*)(kvn + 8 * lane); g0b = *(const f32x4*)(kvn + 8 * lane + 4); }
    else { g0a = *(const f32x4*)(qn + 8 * (lane - 32)); g0b = *(const f32x4*)(qn + 8 * (lane - 32) + 4); }
    if (lane < 16) { g1a = *(const f32x4*)(qn + 256 + 8 * lane); g1b = *(const f32x4*)(qn + 256 + 8 * lane + 4); } else { g1a = (f32x4){0, 0, 0, 0}; g1b = g1a; }
    const float bfl = bfg[lane & 7];
    float run1 = 0.f;
#pragma unroll 1
    for (int rr0 = 0; rr0 < nrows; rr0 += 4) {
      u32x4 w0s[4], w1s[4];
#pragma unroll
      for (int k = 0; k < 4; ++k) { const bf16_t* pr = projc + (size_t)(row0 + rr0 + k) * 768;
          w0s[k] = *(const u32x4*)(pr + 8 * lane); w1s[k] = (u32x4){0, 0, 0, 0}; if (lane < 32) w1s[k] = *(const u32x4*)(pr + 512 + 8 * lane); }
#pragma unroll
      for (int k = 0; k < 4; ++k) {
        const int row = row0 + rr0 + k;
        const u32x4 w0 = w0s[k], w1 = w1s[k];
        float a[8], b[8];
#pragma unroll
        for (int i = 0; i < 4; ++i) { a[2 * i] = __uint_as_float(w0[i] << 16); a[2 * i + 1] = __uint_as_float(w0[i] & 0xffff0000u);
                                      b[2 * i] = __uint_as_float(w1[i] << 16); b[2 * i + 1] = __uint_as_float(w1[i] & 0xffff0000u); }
        float sa = 0.f, sb = 0.f;
#pragma unroll
        for (int i = 0; i < 8; ++i) { sa += a[i] * a[i]; sb += b[i] * b[i]; }
        float skv = (lane < 32) ? sa : 0.f, sq = ((lane >= 32) ? sa : 0.f) + ((lane < 16) ? sb : 0.f);
        skv = wave_sum(skv); sq = wave_sum(sq);
        const float rkv = 1.0f / sqrtf(skv * (1.0f / 256.0f) + EPS), rq = 1.0f / sqrtf(sq * (1.0f / 384.0f) + EPS);
        const float r0 = (lane < 32) ? rkv : rq;
        f32x4 y0 = (f32x4){a[0], a[1], a[2], a[3]} * r0 * g0a, y1 = (f32x4){a[4], a[5], a[6], a[7]} * r0 * g0b;
        if (lane < 32) { *(u32x4*)(latn + (size_t)row * 256 + 8 * lane) = pack8(y0, y1);
            out_store8(p.out + O_LATP, p.out + O_LATS, 256, row, 8 * lane, y0, y1); }
        else { *(u32x4*)(cqn + (size_t)row * 384 + 8 * (lane - 32)) = pack8(y0, y1); }
        if (lane < 16) { f32x4 z0 = (f32x4){b[0], b[1], b[2], b[3]} * rq * g1a, z1 = (f32x4){b[4], b[5], b[6], b[7]} * rq * g1b;
            *(u32x4*)(cqn + (size_t)row * 384 + 256 + 8 * lane) = pack8(z0, z1); }
        float ob[8];
#pragma unroll
        for (int i = 0; i < 8; ++i) ob[i] = __shfl_xor(b[i], 2);
        if (lane >= 16 && lane < 20) {
            const int pos = row_pos(row); const bool first = lane < 18; const int j0 = 8 * (lane - (first ? 16 : 18));
            const float* t = rope + (size_t)pos * 32 + j0;
            const f32x4 c0 = *(const f32x4*)t, c1 = *(const f32x4*)(t + 4), s0 = *(const f32x4*)(t + 16), s1 = *(const f32x4*)(t + 20);
            float cc[8] = {c0.x, c0.y, c0.z, c0.w, c1.x, c1.y, c1.z, c1.w}, ss[8] = {s0.x, s0.y, s0.z, s0.w, s1.x, s1.y, s1.z, s1.w};
            float o[8];
#pragma unroll
            for (int i = 0; i < 8; ++i) o[i] = first ? (b[i] * cc[i] - ob[i] * ss[i]) : (b[i] * cc[i] + ob[i] * ss[i]);
            const f32x4 o0 = (f32x4){o[0], o[1], o[2], o[3]}, o1 = (f32x4){o[4], o[5], o[6], o[7]};
            *(u32x4*)(krb + (size_t)row * 32 + 8 * (lane - 16)) = pack8(o0, o1);
            out_store8(p.out + O_KRP, p.out + O_KRS, 32, row, 8 * (lane - 16), o0, o1);
        }
        {
            float z = 0.f;
#pragma unroll
            for (int i = 0; i < 8; ++i) { const float t = __shfl(b[i], 20); if ((lane & 7) == i) z = t; }
            const float lf = log_sigmoid(z + bfl);
            run1 += lf;
            if (lane < 8) {
                LC[(size_t)row * 8 + lane] = run1;
                if (row < RS0) { const int bb = row >> 13, t = row & 8191; p.out[O_LFP + (size_t)(bb * LP + NMETA + t) * 8 + lane] = lf; }
                else if (row < RM0) { p.out[O_LFS + (size_t)(row - RS0) * 8 + lane] = lf; }
                else { const int m = row - RM0;
#pragma unroll 1
                    for (int bb = 0; bb < NB; ++bb) p.out[O_LFP + (size_t)(bb * LP + m) * 8 + lane] = lf; }
            }
        }
      }
    }
    if (lane < 8) TT[(size_t)gi * 8 + lane] = run1;
}

template <int DK> struct ACfg { static constexpr int NK = (DK == 64) ? 5 : 6, KP = (DK == 64) ? 176 : 208; };
constexpr int VP = 192;
constexpr float THR = 8.0f;
#define MFMA32(a, b, c) __builtin_amdgcn_mfma_f32_32x32x16_bf16((a), (b), (c), 0, 0, 0)
DI int crow(int r, int hi) { return (r & 3) + 8 * (r >> 2) + 4 * hi; }
DI s16x4 vtr(const LAS unsigned char* p) { return __builtin_bit_cast(s16x4, __builtin_amdgcn_ds_read_tr16_b64_v4i16((LAS v4i16_t*)p)); }
DI float bf16_round(float x) { return __uint_as_float(pk2(x, 0.f) << 16); }
DI u32x4 bias_chunk(float bv) {
    const unsigned h = pk2(bv, 0.f) & 0xffffu; const float r1 = bv - __uint_as_float(h << 16);
    const unsigned m = pk2(r1, 0.f) & 0xffffu; const float r2 = r1 - __uint_as_float(m << 16);
    const unsigned l = pk2(r2, 0.f) & 0xffffu;
    return (u32x4){0x3F80u | (h << 16), m | (l << 16), 0u, 0u};
}
DI void rope_qfrag(bf16x8& x1, bf16x8& x2, const float* t) {
    const f32x4 c0 = *(const f32x4*)t, c1 = *(const f32x4*)(t + 4), s0 = *(const f32x4*)(t + 16), s1 = *(const f32x4*)(t + 20);
    const float cc[8] = {c0.x, c0.y, c0.z, c0.w, c1.x, c1.y, c1.z, c1.w}, ss[8] = {s0.x, s0.y, s0.z, s0.w, s1.x, s1.y, s1.z, s1.w};
    float o1[8], o2[8];
#pragma unroll
    for (int i = 0; i < 8; ++i) { const float a = bf2f((unsigned short)x1[i]), b = bf2f((unsigned short)x2[i]); o1[i] = a * cc[i] - b * ss[i]; o2[i] = b * cc[i] + a * ss[i]; }
    const u32x4 w1 = (u32x4){pk2(o1[0], o1[1]), pk2(o1[2], o1[3]), pk2(o1[4], o1[5]), pk2(o1[6], o1[7])};
    const u32x4 w2 = (u32x4){pk2(o2[0], o2[1]), pk2(o2[2], o2[3]), pk2(o2[4], o2[5]), pk2(o2[6], o2[7])};
    x1 = __builtin_bit_cast(bf16x8, w1); x2 = __builtin_bit_cast(bf16x8, w2);
}
template <int DK, bool FOX>
DI void load_qfrags(const Params& p, int qrow0  , int r32, int h, int hi, bf16x8 (&qf)[DK / 16 + 1]) {
    unsigned char* ws = p.ws;
    const char* qb_ = FOX ? (const char*)((const bf16_t*)(ws + WS_FQ) + (size_t)qrow0 * 512 + h * 64) : (const char*)((const bf16_t*)(ws + WS_QMLA) + (size_t)qrow0 * 768 + h * 96);
    const unsigned qo = (unsigned)(r32 * (FOX ? 512 : 768) + 8 * hi) * 2u;
#pragma unroll
    for (int d0 = 0; d0 < DK / 16; ++d0) qf[d0] = *(const bf16x8*)(qb_ + qo + 32 * d0);
    if (!FOX) { const char* rt_ = (const char*)((const float*)(ws + WS_ROPE) + (size_t)row_pos(qrow0) * 32); rope_qfrag(qf[DK / 16 - 2], qf[DK / 16 - 1], (const float*)(rt_ + (unsigned)(r32 * 32 + 8 * hi) * 4u)); }
    const u32x4 ex = hi == 0 ? (u32x4){0x3F800000u, 0x3F803F80u, 0u, 0u} : (u32x4){0u, 0u, 0u, 0u};
    qf[DK / 16] = __builtin_bit_cast(bf16x8, ex);
}
template <int DK, int NKB>
DI void attn_qk(const LAS unsigned char* Kb, const bf16x8 (&qf)[DK / 16 + 1], f32x16 (&s)[NKB], int lane, const f32x16& negm) {
    constexpr int NK = ACfg<DK>::NK, KP = ACfg<DK>::KP;
    const LAS unsigned char* kp = Kb + (lane & 31) * KP + (lane >> 5) * 16;
    f32x16 z;
#pragma unroll
    for (int r = 0; r < 16; ++r) z[r] = (DK == 64) ? 0.f : negm[r];
#pragma unroll
    for (int d0 = 0; d0 < NK; ++d0)
#pragma unroll
        for (int blk = 0; blk < NKB; ++blk) {
            const bf16x8 kf = *(const LAS bf16x8*)(kp + blk * 32 * KP + d0 * 32);
            s[blk] = MFMA32(kf, qf[d0], d0 == 0 ? z : s[blk]);
        }
}
template <int NKB, bool CINIT>
DI void attn_sm_a(f32x16 (&s)[NKB], f32x16 (&o)[2], float& rref, float& l, bf16x8& qfx, bool first, int maskmode, int mparam, int lane, float& rmin, f32x16& negm) {
    const int r32 = lane & 31, hi = lane >> 5;
    if (CINIT && maskmode == 1) {
#pragma unroll
        for (int blk = 0; blk < NKB; ++blk)
#pragma unroll
            for (int r = 0; r < 16; ++r) if (blk * 32 + crow(r, hi) < 48) s[blk][r] = NEGF;
    }
    if (maskmode == 2) {
        const int lim = mparam + r32;
#pragma unroll
        for (int blk = 0; blk < NKB; ++blk)
#pragma unroll
            for (int r = 0; r < 16; ++r) if (blk * 32 + crow(r, hi) > lim) s[blk][r] = NEGF;
    }
    float mx = s[0][0];
#pragma unroll
    for (int blk = 0; blk < NKB; ++blk)
#pragma unroll
        for (int r = 0; r < 16; ++r) mx = fmaxf(mx, s[blk][r]);
    mx = fmaxf(mx, __shfl_xor(mx, 32));
    const bool need = first || (mx > THR);
    if (__any(need)) {
        const float rn = need ? bf16_round(rref + mx) : rref;
        const float d = rn - rref; rref = rn;
#pragma unroll
        for (int blk = 0; blk < NKB; ++blk)
#pragma unroll
            for (int r = 0; r < 16; ++r) s[blk][r] -= d;
        const float f = __builtin_amdgcn_exp2f(-d);
        l *= f;
#pragma unroll
        for (int dd = 0; dd < 2; ++dd)
#pragma unroll
            for (int r = 0; r < 16; ++r) o[dd][r] *= f;
        if (CINIT) {
#pragma unroll
            for (int r = 0; r < 16; ++r) negm[r] = -rref;
        } else if (hi == 0) qfx[0] = (short)(pk2(-rref, 0.f) & 0xffffu);
        float mn = rref;
#pragma unroll
        for (int off = 1; off < 64; off <<= 1) mn = fminf(mn, __shfl_xor(mn, off));
        rmin = mn;
    }
}
template <int NKB>
DI void attn_sm_b(f32x16 (&s)[NKB], float& l, bf16x8 (&pf)[NKB][2]) {
    float ls = 0.f;
#pragma unroll
    for (int blk = 0; blk < NKB; ++blk)
#pragma unroll
        for (int r = 0; r < 16; ++r) { s[blk][r] = __builtin_amdgcn_exp2f(s[blk][r]); ls += s[blk][r]; }
    l += ls;
#pragma unroll
    for (int blk = 0; blk < NKB; ++blk)
#pragma unroll
        for (int s2 = 0; s2 < 2; ++s2) {
            const u32x4 w = (u32x4){pk2(s[blk][8 * s2 + 0], s[blk][8 * s2 + 1]), pk2(s[blk][8 * s2 + 2], s[blk][8 * s2 + 3]),
                                    pk2(s[blk][8 * s2 + 4], s[blk][8 * s2 + 5]), pk2(s[blk][8 * s2 + 6], s[blk][8 * s2 + 7])};
            pf[blk][s2] = __builtin_bit_cast(bf16x8, w);
        }
}
template <int NKB>
DI void attn_pv(const LAS unsigned char* Vb, const bf16x8 (&pf)[NKB][2], f32x16 (&o)[2], int lane) {
    const int hi = lane >> 5, q4 = (lane & 15) >> 2, p4 = lane & 3, gb = (lane >> 4) & 1;
    const LAS unsigned char* vp = Vb + (4 * hi + q4) * VP + 32 * gb + 8 * p4;
#pragma unroll
    for (int blk = 0; blk < NKB; ++blk)
#pragma unroll
        for (int s2 = 0; s2 < 2; ++s2)
#pragma unroll
            for (int d = 0; d < 2; ++d) {
                const LAS unsigned char* a = vp + (blk * 32 + 16 * s2) * VP + d * 64;
                const s16x4 lo = vtr(a), hi4 = vtr(a + 8 * VP);
                const bf16x8 vf = __builtin_shufflevector(lo, hi4, 0, 1, 2, 3, 4, 5, 6, 7);
                o[d] = MFMA32(vf, pf[blk][s2], o[d]);
            }
}
template <int NKB>
DI void attn_sm_pv(f32x16 (&s)[NKB], float& l, const LAS unsigned char* Vb, f32x16 (&o)[2], int lane) {
    const int hi = lane >> 5, q4 = (lane & 15) >> 2, p4 = lane & 3, gb = (lane >> 4) & 1;
    const LAS unsigned char* vp = Vb + (4 * hi + q4) * VP + 32 * gb + 8 * p4;
    float ls0 = 0.f, ls1 = 0.f;
#pragma unroll
    for (int blk = 0; blk < NKB; ++blk) {
#pragma unroll
        for (int r = 0; r < 16; r += 2) { s[blk][r] = __builtin_amdgcn_exp2f(s[blk][r]); s[blk][r + 1] = __builtin_amdgcn_exp2f(s[blk][r + 1]); ls0 += s[blk][r]; ls1 += s[blk][r + 1]; }
#pragma unroll
        for (int s2 = 0; s2 < 2; ++s2) {
            const u32x4 w = (u32x4){pk2(s[blk][8 * s2 + 0], s[blk][8 * s2 + 1]), pk2(s[blk][8 * s2 + 2], s[blk][8 * s2 + 3]),
                                    pk2(s[blk][8 * s2 + 4], s[blk][8 * s2 + 5]), pk2(s[blk][8 * s2 + 6], s[blk][8 * s2 + 7])};
            const bf16x8 pfr = __builtin_bit_cast(bf16x8, w);
#pragma unroll
            for (int d = 0; d < 2; ++d) {
                const LAS unsigned char* a = vp + (blk * 32 + 16 * s2) * VP + d * 64;
                const s16x4 lo = vtr(a), hi4 = vtr(a + 8 * VP);
                const bf16x8 vf = __builtin_shufflevector(lo, hi4, 0, 1, 2, 3, 4, 5, 6, 7);
                o[d] = MFMA32(vf, pfr, o[d]);
            }
        }
    }
    l += ls0 + ls1;
}
DI void attn_store_o(bf16_t* orow, const f32x16 (&o)[2], float l, int hi) {
    l = l + __shfl_xor(l, 32);
    const float inv = 1.0f / l;
#pragma unroll
    for (int d = 0; d < 2; ++d)
#pragma unroll
        for (int g = 0; g < 4; ++g)
            *(u32x2*)(orow + d * 32 + 8 * g + 4 * hi) = (u32x2){pk2(o[d][4 * g] * inv, o[d][4 * g + 1] * inv), pk2(o[d][4 * g + 2] * inv, o[d][4 * g + 3] * inv)};
}

constexpr int A_K0 = 0, A_KSZ = 2 * 15360, A_V0 = 2 * A_KSZ, A_VSZ = 2 * 64 * VP, A_TP = A_V0 + 2 * A_VSZ, A_CBN = A_TP + 1024, A_FLG = A_CBN + 64;
template <bool FOX>
DI void attn_prompt_unit(const Params& p, LAS unsigned char* lds, int b, int h, int qb) {
    constexpr int DK = FOX ? 64 : 96, CPR = DK / 8, NK = ACfg<DK>::NK, KP = ACfg<DK>::KP;
    unsigned char* ws = p.ws;
    int tid_o = threadIdx.x; asm volatile("" : "+v"(tid_o));
    const int tid = tid_o, lane = tid & 63, wid = __builtin_amdgcn_readfirstlane(tid >> 6), r32 = lane & 31, hi = lane >> 5;
    const bf16_t* kh = (const bf16_t*)(ws + (FOX ? WS_FKH : WS_KNH)) + (size_t)h * RT * 64; const bf16_t* vh = (const bf16_t*)(ws + (FOX ? WS_FVH : WS_VMH)) + (size_t)h * RT * 64;
    const bf16_t* krb = (const bf16_t*)(ws + WS_KR); const float* LC = (const float*)(ws + WS_LC); const float* TT = (const float*)(ws + WS_TT);
    bf16_t* mixed = (bf16_t*)(ws + WS_MIXED);
    LAS float* TPs = (LAS float*)(lds + A_TP);
    __syncthreads();
    if (FOX && wid == 0) {
        float t[4];
#pragma unroll
        for (int i = 0; i < 4; ++i) t[i] = TT[(size_t)(b * 256 + 4 * lane + i) * 8 + h];
        float e[4]; e[0] = 0.f; e[1] = t[0]; e[2] = t[0] + t[1]; e[3] = e[2] + t[2]; const float tot = e[3] + t[3];
        float inc = tot;
#pragma unroll
        for (int off = 1; off < 64; off <<= 1) { const float v = __shfl_up(inc, off); if (lane >= off) inc += v; }
        const float ex = inc - tot;
#pragma unroll
        for (int i = 0; i < 4; ++i) TPs[4 * lane + i] = ex + e[i];
    }
    __syncthreads();
    const float ref = FOX ? TPs[8 * qb] : 0.f;
    const float tpmeta = FOX ? -TT[(size_t)(NGRP - 1) * 8 + h] : 0.f;
    const int qrow = b * SEQ + 256 * qb + 32 * wid + r32;
    bf16x8 qf[DK / 16 + 1];
    f32x16 o[2];
#pragma unroll
    for (int r = 0; r < 16; ++r) { o[0][r] = 0.f; o[1][r] = 0.f; }
    float rref = 0.f, l = 0.f, rmin = 0.f, qkb = 0.f;
    f32x16 negm;
#pragma unroll
    for (int r = 0; r < 16; ++r) negm[r] = 0.f;
    LAS float* CBN = (LAS float*)(lds + A_CBN); LAS int* FLG = (LAS int*)(lds + A_FLG);
    bool done = false;
    const int ktmax = 4 * qb + 3, mykt = 4 * qb + (wid >> 1);
    const int vj = tid >> 3, vp = tid & 7, rj = tid >> 2, rp = tid & 3;
    u32x4 rk0_0, rk0_1, rk1_0 = (u32x4){0, 0, 0, 0}, rk1_1 = (u32x4){0, 0, 0, 0}, rv_0, rv_1; float rb_0 = 0.f, rb_1 = 0.f;
#define TROW0(kt) ((kt) < 0 ? RM0 : b * SEQ + 64 * (kt))
#define JOFF(kt, j) ((kt) < 0 ? ((j) >= 48 ? (j) - 48 : 0) : (j))
#define LOADKV(kt, U) do { const int r0_ = TROW0(kt); \
        { const unsigned of_ = (unsigned)(JOFF(kt, vj) * 64 + vp * 8) * 2u; \
          rk0_##U = *(const u32x4*)((const char*)(kh + (size_t)r0_ * 64) + of_); rv_##U = *(const u32x4*)((const char*)(vh + (size_t)r0_ * 64) + of_); } \
        if (!FOX) { \
               if (tid < 256) { const char* rb_ = (const char*)(krb + (size_t)r0_ * 32); rk1_##U = *(const u32x4*)(rb_ + (unsigned)(JOFF(kt, rj) * 32 + rp * 8) * 2u); } } \
        if (tid < 64) { rb_##U = 0.f; \
          if (FOX) { const float tp = (kt) < 0 ? tpmeta : TPs[2 * (kt) + (tid >> 5)]; rb_##U = -(*(const float*)((const char*)(LC + (size_t)r0_ * 8 + h) + (unsigned)JOFF(kt, tid) * 32u) + tp - ref) * LOG2E; } \
          if ((kt) < 0 && tid < 48) rb_##U = NEGF; } \
    } while (0)
#define STOREKV(slot, U) do { LAS unsigned char* B_ = lds + A_K0 + (slot) * A_KSZ + (U) * 64 * KP; \
        *(LAS u32x4*)(B_ + vj * KP + vp * 16) = rk0_##U; \
        if (!FOX && tid < 256) *(LAS u32x4*)(B_ + rj * KP + (8 + rp) * 16) = rk1_##U; \
        if (FOX && tid < 64) { *(LAS u32x4*)(B_ + tid * KP + DK * 2) = bias_chunk(rb_##U); *(LAS u32x4*)(B_ + tid * KP + DK * 2 + 16) = (u32x4){0u, 0u, 0u, 0u}; } \
        *(LAS u32x4*)(lds + A_V0 + (slot) * A_VSZ + (U) * 64 * VP + vj * VP + vp * 16) = rv_##U; \
        if (FOX && tid == 63) CBN[(slot) * 2 + (U)] = rb_##U; \
    } while (0)
#define COMPUTE(kt, slot, U) do { \
        if (FOX && !first && !done && CBN[(slot) * 2 + (U)] + qkb - rmin < -130.0f) done = true;     \
        if ((kt) <= mykt && !done) { \
            const int mm = (FOX && (kt) == mykt) ? 2 : ((!FOX && (kt) < 0) ? 1 : 0); \
            attn_qk<DK, 2>(lds + A_K0 + (slot) * A_KSZ + (U) * 64 * KP, qf, sA, lane, negm); \
            attn_sm_a<2, !FOX>(sA, o, rref, l, qf[DK / 16], first, mm, 32 * (wid & 1), lane, rmin, negm); \
            first = false; \
            attn_sm_pv<2>(sA, l, lds + A_V0 + (slot) * A_VSZ + (U) * 64 * VP, o, lane); } } while (0)
    const int Smax = 2 * qb + 1;
    LOADKV(2 * Smax + 1, 0); LOADKV(2 * Smax, 1);
    load_qfrags<DK, FOX>(p, b * SEQ + 256 * qb + 32 * wid, r32, h, hi, qf);
    if (FOX) {
        float a = 0.f, c = 0.f;
#pragma unroll
        for (int i = 0; i < 8; ++i) { const float x0 = bf2f((unsigned short)qf[0][i]), x1 = bf2f((unsigned short)qf[1][i]), x2 = bf2f((unsigned short)qf[2][i]), x3 = bf2f((unsigned short)qf[3][i]);
            a += x0 * x0 + x1 * x1; c += x2 * x2 + x3 * x3; }
        a += __shfl_xor(a, 32); c += __shfl_xor(c, 32);
#pragma unroll
        for (int off = 1; off < 32; off <<= 1) { a = fmaxf(a, __shfl_xor(a, off)); c = fmaxf(c, __shfl_xor(c, off)); }
        const unsigned* kn2 = (const unsigned*)(ws + WS_KINF) + 2 * h;
        qkb = 1.02f * (sqrtf(a * __uint_as_float(kn2[0])) + sqrtf(c * __uint_as_float(kn2[1])));
    }
    STOREKV(Smax & 1, 0); STOREKV(Smax & 1, 1);
    __syncthreads();
    f32x16 sA[2];
    bool first = true;
    if (wid >= 4) __builtin_amdgcn_s_setprio(1);
#pragma unroll 1
    for (int S = Smax; S >= -1; --S) {
        const int slot = S & 1;
        if (S >= 1) { LOADKV(2 * S - 1, 0); LOADKV(2 * S - 2, 1); } else if (S == 0) { LOADKV(-1, 0); }
        if (S >= 0) { COMPUTE(2 * S + 1, slot, 0); COMPUTE(2 * S, slot, 1); } else { COMPUTE(-1, slot, 0); }
        if (S >= 1) { STOREKV(slot ^ 1, 0); STOREKV(slot ^ 1, 1); } else if (S == 0) { STOREKV(slot ^ 1, 0); }
        if (FOX && lane == 0) FLG[slot * 8 + wid] = done ? 1 : 0;
        __syncthreads();
        if (FOX) { const i32x4 f0 = *(const LAS i32x4*)(FLG + slot * 8), f1 = *(const LAS i32x4*)(FLG + slot * 8 + 4);
            if ((f0.x & f0.y & f0.z & f0.w & f1.x & f1.y & f1.z & f1.w) != 0) break; }
    }
    __builtin_amdgcn_s_setprio(0);
#undef LOADKV
#undef STOREKV
#undef COMPUTE
#undef TROW0
#undef JOFF
    attn_store_o(mixed + (size_t)qrow * 1024 + (FOX ? 512 : 0) + h * 64, o, l, hi);
}

constexpr int SWB = 14336, S_V = 7680, S_TP = S_V + 32 * VP;
constexpr int M_O = 0, M_ML = 65536;
template <bool FOX>
DI void attn_sample_unit(const Params& p, LAS unsigned char* lds0, int sb, int h) {
    constexpr int DK = FOX ? 64 : 96, CPR = DK / 8, NK = ACfg<DK>::NK, KP = ACfg<DK>::KP, NKC = 32 * CPR / 64;
    unsigned char* ws = p.ws;
    int tid_o = threadIdx.x; asm volatile("" : "+v"(tid_o));
    const int tid = tid_o, lane = tid & 63, wid = __builtin_amdgcn_readfirstlane(tid >> 6), r32 = lane & 31, hi = lane >> 5;
    LAS unsigned char* lds = lds0 + wid * SWB;
    const bf16_t* kh = (const bf16_t*)(ws + (FOX ? WS_FKH : WS_KNH)) + (size_t)h * RT * 64; const bf16_t* vh = (const bf16_t*)(ws + (FOX ? WS_FVH : WS_VMH)) + (size_t)h * RT * 64;
    const bf16_t* knc = (const bf16_t*)(ws + WS_KNC) + (size_t)h * 131072 * 64; const bf16_t* vmc = (const bf16_t*)(ws + WS_VMC) + (size_t)h * 131072 * 64;
    const bf16_t* krb = (const bf16_t*)(ws + WS_KR); const bf16_t* ckr = (const bf16_t*)(ws + WS_CKR);
    const float* LC = (const float*)(ws + WS_LC); const float* CLC = (const float*)(ws + WS_CLC); const float* CTT = (const float*)(ws + WS_CTT);
    const float* cfk = p.in[4]; const float* cfv = p.in[5];
    bf16_t* mixed = (bf16_t*)(ws + WS_MIXED);
    LAS float* TPs = (LAS float*)(lds + S_TP);
    __syncthreads();
    float tall = 0.f;
    if (FOX) {
        const float t0 = CTT[(size_t)(sb * 128 + 2 * lane) * 8 + h], t1 = CTT[(size_t)(sb * 128 + 2 * lane + 1) * 8 + h];
        const float tot = t0 + t1; float inc = tot;
#pragma unroll
        for (int off = 1; off < 64; off <<= 1) { const float v = __shfl_up(inc, off); if (lane >= off) inc += v; }
        const float ex = inc - tot;
        TPs[2 * lane] = ex; TPs[2 * lane + 1] = ex + t0;
        tall = __shfl(inc, 63);
    }
    const int row0 = RS0 + sb * 32, qrow = row0 + r32;
    bf16x8 qf[DK / 16 + 1];
    load_qfrags<DK, FOX>(p, row0, r32, h, hi, qf);
    f32x16 o[2];
#pragma unroll
    for (int r = 0; r < 16; ++r) { o[0][r] = 0.f; o[1][r] = 0.f; }
    float rref = 0.f, l = 0.f, rmin = 0.f;
    f32x16 negm;
#pragma unroll
    for (int r = 0; r < 16; ++r) negm[r] = 0.f;
    f32x16 s1[1];
    bool first = true;
    if (wid == 0) {
        const char* nk_ = (const char*)(kh + (size_t)row0 * 64); const char* nv_ = (const char*)(vh + (size_t)row0 * 64);
#pragma unroll
        for (int i = 0; i < 4; ++i) { const unsigned off = (unsigned)(((lane >> 3) + 8 * i) * 64 + (lane & 7) * 8) * 2u;
            *(LAS u32x4*)(lds + (lane >> 3) * KP + (lane & 7) * 16 + i * 8 * KP) = *(const u32x4*)(nk_ + off); *(LAS u32x4*)(lds + S_V + (lane >> 3) * VP + (lane & 7) * 16 + i * 8 * VP) = *(const u32x4*)(nv_ + off); }
        if (!FOX) { const char* nr_ = (const char*)(krb + (size_t)row0 * 32);
#pragma unroll
            for (int i = 0; i < 2; ++i) *(LAS u32x4*)(lds + (lane >> 2) * KP + (8 + (lane & 3)) * 16 + i * 16 * KP) = *(const u32x4*)(nr_ + (unsigned)((lane >> 2) * 32 + (lane & 3) * 8) * 2u + i * 16 * 64); }
        if (FOX && lane < 32) { const float bv = FOX ? -(*(const float*)((const char*)(LC + (size_t)row0 * 8 + h) + (unsigned)lane * 32u)) * LOG2E : 0.f;
            *(LAS u32x4*)(lds + lane * KP + DK * 2) = bias_chunk(bv); *(LAS u32x4*)(lds + lane * KP + DK * 2 + 16) = (u32x4){0u, 0u, 0u, 0u}; }
        asm volatile("s_waitcnt lgkmcnt(0)" ::: "memory");
        attn_qk<DK, 1>(lds, qf, s1, lane, negm);
        attn_sm_a<1, !FOX>(s1, o, rref, l, qf[DK / 16], true, FOX ? 2 : 0, 0, lane, rmin, negm);
        attn_sm_pv<1>(s1, l, lds + S_V, o, lane);
        first = false;
    }
    const size_t crow0 = (size_t)sb * PAST;
    const unsigned ldk0 = (lane >> 3) * KP + (lane & 7) * 16, ldv0 = S_V + (lane >> 3) * VP + (lane & 7) * 16;
    const unsigned so0 = FOX ? (unsigned)((lane >> 3) * 512 + h * 64 + (lane & 7) * 8) * 4u : (unsigned)((lane >> 3) * 64 + (lane & 7) * 8) * 2u;
    constexpr unsigned SROW8 = FOX ? 8u * 512u * 4u : 8u * 64u * 2u;
    if (FOX) {
        f32x4 rk[4][2], rv[4][2]; float rc = 0.f;
#define LOADC(tt) do { const char* kb_ = (const char*)(cfk + (crow0 + 32 * (tt)) * 512); const char* vb_ = (const char*)(cfv + (crow0 + 32 * (tt)) * 512); \
            _Pragma("unroll") for (int i = 0; i < 4; ++i) { const unsigned so_ = so0 + i * SROW8; rk[i][0] = *(const f32x4*)(kb_ + so_); rk[i][1] = *(const f32x4*)(kb_ + so_ + 16); rv[i][0] = *(const f32x4*)(vb_ + so_); rv[i][1] = *(const f32x4*)(vb_ + so_ + 16); } \
            if (lane < 32) rc = *(const float*)((const char*)(CLC + (crow0 + 32 * (tt)) * 8 + h) + (unsigned)lane * 32u); } while (0)
        LOADC(127 - wid);
#pragma unroll 1
        for (int t = 127 - wid; t >= 0; t -= 8) {
#if 0
            for (int i = 0; i < 4; ++i) { const unsigned so_ = so0 + i * SROW8; rk[i][0] = *(const f32x4*)(kb_ + so_); rk[i][1] = *(const f32x4*)(kb_ + so_ + 16); rv[i][0] = *(const f32x4*)(vb_ + so_); rv[i][1] = *(const f32x4*)(vb_ + so_ + 16); }
#endif
#pragma unroll
            for (int i = 0; i < 4; ++i) { *(LAS u32x4*)(lds + ldk0 + i * 8 * KP) = pack8(rk[i][0], rk[i][1]); *(LAS u32x4*)(lds + ldv0 + i * 8 * VP) = pack8(rv[i][0], rv[i][1]); }
            if (lane < 32) { *(LAS u32x4*)(lds + lane * KP + DK * 2) = bias_chunk(-(rc + TPs[t] - tall) * LOG2E); *(LAS u32x4*)(lds + lane * KP + DK * 2 + 16) = (u32x4){0u, 0u, 0u, 0u}; }
            if (t >= 8) LOADC(t - 8);
            asm volatile("s_waitcnt lgkmcnt(0)" ::: "memory");
            attn_qk<DK, 1>(lds, qf, s1, lane, negm);
            attn_sm_a<1, !FOX>(s1, o, rref, l, qf[DK / 16], first, 0, 0, lane, rmin, negm);
            attn_sm_pv<1>(s1, l, lds + S_V, o, lane);
            first = false;
        }
#undef LOADC
    } else {
        const unsigned ro0 = (unsigned)((lane >> 2) * 32 + (lane & 3) * 8) * 2u, rld0 = (lane >> 2) * KP + (8 + (lane & 3)) * 16;
        u32x4 rk[4], rr[2], rv[4];
#define LOADC(tt) do { const char* kb_ = (const char*)(knc + (crow0 + 32 * (tt)) * 64); const char* vb_ = (const char*)(vmc + (crow0 + 32 * (tt)) * 64); const char* rb_ = (const char*)(ckr + (crow0 + 32 * (tt)) * 32); \
            _Pragma("unroll") for (int i = 0; i < 4; ++i) { const unsigned so_ = so0 + i * SROW8; rk[i] = *(const u32x4*)(kb_ + so_); rv[i] = *(const u32x4*)(vb_ + so_); } \
            _Pragma("unroll") for (int i = 0; i < 2; ++i) rr[i] = *(const u32x4*)(rb_ + ro0 + i * 16 * 64); } while (0)
        LOADC(127 - wid);
#pragma unroll 1
        for (int t = 127 - wid; t >= 0; t -= 8) {
#pragma unroll
            for (int i = 0; i < 4; ++i) { *(LAS u32x4*)(lds + ldk0 + i * 8 * KP) = rk[i]; *(LAS u32x4*)(lds + ldv0 + i * 8 * VP) = rv[i]; }
#pragma unroll
            for (int i = 0; i < 2; ++i) *(LAS u32x4*)(lds + rld0 + i * 16 * KP) = rr[i];
            if (t >= 8) LOADC(t - 8);
            asm volatile("s_waitcnt lgkmcnt(0)" ::: "memory");
            attn_qk<DK, 1>(lds, qf, s1, lane, negm);
            attn_sm_a<1, !FOX>(s1, o, rref, l, qf[DK / 16], first, 0, 0, lane, rmin, negm);
            attn_sm_pv<1>(s1, l, lds + S_V, o, lane);
            first = false;
        }
#undef LOADC
    }
    l = l + __shfl_xor(l, 32);
    __syncthreads();
    {
        LAS float* MO = (LAS float*)(lds0 + M_O) + (size_t)(wid * 32 + r32) * 64; LAS float* ML = (LAS float*)(lds0 + M_ML) + (wid * 32 + r32) * 2;
#pragma unroll
        for (int d = 0; d < 2; ++d)
#pragma unroll
            for (int g = 0; g < 4; ++g) *(LAS f32x4*)(MO + d * 32 + 8 * g + 4 * hi) = (f32x4){o[d][4 * g], o[d][4 * g + 1], o[d][4 * g + 2], o[d][4 * g + 3]};
        if (hi == 0) { ML[0] = rref; ML[1] = l; }
    }
    __syncthreads();
    {
        const int q = tid >> 4, c4 = (tid & 15) * 4;
        const LAS float* ML = (const LAS float*)(lds0 + M_ML) + q * 2; const LAS float* MO = (const LAS float*)(lds0 + M_O) + q * 64 + c4;
        float M = ML[0];
#pragma unroll
        for (int w = 1; w < 8; ++w) M = fmaxf(M, ML[w * 64]);
        float L = 0.f; f32x4 acc = (f32x4){0.f, 0.f, 0.f, 0.f};
#pragma unroll
        for (int w = 0; w < 8; ++w) { const float f = __builtin_amdgcn_exp2f(ML[w * 64] - M); L += ML[w * 64 + 1] * f; acc = acc + *(const LAS f32x4*)(MO + w * 2048) * f; }
        const float inv = 1.0f / L;
        *(u32x2*)((char*)(mixed + (size_t)row0 * 1024 + (FOX ? 512 : 0) + h * 64) + (unsigned)(q * 1024 + c4) * 2u) = (u32x2){pk2(acc.x * inv, acc.y * inv), pk2(acc.z * inv, acc.w * inv)};
    }
}

#define XB_TMO      128
#define XB_XCNT(j)  (256  + 64 * (j))
#define XB_XSUB(j)  (1280 + 64 * (j))
#define XB_XGEN(j)  (2304 + 64 * (j))
#define XB_TOP      3328
#define XB_TOPGEN   3392
#define XCD_BAR_WORDS 3456
#define XB_SPIN_CAP (1u << 18)

__device__ __forceinline__ unsigned xb_ld(unsigned* p)              { return __hip_atomic_load(p, __ATOMIC_RELAXED, __HIP_MEMORY_SCOPE_AGENT); }
__device__ __forceinline__ unsigned xb_add(unsigned* p, unsigned v) { return __hip_atomic_fetch_add(p, v, __ATOMIC_RELAXED, __HIP_MEMORY_SCOPE_AGENT); }
__device__ __forceinline__ unsigned xb_xcc_id() { return (unsigned)__builtin_amdgcn_s_getreg((3 << 11) | 20) & 0xFu; }
#define XB_SPIN(cond, bar) do { unsigned _sp = 0; while (cond) { __builtin_amdgcn_s_sleep(1); \
    if ((++_sp & 255u) == 0u) { if (xb_ld(&(bar)[XB_TMO])) break; if (_sp > XB_SPIN_CAP) { atomicAdd(&(bar)[XB_TMO], 1u); break; } } } } while (0)

struct XcdBarrier {
    unsigned* bar; unsigned x;
    volatile LAS unsigned* st;
};

__device__ __forceinline__ XcdBarrier xcd_barrier_post(unsigned* bar, volatile LAS unsigned* st) {
    XcdBarrier b; b.bar = bar; b.x = xb_xcc_id(); b.st = st;
    if (threadIdx.x == 0) (void)xb_add(&bar[XB_XCNT(b.x)], 1u);
    return b;
}
__device__ __forceinline__ void xcd_barrier_complete(unsigned* bar, unsigned x, unsigned& nloc, unsigned& nx) {
    const unsigned G = gridDim.x * gridDim.y * gridDim.z;
    unsigned sum, cnt, mine, sp = 0u;
    for (;;) {
        sum = 0u; cnt = 0u; mine = 0u;
#pragma unroll
        for (unsigned j = 0; j < 16; ++j) { const unsigned c = xb_ld(&bar[XB_XCNT(j)]); sum += c; cnt += (c > 0u) ? 1u : 0u; mine = (j == x) ? c : mine; }
        if (sum == G) break;
        __builtin_amdgcn_s_sleep(1);
        if ((++sp & 255u) == 0u) { if (xb_ld(&bar[XB_TMO])) break; if (sp > XB_SPIN_CAP) { atomicAdd(&bar[XB_TMO], 1u); break; } }
    }
    nloc = mine > 0u ? mine : 1u; nx = cnt > 0u ? cnt : 1u;
}

__device__ __forceinline__ void xcd_barrier(const XcdBarrier& b) {
    asm volatile("s_waitcnt vmcnt(0)" ::: "memory");
    __syncthreads();
    if (threadIdx.x == 0) {
        unsigned* bar = b.bar;
        __builtin_amdgcn_s_waitcnt(0);
        unsigned nloc = b.st[0], nx = b.st[1];
        if (nloc == 0u) { xcd_barrier_complete(bar, b.x, nloc, nx); b.st[0] = nloc; b.st[1] = nx; }
        const unsigned old = xb_add(&bar[XB_XSUB(b.x)], 1u);
        const unsigned gen = old / nloc;
        if (old + 1u == (gen + 1u) * nloc) {
            __builtin_amdgcn_fence(__ATOMIC_RELEASE, "agent");
            asm volatile("s_waitcnt vmcnt(0)" ::: "memory");
            const unsigned og = xb_add(&bar[XB_TOP], 1u);
            const unsigned tg = og / nx;
            if (og + 1u == (tg + 1u) * nx) xb_add(&bar[XB_TOPGEN], 1u);
            else XB_SPIN(xb_ld(&bar[XB_TOPGEN]) == tg, bar);
            __builtin_amdgcn_fence(__ATOMIC_ACQUIRE, "agent");
            xb_add(&bar[XB_XGEN(b.x)], 1u);
            asm volatile("s_waitcnt vmcnt(0)" ::: "memory");
        } else {
            XB_SPIN(xb_ld(&bar[XB_XGEN(b.x)]) == gen, bar);
            __builtin_amdgcn_fence(__ATOMIC_ACQUIRE, "agent");
            asm volatile("s_waitcnt vmcnt(0)" ::: "memory");
        }
    }
    __syncthreads();
}


constexpr size_t WS_XBAR = 800 * 1024;
constexpr int LDS_XB = LDS_BYTES - 64;
constexpr int NPHASE = 10;
__global__ void __launch_bounds__(512, 2) mega_fwd(Params p) {
    extern __shared__ __attribute__((aligned(16))) unsigned char lds_raw[];
    LAS unsigned char* lds = (LAS unsigned char*)lds_raw;
    __builtin_assume(__builtin_amdgcn_workitem_id_y() == 0); __builtin_assume(__builtin_amdgcn_workitem_id_z() == 0);
    cg::grid_group grid = cg::this_grid();
    unsigned char* ws = p.ws;
    const int tid = threadIdx.x, lane = tid & 63, wid = __builtin_amdgcn_readfirstlane(tid >> 6);
    const int G = gridDim.x, gw = blockIdx.x * 8 + wid, NGW = G * 8, gt = blockIdx.x * 512 + tid, NGT = G * 512;
    const int lo = p.ph_lo, hi = p.ph_hi;
    if (threadIdx.x < 2) ((volatile LAS unsigned*)(lds + LDS_XB))[threadIdx.x] = 0u;
    __syncthreads();
    XcdBarrier xbar; xbar.bar = (unsigned*)(ws + WS_XBAR); xbar.x = 0; xbar.st = nullptr;
    if (hi - lo > 1) xbar = xcd_barrier_post((unsigned*)(ws + WS_XBAR), (volatile LAS unsigned*)(lds + LDS_XB));
#ifdef PH_ONLY
#define IN(k) ((k) == PH_ONLY && lo <= (k) && (k) < hi)
#else
#define IN(k) (lo <= (k) && (k) < hi)
#endif
#define SEAM(k) do { if (IN(k) && IN((k) + 1)) { if ((k) == 0) grid.sync(); else xcd_barrier(xbar); } } while (0)
#define PHASE_IDS() int tid_q = threadIdx.x; asm volatile("" : "+v"(tid_q)); const int lane = tid_q & 63, gt = blockIdx.x * 512 + tid_q; (void)gt; (void)lane

    if (IN(0)) {
        PHASE_IDS();
        LAS float* scr = (LAS float*)(lds + wid * 8448);
        constexpr int I_IN = 16 * 70, I_UQ = 6 * 24, I_UKV = 4 * 32, I_OUT = 16 * 32, I_G = 16 * 88, I_D = 44 * 32;
        constexpr int NITEMS = I_IN + I_UQ + I_UKV + I_OUT + 2 * I_G + I_D;
        for (int it = gw; it < NITEMS; it += NGW) {
            int r = it;
            if (r < I_IN) { p0_transpose_item(p.in[9], 1024, DIN, ((bf16_t*)(ws + WS_WIN)), 1, scr, r, lane); continue; } r -= I_IN;
            if (r < I_UQ) { p0_transpose_item(p.in[12], 384, 768, ((bf16_t*)(ws + WS_WUQ)), 4, scr, r, lane); continue; } r -= I_UQ;
            if (r < I_UKV) { p0_transpose_item(p.in[14], 256, 1024, ((bf16_t*)(ws + WS_WUKV)), 0, scr, r, lane); continue; } r -= I_UKV;
            if (r < I_OUT) { p0_transpose_item(p.in[15], 1024, 1024, ((bf16_t*)(ws + WS_WOUT)), 0, scr, r, lane); continue; } r -= I_OUT;
            if (r < I_G) { p0_transpose_item(p.in[17], 1024, DFF, ((bf16_t*)(ws + WS_WGU)), 2, scr, r, lane, p.in[16]); continue; } r -= I_G;
            if (r < I_G) { p0_transpose_item(p.in[18], 1024, DFF, ((bf16_t*)(ws + WS_WGU)), 3, scr, r, lane, p.in[16]); continue; } r -= I_G;
            p0_transpose_item(p.in[19], DFF, 1024, ((bf16_t*)(ws + WS_WDN)), 0, scr, r, lane);
        }
        if (gt < 16) ((unsigned*)(ws + WS_KINF))[gt] = 0u;
        for (int c = gt; c < RT; c += NGT) { ((float*)(ws + WS_SS1))[c] = 0.f; ((float*)(ws + WS_SS2))[c] = 0.f; }
        for (int c = gt; c < 88 * 128; c += NGT) ((u32x4*)(((bf16_t*)(ws + WS_WIN)) + (size_t)680 * 1024))[c] = (u32x4){0, 0, 0, 0};
        bf16_t* XN = (bf16_t*)(ws + WS_XN);
        for (int r0 = gw; r0 < RT; r0 += 2 * NGW) {
            const int r1 = r0 + NGW;
            const float* xa = x_of_row(p, r0); const float* xb = r1 < RT ? x_of_row(p, r1) : nullptr;
            if (xa && xb) { norm_rows2_to_bf16(xa, xb, p.in[8], XN + (size_t)r0 * DM, XN + (size_t)r1 * DM, lane); continue; }
#pragma unroll 1
            for (int k = 0; k < 2; ++k) { const int r = k ? r1 : r0; if (r >= RT) break; const float* xr = k ? xb : xa;
                if (xr) norm_row_to_bf16(xr, p.in[8], XN + (size_t)r * DM, lane);
                else { ((u32x4*)(XN + (size_t)r * DM))[lane] = (u32x4){0, 0, 0, 0}; ((u32x4*)(XN + (size_t)r * DM))[lane + 64] = (u32x4){0, 0, 0, 0}; } }
        }
        for (int i = gt; i < LP * 16; i += NGT) rope_entry((float*)(ws + WS_ROPE), i);
        { const float* cl = p.in[2]; bf16_t* CLAT = (bf16_t*)(ws + WS_CLAT);
          for (int c = gt; c < 131072 * 32; c += NGT) { const f32x4 a = ((const f32x4*)cl)[2 * (size_t)c], b2 = ((const f32x4*)cl)[2 * (size_t)c + 1]; ((u32x4*)CLAT)[c] = pack8(a, b2); }
          const float* ck = p.in[3]; bf16_t* CKR = (bf16_t*)(ws + WS_CKR);
          for (int c = gt; c < 131072 * 4; c += NGT) { const f32x4 a = ((const f32x4*)ck)[2 * (size_t)c], b2 = ((const f32x4*)ck)[2 * (size_t)c + 1]; ((u32x4*)CKR)[c] = pack8(a, b2); } }
        for (int g = gw; g < 4096; g += NGW) cache_cum_group(p.in[6], (float*)(ws + WS_CLC), (float*)(ws + WS_CTT), g, lane);
    }
    SEAM(0);
    if (IN(1)) {
        { pg8::Gemm g{(const bf16_t*)(ws + WS_XN), ((bf16_t*)(ws + WS_WIN)), RT, 2304, 1024}; pg8::StaticOrder S; S.init(RT, 2304, G, (int)blockIdx.x);
          EpiG1 E{(bf16_t*)(ws + WS_PROJC), (bf16_t*)(ws + WS_FQ), (bf16_t*)(ws + WS_FKH), (bf16_t*)(ws + WS_FVH), p.out, (unsigned*)(ws + WS_KINF)};
          pg8::gemm_phase<EpiG1, pg8::StaticOrder, false, true>(lds, g, S, E); }
        { pg8::Gemm g{(const bf16_t*)(ws + WS_CLAT), ((bf16_t*)(ws + WS_WUKV)), 131072, 1024, 256}; pg8::StaticOrder S; S.init(131072, 1024, G, (int)blockIdx.x);
          EpiKV E{(bf16_t*)(ws + WS_KNC), (bf16_t*)(ws + WS_VMC), (size_t)131072};
          pg8::gemm_phase<EpiKV, pg8::StaticOrder, false, true>(lds, g, S, E); }
    }
    SEAM(1);
    if (IN(2)) { PHASE_IDS(); for (int gi = gw; gi < NGRP; gi += NGW) p2_group(p, gi, lane); }
    SEAM(2);
    if (IN(3)) {
        { pg8::Gemm g{(const bf16_t*)(ws + WS_CQN), ((bf16_t*)(ws + WS_WUQ)), RT, 768, 384}; pg8::StaticOrder S; S.init(RT, 768, G, (int)blockIdx.x);
          EpiBf16 E{(bf16_t*)(ws + WS_QMLA), 768};
          pg8::gemm_phase<EpiBf16, pg8::StaticOrder, false, true>(lds, g, S, E); }
        { pg8::Gemm g{(const bf16_t*)(ws + WS_LATN), ((bf16_t*)(ws + WS_WUKV)), RT, 1024, 256}; pg8::StaticOrder S; S.init(RT, 1024, G, (int)blockIdx.x);
          EpiKV E{(bf16_t*)(ws + WS_KNH), (bf16_t*)(ws + WS_VMH), (size_t)RT};
          pg8::gemm_phase<EpiKV, pg8::StaticOrder, false, true>(lds, g, S, E); }
    }
    SEAM(3);
    if (IN(4)) {
        const int bx = blockIdx.x;
        if (G == 256) {
#pragma unroll 1
            for (int r = 15; r >= 0; --r) {
                if (r == (bx & 15)) {
#pragma unroll 1
                    for (int k = 0; k < 2; ++k) { const int u = 2 * bx + k, sb = u >> 4, h = u & 7;
                        if ((u >> 3) & 1) attn_sample_unit<true>(p, lds, sb, h); else attn_sample_unit<false>(p, lds, sb, h); }
                }
                const int j = r >> 1, type = (r ^ bx) & 1, bh = (bx >> 1) & 63, q4 = (bx & 1) + 2 * (bx >> 7), qb = 4 * j + ((j & 1) ? 3 - q4 : q4);
                if (type) attn_prompt_unit<true>(p, lds, bh >> 3, (bh + j) & 7, qb); else attn_prompt_unit<false>(p, lds, bh >> 3, bh & 7, qb);
            }
        } else {
            for (int su = 2 * bx; su < 512; su += 2 * G) {
#pragma unroll 1
                for (int k = 0; k < 2; ++k) { const int u = su + k, sb = u >> 4, h = u & 7;
                    if ((u >> 3) & 1) attn_sample_unit<true>(p, lds, sb, h); else attn_sample_unit<false>(p, lds, sb, h); }
            }
            for (int ui = bx; ui < 4096; ui += G) {
                const int qb = 31 - (ui >> 7), c = ui & 127, type = c >> 6, b = (c >> 3) & 7, h = c & 7;
                if (type) attn_prompt_unit<true>(p, lds, b, h, qb); else attn_prompt_unit<false>(p, lds, b, h, qb);
            }
        }
    }
    SEAM(4);
    if (IN(5)) {
        pg8::Gemm g{(const bf16_t*)(ws + WS_MIXED), ((bf16_t*)(ws + WS_WOUT)), RS0, 1024, 1024}; pg8::StaticOrder S; S.init(RS0, 1024, G, (int)blockIdx.x);
        EpiRes E{p.in[0], p.in[1], (bf16_t*)(ws + WS_HN), (float*)(ws + WS_SS1)};
        pg8::gemm_phase<EpiRes, pg8::StaticOrder, true, true>(lds, g, S, E);
        { pg8::Gemm g2{(const bf16_t*)(ws + WS_MIXED), ((bf16_t*)(ws + WS_WOUT)), RT, 1024, 256, 1024}; SplitOrder S2{(int)blockIdx.x, 4};
          EpiPart E2{(float*)(ws + WS_XPART)};
          pg8::gemm_phase<EpiPart, SplitOrder, false, true>(lds, g2, S2, E2); }
        xcd_barrier(xbar);
        {
            PHASE_IDS();
            bf16_t* x1b = (bf16_t*)(ws + WS_HN); float* ss1 = (float*)(ws + WS_SS1);
            for (int r = RS0 + gw; r < RM0; r += NGW) {
                const float* xr = p.in[1] + (size_t)(r - RS0) * DM + 16 * lane; const float* xp = (const float*)(ws + WS_XPART) + (size_t)(r - RS0) * 1024 + 16 * lane;
                f32x4 v[4];
#pragma unroll
                for (int j = 0; j < 4; ++j) v[j] = ((const f32x4*)xr)[j];
#pragma unroll
                for (int ks = 0; ks < 4; ++ks)
#pragma unroll
                    for (int j = 0; j < 4; ++j) v[j] = v[j] + ((const f32x4*)(xp + (size_t)ks * 1024 * 1024))[j];
                float sq = 0.f;
#pragma unroll
                for (int j = 0; j < 4; ++j) sq += (v[j].x * v[j].x + v[j].y * v[j].y) + (v[j].z * v[j].z + v[j].w * v[j].w);
                sq = wave_sum(sq);
                ((u32x4*)(x1b + (size_t)r * DM))[2 * lane] = pack8(v[0], v[1]); ((u32x4*)(x1b + (size_t)r * DM))[2 * lane + 1] = pack8(v[2], v[3]);
                if (lane == 0) ss1[r] = sq;
            }
        }
    }
    if (IN(5) && IN(7)) xcd_barrier(xbar);
    if (IN(7)) {
        pg8::Gemm g{(const bf16_t*)(ws + WS_HN), ((bf16_t*)(ws + WS_WGU)), RT, 2 * DFF, 1024}; pg8::StaticOrder S; S.init(RT, 2 * DFF, G, (int)blockIdx.x);
        EpiSwiglu E{(bf16_t*)(ws + WS_ACT), (const float*)(ws + WS_SS1)};
        pg8::gemm_phase<EpiSwiglu, pg8::StaticOrder, true, true>(lds, g, S, E);
    }
    SEAM(7);
    if (IN(8)) {
        pg8::Gemm g{(const bf16_t*)(ws + WS_ACT), ((bf16_t*)(ws + WS_WDN)), RS0, 1024, DFF, 0}; pg8::StaticOrder S; S.init(RS0, 1024, G, (int)blockIdx.x);
        EpiAcc E{(bf16_t*)(ws + WS_HN), (float*)(ws + WS_SS2)};
        pg8::gemm_phase<EpiAcc, pg8::StaticOrder, true, true>(lds, g, S, E);
        { pg8::Gemm g2{(const bf16_t*)(ws + WS_ACT), ((bf16_t*)(ws + WS_WDN)), RT, 1024, 256, DFF}; SplitOrder S2{(int)blockIdx.x, 11};
          EpiPart E2{(float*)(ws + WS_XPART)};
          pg8::gemm_phase<EpiPart, SplitOrder, false, true>(lds, g2, S2, E2); }
    }
    SEAM(8);
    if (IN(9)) {
        PHASE_IDS();
        const bf16_t* x2b = (const bf16_t*)(ws + WS_HN); const float* ss2 = (const float*)(ws + WS_SS2); const float* g = p.in[20];
        f32x4 gg[4];
#pragma unroll
        for (int j = 0; j < 4; ++j) gg[j] = ((const f32x4*)g)[4 * lane + j];
        for (int r = RS0 + gw; r < RM0; r += NGW) {
            const u32x4 w0 = ((const u32x4*)(x2b + (size_t)r * DM))[2 * lane], w1 = ((const u32x4*)(x2b + (size_t)r * DM))[2 * lane + 1];
            f32x4 v[4];
            v[0] = (f32x4){__uint_as_float(w0.x << 16), __uint_as_float(w0.x & 0xffff0000u), __uint_as_float(w0.y << 16), __uint_as_float(w0.y & 0xffff0000u)};
            v[1] = (f32x4){__uint_as_float(w0.z << 16), __uint_as_float(w0.z & 0xffff0000u), __uint_as_float(w0.w << 16), __uint_as_float(w0.w & 0xffff0000u)};
            v[2] = (f32x4){__uint_as_float(w1.x << 16), __uint_as_float(w1.x & 0xffff0000u), __uint_as_float(w1.y << 16), __uint_as_float(w1.y & 0xffff0000u)};
            v[3] = (f32x4){__uint_as_float(w1.z << 16), __uint_as_float(w1.z & 0xffff0000u), __uint_as_float(w1.w << 16), __uint_as_float(w1.w & 0xffff0000u)};
            const float* xp = (const float*)(ws + WS_XPART) + (size_t)(r - RS0) * 1024 + 16 * lane;
#pragma unroll 1
            for (int ks = 0; ks < 11; ++ks) {
#pragma unroll
                for (int j = 0; j < 4; ++j) v[j] = v[j] + ((const f32x4*)(xp + (size_t)ks * 1024 * 1024))[j]; }
            float sq = 0.f;
#pragma unroll
            for (int j = 0; j < 4; ++j) sq += (v[j].x * v[j].x + v[j].y * v[j].y) + (v[j].z * v[j].z + v[j].w * v[j].w);
            const float rstd = 1.0f / sqrtf(wave_sum(sq) * (1.0f / DM) + EPS);
            f32x4* o4 = (f32x4*)(p.out + (size_t)r * DM) + 4 * lane;
#pragma unroll
            for (int j = 0; j < 4; ++j) o4[j] = v[j] * rstd * gg[j];
        }
        for (int rb = gw; rb < RS0; rb += 4 * NGW) {
            u32x4 w0[4], w1[4]; float sr[4];
#pragma unroll
            for (int k = 0; k < 4; ++k) { const int r = rb + k * NGW; const u32x4* src = (const u32x4*)(x2b + (size_t)(r < RS0 ? r : rb) * DM); w0[k] = src[2 * lane]; w1[k] = src[2 * lane + 1]; sr[k] = ss2[r < RS0 ? r : rb]; }
#pragma unroll
            for (int k = 0; k < 4; ++k) { const int r = rb + k * NGW; if (r >= RS0) break;
                const float rstd = 1.0f / sqrtf(sr[k] * (1.0f / DM) + EPS);
                f32x4* o4 = (f32x4*)(p.out + (size_t)r * DM) + 4 * lane;
                o4[0] = (f32x4){__uint_as_float(w0[k].x << 16), __uint_as_float(w0[k].x & 0xffff0000u), __uint_as_float(w0[k].y << 16), __uint_as_float(w0[k].y & 0xffff0000u)} * rstd * gg[0];
                o4[1] = (f32x4){__uint_as_float(w0[k].z << 16), __uint_as_float(w0[k].z & 0xffff0000u), __uint_as_float(w0[k].w << 16), __uint_as_float(w0[k].w & 0xffff0000u)} * rstd * gg[1];
                o4[2] = (f32x4){__uint_as_float(w1[k].x << 16), __uint_as_float(w1[k].x & 0xffff0000u), __uint_as_float(w1[k].y << 16), __uint_as_float(w1[k].y & 0xffff0000u)} * rstd * gg[2];
                o4[3] = (f32x4){__uint_as_float(w1[k].z << 16), __uint_as_float(w1[k].z & 0xffff0000u), __uint_as_float(w1[k].w << 16), __uint_as_float(w1[k].w & 0xffff0000u)} * rstd * gg[3];
            }
        }
    }
#undef IN
#undef SEAM
}

#ifndef MK_N_LAUNCHES
#define MK_N_LAUNCHES 1
#endif
extern "C" void kernel_launch(void* const* d_in, const int* in_sizes, int n_in, void* d_out, int out_size, void* d_ws, size_t ws_size, hipStream_t stream) {
    static int grid = 0;
    if (grid == 0) {
        if (n_in != 21 || (size_t)out_size != O_END || ws_size < WS_END) { fprintf(stderr, "kernel_launch: unexpected shapes n_in %d out %d ws %zu (need %zu)\n", n_in, out_size, ws_size, (size_t)WS_END); grid = -1; return; }
        int dev = 0, cus = 0, per_cu = 0;
        hipGetDevice(&dev); hipDeviceGetAttribute(&cus, hipDeviceAttributeMultiprocessorCount, dev);
        if (hipFuncSetAttribute((const void*)mega_fwd, hipFuncAttributeMaxDynamicSharedMemorySize, LDS_BYTES) != hipSuccess) { fprintf(stderr, "kernel_launch: hipFuncSetAttribute failed\n"); grid = -1; return; }
        if (hipOccupancyMaxActiveBlocksPerMultiprocessor(&per_cu, (const void*)mega_fwd, 512, LDS_BYTES) != hipSuccess || per_cu < 1) { fprintf(stderr, "kernel_launch: occupancy query says %d\n", per_cu); per_cu = 1; }
        (void)hipGetLastError();
        grid = cus;
    }
    if (grid < 0) return;
    Params prm{};
    for (int i = 0; i < 21; ++i) prm.in[i] = (const float*)d_in[i];
    prm.out = (float*)d_out; prm.ws = (unsigned char*)d_ws;
#if MK_N_LAUNCHES == 1
    (void)hipMemsetAsync((unsigned char*)d_ws + WS_XBAR, 0, 16384, stream);
    prm.ph_lo = 0; prm.ph_hi = NPHASE;
    void* args[] = {&prm};
    hipError_t e = hipLaunchCooperativeKernel((const void*)mega_fwd, dim3(grid), dim3(512), args, LDS_BYTES, stream);
    if (e != hipSuccess) fprintf(stderr, "cooperative launch failed: %s (grid %d)\n", hipGetErrorString(e), grid);
#ifdef PROBE_EXTRA_PHASE
    { Params q2 = prm; q2.ph_lo = PROBE_EXTRA_PHASE; q2.ph_hi = PROBE_EXTRA_PHASE + 1; hipLaunchKernelGGL(mega_fwd, dim3(grid), dim3(512), LDS_BYTES, stream, q2); }
#endif
#else
    for (int k = 0; k < NPHASE; ++k) { prm.ph_lo = k; prm.ph_hi = k + 1; hipLaunchKernelGGL(mega_fwd, dim3(grid), dim3(512), LDS_BYTES, stream, prm); }
#endif
}
```

```cpp
#include <hip/hip_runtime.h>
#include <hip/hip_cooperative_groups.h>
#include <cstdio>
#include <cstdint>
namespace cg = cooperative_groups;
namespace pg8 {
#define PG8_LAS __attribute__((address_space(3)))
typedef unsigned short bf16_t;
typedef short bf16x8 __attribute__((ext_vector_type(8)));
typedef float f32x4 __attribute__((ext_vector_type(4)));
typedef unsigned u32x4 __attribute__((ext_vector_type(4)));
constexpr int BM = 256, BK = 64, HALF = 128, HTB = HALF * BK * 2  , STAGE_BYTES = 8 * HTB, NXCD = 8, WGM = 8;

__host__ __device__ __forceinline__ int lds_byte(int r, int c) { const int st = (r >> 4) * 2 + (c >> 5), rr = r & 15, cc = c & 31, ob = rr * 64 + cc * 2; return st * 1024 + (ob ^ (((ob >> 9) & 1) << 5)); }
__host__ __device__ __forceinline__ void stage_rc(int b, int& R, int& C) { const int st = b / 1024, sb = b % 1024, swz = sb ^ (((sb >> 9) & 1) << 5); R = (st >> 1) * 16 + swz / 64; C = (st & 1) * 32 + (swz % 64) / 2; }
__host__ __device__ __forceinline__ int perm32(int rho) { const int n = rho >> 4, i = rho & 15; return 8 * (i >> 2) + 4 * n + (i & 3); }

struct Unit { int pm, pn, ko; };
struct Gemm { const bf16_t* A; const bf16_t* Bt; int M, N, K, ld; };

struct StaticOrder {
    int nM, nN, nwg, G, c;
    __host__ __device__ void init(int M, int N, int G_, int c_) { nM = M / BM; nN = N / BM; nwg = nM * nN; G = G_; c = c_; }
    __host__ __device__ bool next(int i, Unit& u) const {
        const long L = (long)i * G + c; if (L >= nwg) return false;
        int wgid = (int)L; { const int q = nwg / NXCD, r = nwg % NXCD, xcd = wgid % NXCD, off = wgid / NXCD; wgid = (xcd < r ? xcd * (q + 1) : r * (q + 1) + (xcd - r) * q) + off; }
        const int nig = WGM * nN, gid = wgid / nig, fm = gid * WGM, gsz = (nM - fm) < WGM ? (nM - fm) : WGM;
        u.pm = fm + ((wgid % nig) % gsz); u.pn = (wgid % nig) / gsz; u.ko = 0; return true;
    }
    __device__ __forceinline__ void a_ready(const Unit&) const {}
    __device__ __forceinline__ void done(const Unit&) const {}
};

__device__ __forceinline__ unsigned cvt_pk_bf16(float lo, float hi) { unsigned r; asm volatile("v_cvt_pk_bf16_f32 %0, %1, %2" : "=v"(r) : "v"(lo), "v"(hi)); return r; }
template <class Epi, class Sched, bool ALIGN_EPI = false, bool SP2 = false>
__device__ __forceinline__ void gemm_phase(PG8_LAS unsigned char* lds, const Gemm g, const Sched& S, const Epi& E) {
    int tid_o = threadIdx.x; asm volatile("" : "+v"(tid_o));
    const int tid = tid_o, wid = __builtin_amdgcn_readfirstlane(tid >> 6), lane = tid & 63, wr = wid >> 2, wc = wid & 3, fr = lane & 15, fq = lane >> 4;
    const int K = g.K, nt = K / BK, LD = g.ld ? g.ld : g.K;
    unsigned voffA[2], voffB[2];
#pragma unroll
    for (int i = 0; i < 2; ++i) { int R, C; stage_rc(tid * 16 + i * 8192, R, C); const int Rb = Epi::PERM ? ((R & ~31) + perm32(R & 31)) : R;
        voffA[i] = (unsigned)(R * LD + C) * 2u; voffB[i] = (unsigned)(Rb * LD + C) * 2u; }
    const size_t kstep = (size_t)(BK * 2);
    const size_t hstep = (size_t)HALF * LD * 2;
    const size_t tstep = 2 * hstep;
    const unsigned ldsw = (unsigned)wid * 1024u;
    const int aoff = lds_byte(wr * 64 + fr, fq * 8), boff = lds_byte(wc * 32 + fr, fq * 8);
#define PG8_SA(b, h) (((b) * 2 + (h)) * HTB)
#define PG8_SB(b, h) ((4 + (b) * 2 + (h)) * HTB)
#define PG8_STAGE(bufoff, gbase, voff) do { _Pragma("unroll") for (int _i = 0; _i < 2; ++_i) \
        __builtin_amdgcn_global_load_lds((const unsigned*)((const char*)(gbase) + (voff)[_i]), (PG8_LAS unsigned*)(lds + (bufoff) + ldsw + _i * 8192), 16, 0, 0); } while (0)
#define PG8_LDA(dst, b, h) do { _Pragma("unroll") for (int m = 0; m < 4; ++m) _Pragma("unroll") for (int k = 0; k < 2; ++k) dst[m][k] = *(const PG8_LAS bf16x8*)(lds + PG8_SA(b, h) + aoff + m * 2048 + k * 1024); } while (0)
#define PG8_LDB(dst, b, h) do { _Pragma("unroll") for (int n = 0; n < 2; ++n) _Pragma("unroll") for (int k = 0; k < 2; ++k) dst[n][k] = *(const PG8_LAS bf16x8*)(lds + PG8_SB(b, h) + boff + n * 2048 + k * 1024); } while (0)
#define PG8_MMA(ai, bj, At, Bt) do { __builtin_amdgcn_s_setprio(1); _Pragma("unroll") for (int m = 0; m < 4; ++m) _Pragma("unroll") for (int n = 0; n < 2; ++n) _Pragma("unroll") for (int k = 0; k < 2; ++k) \
        acc[ai][bj][m][n] = __builtin_amdgcn_mfma_f32_16x16x32_bf16(Bt[n][k], At[m][k], acc[ai][bj][m][n], 0, 0, 0); __builtin_amdgcn_s_setprio(0); } while (0)
#define PG8_WAIT_V(n) asm volatile("s_waitcnt vmcnt(" #n ")" ::: "memory")
#define PG8_WAIT_L(n) asm volatile("s_waitcnt lgkmcnt(" #n ")" ::: "memory")
#define PG8_BAR __builtin_amdgcn_s_barrier()
#define PG8_SCHED __builtin_amdgcn_sched_barrier(0)
    Unit cur, nxt; int ui = 0;
    if (!S.next(0, cur)) return;
    f32x4 acc[2][2][4][2];
#pragma unroll
    for (int a = 0; a < 2; ++a)
#pragma unroll
        for (int b = 0; b < 2; ++b)
#pragma unroll
            for (int m = 0; m < 4; ++m)
#pragma unroll
                for (int n = 0; n < 2; ++n) acc[a][b][m][n] = (f32x4){0.f, 0.f, 0.f, 0.f};
    bf16x8 At[4][2], B0[2][2], B1[2][2];
    const char* cA = (const char*)g.A + (size_t)cur.pm * tstep + (size_t)cur.ko * 2; const char* cB = (const char*)g.Bt + (size_t)cur.pn * tstep + (size_t)cur.ko * 2;
    S.a_ready(cur);
    if constexpr (SP2) {
        PG8_STAGE(PG8_SB(0, 0), cB, voffB); PG8_STAGE(PG8_SB(0, 1), cB + hstep, voffB); PG8_STAGE(PG8_SA(0, 0), cA, voffA); PG8_STAGE(PG8_SA(0, 1), cA + hstep, voffA);
        if (wr == 1) PG8_BAR;
        PG8_WAIT_V(2); PG8_BAR;
        PG8_STAGE(PG8_SB(1, 0), cB + kstep, voffB); PG8_STAGE(PG8_SA(1, 0), cA + kstep, voffA); PG8_STAGE(PG8_SB(1, 1), cB + hstep + kstep, voffB);
        PG8_WAIT_V(6); PG8_BAR;
    } else {
        PG8_STAGE(PG8_SB(0, 0), cB, voffB); PG8_STAGE(PG8_SA(0, 0), cA, voffA); PG8_STAGE(PG8_SB(0, 1), cB + hstep, voffB); PG8_STAGE(PG8_SA(0, 1), cA + hstep, voffA);
        if (wr == 1) PG8_BAR;
        PG8_WAIT_V(4); PG8_BAR;
        PG8_STAGE(PG8_SB(1, 0), cB + kstep, voffB); PG8_STAGE(PG8_SA(1, 0), cA + kstep, voffA); PG8_STAGE(PG8_SB(1, 1), cB + hstep + kstep, voffB);
        PG8_WAIT_V(6); PG8_BAR;
    }
    for (;;) {
        const bool has_next = S.next(ui + 1, nxt);
        const char* nA = has_next ? (const char*)g.A + (size_t)nxt.pm * tstep + (size_t)nxt.ko * 2 : cA; const char* nB = has_next ? (const char*)g.Bt + (size_t)nxt.pn * tstep + (size_t)nxt.ko * 2 : cB;
        for (int t = 0; t < nt; t += 2) {
            const bool last = (t == nt - 2);
            const char* a1 = cA + (size_t)(t + 1) * kstep;
            const char* a2 = last ? nA : cA + (size_t)(t + 2) * kstep; const char* b2 = last ? nB : cB + (size_t)(t + 2) * kstep;
            const char* a3 = a2 + kstep; const char* b3 = b2 + kstep;
            if (last && has_next) S.a_ready(nxt);
            if constexpr (SP2) {
            PG8_LDB(B0, 0, 0); PG8_LDB(B1, 0, 1); PG8_SCHED; PG8_LDA(At, 0, 0); PG8_STAGE(PG8_SA(1, 1), a1 + hstep, voffA);
            PG8_WAIT_V(8); PG8_WAIT_L(0); PG8_BAR; PG8_MMA(0, 0, At, B0); PG8_MMA(0, 1, At, B1); PG8_BAR; PG8_SCHED;
            PG8_LDA(At, 0, 1); PG8_STAGE(PG8_SB(0, 0), b2, voffB); PG8_STAGE(PG8_SB(0, 1), b2 + hstep, voffB); PG8_STAGE(PG8_SA(0, 0), a2, voffA);
            PG8_WAIT_V(8); PG8_WAIT_L(0); PG8_BAR; PG8_MMA(1, 0, At, B0); PG8_MMA(1, 1, At, B1); PG8_BAR; PG8_SCHED;
            PG8_LDB(B0, 1, 0); PG8_LDB(B1, 1, 1); PG8_SCHED; PG8_LDA(At, 1, 0); PG8_STAGE(PG8_SA(0, 1), a2 + hstep, voffA);
            PG8_WAIT_V(8); PG8_WAIT_L(0); PG8_BAR; PG8_MMA(0, 0, At, B0); PG8_MMA(0, 1, At, B1); PG8_BAR; PG8_SCHED;
            PG8_LDA(At, 1, 1); PG8_STAGE(PG8_SB(1, 0), b3, voffB); PG8_STAGE(PG8_SB(1, 1), b3 + hstep, voffB); PG8_STAGE(PG8_SA(1, 0), a3, voffA);
            PG8_WAIT_V(8); PG8_WAIT_L(0); PG8_BAR; PG8_MMA(1, 0, At, B0); PG8_MMA(1, 1, At, B1); PG8_BAR; PG8_SCHED;
            } else {
            PG8_LDB(B0, 0, 0); PG8_SCHED; PG8_LDA(At, 0, 0); PG8_STAGE(PG8_SA(1, 1), a1 + hstep, voffA);
            PG8_WAIT_L(8); PG8_BAR; PG8_WAIT_L(0); PG8_MMA(0, 0, At, B0); PG8_BAR; PG8_SCHED;
            PG8_LDB(B1, 0, 1); PG8_STAGE(PG8_SB(0, 0), b2, voffB);
            PG8_BAR; PG8_WAIT_L(0); PG8_MMA(0, 1, At, B1); PG8_BAR;
            PG8_LDA(At, 0, 1); PG8_STAGE(PG8_SA(0, 0), a2, voffA);
            PG8_BAR; PG8_WAIT_L(0); PG8_MMA(1, 0, At, B0); PG8_BAR; PG8_SCHED;
            PG8_STAGE(PG8_SB(0, 1), b2 + hstep, voffB);
            PG8_WAIT_V(6); PG8_BAR; PG8_MMA(1, 1, At, B1); PG8_BAR;
            PG8_LDB(B0, 1, 0); PG8_SCHED; PG8_LDA(At, 1, 0); PG8_STAGE(PG8_SA(0, 1), a2 + hstep, voffA);
            PG8_WAIT_L(8); PG8_BAR; PG8_WAIT_L(0); PG8_MMA(0, 0, At, B0); PG8_BAR; PG8_SCHED;
            PG8_LDB(B1, 1, 1); PG8_STAGE(PG8_SB(1, 0), b3, voffB);
            PG8_BAR; PG8_WAIT_L(0); PG8_MMA(0, 1, At, B1); PG8_BAR;
            PG8_LDA(At, 1, 1); PG8_STAGE(PG8_SA(1, 0), a3, voffA);
            PG8_BAR; PG8_WAIT_L(0); PG8_MMA(1, 0, At, B0); PG8_BAR; PG8_SCHED;
            PG8_STAGE(PG8_SB(1, 1), b3 + hstep, voffB);
            PG8_WAIT_V(6); PG8_BAR; PG8_MMA(1, 1, At, B1); PG8_BAR;
            }
        }
        if constexpr (ALIGN_EPI) { if (wr == 0) PG8_BAR; }
        if constexpr (!Epi::AFTER_DRAIN) { E(acc, cur, wr, wc, fr, fq); S.done(cur); }
        if (!has_next) break;
#pragma unroll
        for (int a = 0; a < 2; ++a)
#pragma unroll
            for (int b = 0; b < 2; ++b)
#pragma unroll
                for (int m = 0; m < 4; ++m)
#pragma unroll
                    for (int n = 0; n < 2; ++n) acc[a][b][m][n] = (f32x4){0.f, 0.f, 0.f, 0.f};
        cur = nxt; cA = nA; cB = nB; ++ui;
        if constexpr (ALIGN_EPI) { if (wr == 1) PG8_BAR; }
    }
    PG8_WAIT_V(0);
    if constexpr (!ALIGN_EPI) { if (wr == 0) PG8_BAR; }
    PG8_BAR;
    if constexpr (Epi::AFTER_DRAIN) { E.fused(acc, cur, wr, wc, fr, fq, lds, wid, lane); S.done(cur); }
#undef PG8_SA
#undef PG8_SB
#undef PG8_STAGE
#undef PG8_LDA
#undef PG8_LDB
#undef PG8_MMA
#undef PG8_WAIT_V
#undef PG8_WAIT_L
#undef PG8_BAR
#undef PG8_SCHED
}
}

#define DI __device__ __forceinline__
#define LAS __attribute__((address_space(3)))
typedef unsigned short bf16_t;
typedef short bf16x8 __attribute__((ext_vector_type(8)));
typedef short s16x4 __attribute__((ext_vector_type(4)));
typedef float f32x4 __attribute__((ext_vector_type(4)));
typedef float f32x16 __attribute__((ext_vector_type(16)));
typedef unsigned u32x4 __attribute__((ext_vector_type(4)));
typedef unsigned u32x2 __attribute__((ext_vector_type(2)));
typedef float f32x2_t __attribute__((ext_vector_type(2)));
typedef __bf16 bf16x2_t __attribute__((ext_vector_type(2)));
typedef short v4i16_t __attribute__((ext_vector_type(4)));
typedef int i32x4 __attribute__((ext_vector_type(4)));

constexpr int DM = 1024, NB = 8, SEQ = 8192, NMETA = 16, LP = 8208, SBN = 32, SSN = 32, PAST = 4096;
constexpr int RS0 = 65536, RM0 = 66560, RV = 66576, RT = 66816;
constexpr int DFF = 2816, DIN = 2216;
constexpr int NGRP = 2081;
constexpr float EPS = 1e-6f, LOG2E = 1.4426950408889634f;
constexpr float QS_FOX = 0.125f * LOG2E;
constexpr float QS_MLA = 0.10206207261596577f * LOG2E;
constexpr float NEGF = -1e30f;

constexpr size_t O_YP = 0, O_YS = O_YP + (size_t)NB * SEQ * DM, O_LATP = O_YS + (size_t)SBN * SSN * DM, O_KRP = O_LATP + (size_t)NB * LP * 256,
                 O_FKP = O_KRP + (size_t)NB * LP * 32, O_FVP = O_FKP + (size_t)NB * LP * 512, O_LFP = O_FVP + (size_t)NB * LP * 512,
                 O_LATS = O_LFP + (size_t)NB * LP * 8, O_KRS = O_LATS + (size_t)1024 * 256, O_FKS = O_KRS + (size_t)1024 * 32,
                 O_FVS = O_FKS + (size_t)1024 * 512, O_LFS = O_FVS + (size_t)1024 * 512, O_END = O_LFS + (size_t)1024 * 8;

constexpr size_t MiB = 1u << 20;
constexpr size_t WS_SS2 = 524288;
constexpr size_t WS_SS1 = 4096;
constexpr size_t WS_KINF = 0;
constexpr size_t WS_ROPE = 1 * MiB, WS_LC = 3 * MiB, WS_CLC = 6 * MiB, WS_TT = 10 * MiB, WS_CTT = 10 * MiB + 512 * 1024;
constexpr size_t WS_WIN = 11 * MiB, WS_WUQ = 16 * MiB, WS_WUKV = 17 * MiB, WS_WOUT = 18 * MiB, WS_WGU = 20 * MiB, WS_WDN = 31 * MiB;
constexpr size_t WS_XN = 37 * MiB;
constexpr size_t WS_CQN = WS_XN, WS_LATN = WS_XN + 50 * MiB, WS_MIXED = WS_XN;
constexpr size_t WS_PROJC = 168 * MiB;
constexpr size_t WS_QMLA = WS_PROJC;
constexpr size_t WS_KR = 266 * MiB;
constexpr size_t WS_CKR = 271 * MiB;
constexpr size_t WS_CLAT = 279 * MiB;
constexpr size_t WS_FQKV = 343 * MiB;
constexpr size_t WS_KVX = 539 * MiB;
constexpr size_t WS_KVXC = 670 * MiB;
constexpr size_t WS_XPART = 928 * MiB;
constexpr size_t WS_END = 972 * MiB;
constexpr size_t HM_BYTES = (size_t)RT * 512 * 2;
constexpr size_t WS_FQ = WS_FQKV, WS_FKH = WS_FQKV + HM_BYTES, WS_FVH = WS_FQKV + 2 * HM_BYTES;
constexpr size_t WS_KNH = WS_KVX, WS_VMH = WS_KVX + HM_BYTES;
constexpr size_t WS_KNC = WS_KVXC, WS_VMC = WS_KVXC + 128 * MiB;
static_assert(WS_FVH + HM_BYTES <= WS_KVX && WS_VMH + HM_BYTES <= WS_KVXC, "ws map");
constexpr size_t WS_HN = WS_FQKV;
constexpr size_t WS_ACT = WS_FQKV + 131 * MiB;
static_assert(WS_ACT + (size_t)RT * DFF * 2 <= WS_END, "ws map");
static_assert(WS_LATN + (size_t)RT * 256 * 2 <= WS_PROJC && WS_CQN + (size_t)RT * 384 * 2 <= WS_LATN, "ws map");

constexpr int LDS_BYTES = 147456;

struct Params { const float* in[21]; float* out; unsigned char* ws; int ph_lo, ph_hi; };

DI unsigned pk2(float lo, float hi) { f32x2_t v = {lo, hi}; bf16x2_t b = __builtin_convertvector(v, bf16x2_t); return __builtin_bit_cast(unsigned, b); }
DI float bf2f(unsigned short x) { return __uint_as_float((unsigned)x << 16); }
DI u32x4 pack8(f32x4 a, f32x4 b) { return (u32x4){pk2(a.x, a.y), pk2(a.z, a.w), pk2(b.x, b.y), pk2(b.z, b.w)}; }
DI float wave_sum(float v) {
#pragma unroll
    for (int o = 1; o < 64; o <<= 1) v += __shfl_xor(v, o);
    return v;
}
DI int row_pos(int row) { return row < RS0 ? NMETA + (row & 8191) : (row < RM0 ? PAST + ((row - RS0) & 31) : (row < RV ? row - RM0 : 0)); }
DI const float* x_of_row(const Params& p, int row) {
    return row < RS0 ? p.in[0] + (size_t)row * DM : (row < RM0 ? p.in[1] + (size_t)(row - RS0) * DM : (row < RV ? p.in[7] + (size_t)(row - RM0) * DM : nullptr));
}
DI void out_store8(float* outp, float* outs, int width, int row, int cc, f32x4 v0, f32x4 v1) {
    if (row < RS0) { const int b = row >> 13, t = row & 8191; float* d = outp + (size_t)(b * LP + NMETA + t) * width + cc; *(f32x4*)d = v0; *(f32x4*)(d + 4) = v1; }
    else if (row < RM0) { float* d = outs + (size_t)(row - RS0) * width + cc; *(f32x4*)d = v0; *(f32x4*)(d + 4) = v1; }
    else if (row < RV) { const int m = row - RM0;
#pragma unroll 1
        for (int b = 0; b < NB; ++b) { float* d = outp + (size_t)(b * LP + m) * width + cc; *(f32x4*)d = v0; *(f32x4*)(d + 4) = v1; } }
}

struct EpiG1 {
    static constexpr bool PERM = true, AFTER_DRAIN = false;
    bf16_t* projc; bf16_t* fqp; bf16_t* fkh; bf16_t* fvh; float* out; unsigned* kinf;
    DI void operator()(const f32x4 (&acc)[2][2][4][2], const pg8::Unit& u, int wr, int wc, int fr, int fq) const {
        const int pn = u.pn;
        float kmx[2] = {0.f, 0.f};
#pragma unroll
        for (int ai = 0; ai < 2; ++ai)
#pragma unroll
            for (int m = 0; m < 4; ++m) {
                const int row = u.pm * 256 + ai * 128 + wr * 64 + m * 16 + fr;
#pragma unroll
                for (int bj = 0; bj < 2; ++bj) {
                    const int col8 = bj * 128 + wc * 32 + 8 * fq;
                    f32x4 v0 = acc[ai][bj][m][0], v1 = acc[ai][bj][m][1];
                    if (pn < 3) { *(u32x4*)(projc + (size_t)row * 768 + pn * 256 + col8) = pack8(v0, v1); }
                    else {
                        const int c = (pn - 3) * 256 + col8;
                        if (pn < 5) *(u32x4*)(fqp + (size_t)row * 512 + c) = pack8(v0, v1);
                        else { char* base = (char*)((pn < 7 ? fkh : fvh) + (size_t)(((pn - 5) & 1) * 4 + bj * 2 + (wc >> 1)) * RT * 64);
                               *(u32x4*)(base + (unsigned)(row * 64 + (wc & 1) * 32 + 8 * fq) * 2u) = pack8(v0, v1); }
                        if (pn == 5 || pn == 6) {
                            float q2 = (v0.x * v0.x + v0.y * v0.y) + (v0.z * v0.z + v0.w * v0.w) + (v1.x * v1.x + v1.y * v1.y) + (v1.z * v1.z + v1.w * v1.w);
                            q2 += __shfl_xor(q2, 16); q2 += __shfl_xor(q2, 32);
                            kmx[bj] = fmaxf(kmx[bj], q2); }
                        if (pn >= 5) { const int which = (pn - 5) >> 1, cc = ((pn - 5) & 1) * 256 + col8;
                            out_store8(out + (which ? O_FVP : O_FKP), out + (which ? O_FVS : O_FKS), 512, row, cc, v0, v1); }
                    }
                }
            }
        if (pn == 5 || pn == 6) {
#pragma unroll
            for (int bj = 0; bj < 2; ++bj) { float m = kmx[bj];
#pragma unroll
                for (int o = 1; o < 64; o <<= 1) m = fmaxf(m, __shfl_xor(m, o));
                if ((fr | (fq << 4)) == 0) atomicMax(kinf + ((pn - 5) * 4 + bj * 2 + (wc >> 1)) * 2 + (wc & 1), __float_as_uint(m)); }
        }
    }
};
struct EpiBf16 {
    static constexpr bool PERM = true, AFTER_DRAIN = false;
    bf16_t* O; int ldc;
    DI void operator()(const f32x4 (&acc)[2][2][4][2], const pg8::Unit& u, int wr, int wc, int fr, int fq) const {
#pragma unroll
        for (int ai = 0; ai < 2; ++ai)
#pragma unroll
            for (int m = 0; m < 4; ++m) {
                const int row = u.pm * 256 + ai * 128 + wr * 64 + m * 16 + fr;
#pragma unroll
                for (int bj = 0; bj < 2; ++bj) {
                    const int col = u.pn * 256 + bj * 128 + wc * 32 + 8 * fq;
                    *(u32x4*)(O + (size_t)row * ldc + col) = pack8(acc[ai][bj][m][0], acc[ai][bj][m][1]);
                }
            }
    }
};
struct EpiKV {
    static constexpr bool PERM = true, AFTER_DRAIN = false;
    bf16_t* kn; bf16_t* vm; size_t nrows;
    DI void operator()(const f32x4 (&acc)[2][2][4][2], const pg8::Unit& u, int wr, int wc, int fr, int fq) const {
        const int d = (wc & 1) * 32 + 8 * fq;
#pragma unroll
        for (int bj = 0; bj < 2; ++bj) {
            char* base = (char*)(((wc >> 1) ? vm : kn) + (size_t)(u.pn * 2 + bj) * nrows * 64);
#pragma unroll
            for (int ai = 0; ai < 2; ++ai)
#pragma unroll
                for (int m = 0; m < 4; ++m) {
                    const int row = u.pm * 256 + ai * 128 + wr * 64 + m * 16 + fr;
                    *(u32x4*)(base + (unsigned)(row * 64 + d) * 2u) = pack8(acc[ai][bj][m][0], acc[ai][bj][m][1]);
                }
        }
    }
};
struct EpiQ {
    static constexpr bool PERM = false, AFTER_DRAIN = false;
    bf16_t* O; const float* rope;
    DI void operator()(const f32x4 (&acc)[2][2][4][2], const pg8::Unit& u, int wr, int wc, int fr, int fq) const {
#pragma unroll
        for (int bj = 0; bj < 2; ++bj) {
            const int g = u.pn * 8 + bj * 4 + wc;
            const bool is_rope = (g % 3) == 2;
#pragma unroll
            for (int ai = 0; ai < 2; ++ai)
#pragma unroll
                for (int m = 0; m < 4; ++m) {
                    const int row = u.pm * 256 + ai * 128 + wr * 64 + m * 16 + fr;
                    f32x4 a = acc[ai][bj][m][0], b = acc[ai][bj][m][1];
                    if (is_rope) {
                        const float* t = rope + (size_t)row_pos(row) * 32;
                        const f32x4 c = *(const f32x4*)(t + 4 * fq), s = *(const f32x4*)(t + 16 + 4 * fq);
                        const f32x4 o1 = a * c - b * s, o2 = b * c + a * s; a = o1; b = o2;
                    }
                    a = a * QS_MLA; b = b * QS_MLA;
                    bf16_t* d = O + (size_t)row * 768 + g * 32 + 4 * fq;
                    *(u32x2*)d = (u32x2){pk2(a.x, a.y), pk2(a.z, a.w)};
                    *(u32x2*)(d + 16) = (u32x2){pk2(b.x, b.y), pk2(b.z, b.w)};
                }
        }
    }
};
struct EpiRes {
    static constexpr bool PERM = true, AFTER_DRAIN = false;
    const float* xp; const float* xs; bf16_t* x1b; float* ss;
    DI void operator()(const f32x4 (&acc)[2][2][4][2], const pg8::Unit& u, int wr, int wc, int fr, int fq) const {
#pragma unroll
        for (int ai = 0; ai < 2; ++ai)
#pragma unroll
            for (int m = 0; m < 4; ++m) {
                const int row = u.pm * 256 + ai * 128 + wr * 64 + m * 16 + fr;
                float q = 0.f;
                if (row < RM0) {
                    const float* xr = row < RS0 ? xp + (size_t)row * DM : xs + (size_t)(row - RS0) * DM;
#pragma unroll
                    for (int bj = 0; bj < 2; ++bj) {
                        const int col = u.pn * 256 + bj * 128 + wc * 32 + 8 * fq;
                        const f32x4 y0 = *(const f32x4*)(xr + col) + acc[ai][bj][m][0], y1 = *(const f32x4*)(xr + col + 4) + acc[ai][bj][m][1];
                        q += (y0.x * y0.x + y0.y * y0.y) + (y0.z * y0.z + y0.w * y0.w) + (y1.x * y1.x + y1.y * y1.y) + (y1.z * y1.z + y1.w * y1.w);
                        *(u32x4*)(x1b + (size_t)row * DM + col) = pack8(y0, y1);
                    }
                }
                q += __shfl_xor(q, 16); q += __shfl_xor(q, 32);
                if (fq == 0 && row < RM0) atomicAdd(ss + row, q);
            }
    }
};
struct SplitOrder {
    int c, nsl;
    DI bool next(int i, pg8::Unit& u) const { if (i != 0 || c >= 16 * nsl) return false; u.pm = 256 + c / (4 * nsl); u.pn = (c / nsl) & 3; u.ko = (c % nsl) * 256; return true; }
    DI void a_ready(const pg8::Unit&) const {}
    DI void done(const pg8::Unit&) const {}
};
struct EpiPart {
    static constexpr bool PERM = true, AFTER_DRAIN = false;
    float* xp;
    DI void operator()(const f32x4 (&acc)[2][2][4][2], const pg8::Unit& u, int wr, int wc, int fr, int fq) const {
        float* base = xp + (size_t)(u.ko >> 8) * 1024 * 1024;
#pragma unroll
        for (int ai = 0; ai < 2; ++ai)
#pragma unroll
            for (int m = 0; m < 4; ++m) {
                const int rs = (u.pm - 256) * 256 + ai * 128 + wr * 64 + m * 16 + fr;
#pragma unroll
                for (int bj = 0; bj < 2; ++bj) {
                    float* d = base + (size_t)rs * 1024 + u.pn * 256 + bj * 128 + wc * 32 + 8 * fq;
                    *(f32x4*)d = acc[ai][bj][m][0]; *(f32x4*)(d + 4) = acc[ai][bj][m][1];
                }
            }
    }
};
struct EpiAcc {
    static constexpr bool PERM = true, AFTER_DRAIN = false;
    bf16_t* x1b; float* ss;
    DI void operator()(const f32x4 (&acc)[2][2][4][2], const pg8::Unit& u, int wr, int wc, int fr, int fq) const {
#pragma unroll
        for (int ai = 0; ai < 2; ++ai)
#pragma unroll
            for (int m = 0; m < 4; ++m) {
                const int row = u.pm * 256 + ai * 128 + wr * 64 + m * 16 + fr;
                float q = 0.f;
                if (row < RM0) {
#pragma unroll
                    for (int bj = 0; bj < 2; ++bj) {
                        const int col = u.pn * 256 + bj * 128 + wc * 32 + 8 * fq;
                        bf16_t* d = x1b + (size_t)row * DM + col;
                        const u32x4 w = *(const u32x4*)d;
                        const f32x4 y0 = (f32x4){__uint_as_float(w.x << 16), __uint_as_float(w.x & 0xffff0000u), __uint_as_float(w.y << 16), __uint_as_float(w.y & 0xffff0000u)} + acc[ai][bj][m][0];
                        const f32x4 y1 = (f32x4){__uint_as_float(w.z << 16), __uint_as_float(w.z & 0xffff0000u), __uint_as_float(w.w << 16), __uint_as_float(w.w & 0xffff0000u)} + acc[ai][bj][m][1];
                        q += (y0.x * y0.x + y0.y * y0.y) + (y0.z * y0.z + y0.w * y0.w) + (y1.x * y1.x + y1.y * y1.y) + (y1.z * y1.z + y1.w * y1.w);
                        *(u32x4*)d = pack8(y0, y1);
                    }
                }
                q += __shfl_xor(q, 16); q += __shfl_xor(q, 32);
                if (fq == 0 && row < RM0) atomicAdd(ss + row, q);
            }
    }
};
DI float silu_mul(float g, float u) { return g * u * __builtin_amdgcn_rcpf(1.0f + __builtin_amdgcn_exp2f(-g * LOG2E)); }
struct EpiSwiglu {
    static constexpr bool PERM = true, AFTER_DRAIN = false;
    bf16_t* O; const float* ss;
    DI void operator()(const f32x4 (&acc)[2][2][4][2], const pg8::Unit& u, int wr, int wc, int fr, int fq) const {
#pragma unroll
        for (int ai = 0; ai < 2; ++ai)
#pragma unroll
            for (int m = 0; m < 4; ++m) {
                const int row = u.pm * 256 + ai * 128 + wr * 64 + m * 16 + fr;
                const float rstd = 1.0f / sqrtf(ss[row] * (1.0f / DM) + EPS);
                const f32x4 g0 = acc[ai][0][m][0] * rstd, g1 = acc[ai][0][m][1] * rstd, u0 = acc[ai][1][m][0] * rstd, u1 = acc[ai][1][m][1] * rstd;
                f32x4 a0, a1;
#pragma unroll
                for (int i = 0; i < 4; ++i) { a0[i] = silu_mul(g0[i], u0[i]); a1[i] = silu_mul(g1[i], u1[i]); }
                *(u32x4*)(O + (size_t)row * DFF + u.pn * 128 + wc * 32 + 8 * fq) = pack8(a0, a1);
            }
    }
};

DI int wmap(int kind, int n) {
    if (kind == 0 || kind == 4) return n;
    if (kind == 1) return n < 384 ? 256 + n : (n < 640 ? n - 384 : (n < 672 ? n : (n < 2208 ? n + 96 : n - 1536)));
    if (kind == 2) return 256 * (n >> 7) + (n & 127);
    return 256 * (n >> 7) + 128 + (n & 127);
}
DI float wscale(int kind, int n) { return kind == 4 ? QS_MLA : ((kind == 1 && n >= 672 && n < 1184) ? QS_FOX : 1.0f); }
DI void p0_transpose_item(const float* W, int K, int N, bf16_t* WT, int kind, LAS float* scr, int item, int lane, const float* kscale = nullptr) {
    const int nblk = (N + 31) / 32, kb = item / nblk, nb = item % nblk, k0 = 64 * kb, n0 = 32 * nb;
    const int nl = n0 + (lane & 31);
    const float wsc = wscale(kind, nl);
#pragma unroll 8
    for (int i = 0; i < 32; ++i) { const int kk = 2 * i + (lane >> 5); scr[kk * 33 + (lane & 31)] = (nl < N) ? W[(size_t)(k0 + kk) * N + nl] * (kscale ? wsc * kscale[k0 + kk] : wsc) : 0.f; }
    asm volatile("s_waitcnt lgkmcnt(0)" ::: "memory");
    const int c = lane & 7;
#pragma unroll
    for (int j = 0; j < 4; ++j) { const int n = (lane >> 3) + 8 * j; const LAS float* s = scr + (8 * c) * 33 + n;
        u32x4 o; o.x = pk2(s[0 * 33], s[1 * 33]); o.y = pk2(s[2 * 33], s[3 * 33]); o.z = pk2(s[4 * 33], s[5 * 33]); o.w = pk2(s[6 * 33], s[7 * 33]);
        if (n0 + n < N) *(u32x4*)(WT + (size_t)wmap(kind, n0 + n) * K + k0 + 8 * c) = o; }
    asm volatile("s_waitcnt lgkmcnt(0)" ::: "memory");
}
DI void norm_row_to_bf16(const float* xrow, const float* g, bf16_t* orow, int lane) {
    f32x4 v[4]; float s = 0.f;
#pragma unroll
    for (int j = 0; j < 4; ++j) { v[j] = ((const f32x4*)xrow)[lane + 64 * j]; s += (v[j].x * v[j].x + v[j].y * v[j].y) + (v[j].z * v[j].z + v[j].w * v[j].w); }
    const float rstd = 1.0f / sqrtf(wave_sum(s) * (1.0f / DM) + EPS);
#pragma unroll
    for (int j = 0; j < 4; ++j) { const f32x4 gg = ((const f32x4*)g)[lane + 64 * j]; const f32x4 y = v[j] * rstd * gg;
        ((u32x2*)orow)[lane + 64 * j] = (u32x2){pk2(y.x, y.y), pk2(y.z, y.w)}; }
}
DI void norm_rows2_to_bf16(const float* x0, const float* x1, const float* g, bf16_t* o0, bf16_t* o1, int lane) {
    f32x4 v[4], w[4]; float s = 0.f, t = 0.f;
#pragma unroll
    for (int j = 0; j < 4; ++j) { v[j] = ((const f32x4*)x0)[lane + 64 * j]; w[j] = ((const f32x4*)x1)[lane + 64 * j]; }
#pragma unroll
    for (int j = 0; j < 4; ++j) { s += (v[j].x * v[j].x + v[j].y * v[j].y) + (v[j].z * v[j].z + v[j].w * v[j].w); t += (w[j].x * w[j].x + w[j].y * w[j].y) + (w[j].z * w[j].z + w[j].w * w[j].w); }
#pragma unroll
    for (int o = 1; o < 64; o <<= 1) { s += __shfl_xor(s, o); t += __shfl_xor(t, o); }
    const float rs = 1.0f / sqrtf(s * (1.0f / DM) + EPS), rt = 1.0f / sqrtf(t * (1.0f / DM) + EPS);
#pragma unroll
    for (int j = 0; j < 4; ++j) { const f32x4 gg = ((const f32x4*)g)[lane + 64 * j]; const f32x4 y = v[j] * rs * gg, z = w[j] * rt * gg;
        ((u32x2*)o0)[lane + 64 * j] = (u32x2){pk2(y.x, y.y), pk2(y.z, y.w)}; ((u32x2*)o1)[lane + 64 * j] = (u32x2){pk2(z.x, z.y), pk2(z.z, z.w)}; }
}
DI void rope_entry(float* tab, int idx) {
    const int pos = idx >> 4, i = idx & 15;
    double inv = 1.0; for (int k = 0; k < i; ++k) inv *= 0.5623413251903491;
    const double ang = (double)pos * inv;
    const double k2 = __builtin_rint(ang * 0.15915494309189535);
    double r = __builtin_fma(-k2, 6.283185307179586, ang); r = __builtin_fma(-k2, 2.4492935982947064e-16, r);
    const double q = __builtin_rint(r * 0.6366197723675814);
    const double y = __builtin_fma(-q, 1.5707963267948966, r), y2 = y * y;
    double sp = 1.0 / 6227020800.0; sp = sp * y2 - 1.0 / 39916800.0; sp = sp * y2 + 1.0 / 362880.0; sp = sp * y2 - 1.0 / 5040.0; sp = sp * y2 + 1.0 / 120.0; sp = sp * y2 - 1.0 / 6.0; sp = sp * y2 + 1.0;
    const double sn = sp * y;
    double cp = -1.0 / 87178291200.0; cp = cp * y2 + 1.0 / 479001600.0; cp = cp * y2 - 1.0 / 3628800.0; cp = cp * y2 + 1.0 / 40320.0; cp = cp * y2 - 1.0 / 720.0; cp = cp * y2 + 1.0 / 24.0; cp = cp * y2 - 0.5; cp = cp * y2 + 1.0;
    const int qi = ((int)q) & 3;
    const double s = (qi == 0) ? sn : (qi == 1) ? cp : (qi == 2) ? -sn : -cp;
    const double c = (qi == 0) ? cp : (qi == 1) ? -sn : (qi == 2) ? -cp : sn;
    tab[pos * 32 + i] = (float)c; tab[pos * 32 + 16 + i] = (float)s;
}
DI void cache_cum_group(const float* lf, float* clc, float* ctt, int g, int lane) {
    f32x4 v = ((const f32x4*)(lf + (size_t)g * 256))[lane];
#pragma unroll
    for (int off = 2; off < 64; off <<= 1) {
        f32x4 t; t.x = __shfl_up(v.x, off); t.y = __shfl_up(v.y, off); t.z = __shfl_up(v.z, off); t.w = __shfl_up(v.w, off);
        if (lane >= off) v = v + t;
    }
    ((f32x4*)(clc + (size_t)g * 256))[lane] = v;
    if (lane >= 62) *(f32x4*)(ctt + (size_t)g * 8 + 4 * (lane & 1)) = v;
}
DI float log_sigmoid(float z) { return fminf(z, 0.f) - log1pf(expf(-fabsf(z))); }

DI void p2_group(const Params& p, int gi, int lane) {
    unsigned char* ws = p.ws;
    const bf16_t* projc = (const bf16_t*)(ws + WS_PROJC);
    bf16_t* cqn = (bf16_t*)(ws + WS_CQN); bf16_t* latn = (bf16_t*)(ws + WS_LATN); bf16_t* krb = (bf16_t*)(ws + WS_KR);
    const float* rope = (const float*)(ws + WS_ROPE); float* LC = (float*)(ws + WS_LC); float* TT = (float*)(ws + WS_TT);
    const float* qn = p.in[11]; const float* kvn = p.in[13]; const float* bfg = p.in[10];
    const int row0 = gi * 32, nrows = (gi == NGRP - 1) ? 16 : 32;
    f32x4 g0a, g0b, g1a, g1b;
    if (lane < 32) { g0a = *(const f32x4*)(kvn + 8 * lane); g0b = *(const f32x4*)(kvn + 8 * lane + 4); }
    else { g0a = *(const f32x4*)(qn + 8 * (lane - 32)); g0b = *(const f32x4*)(qn + 8 * (lane - 32) + 4); }
    if (lane < 16) { g1a = *(const f32x4*)(qn + 256 + 8 * lane); g1b = *(const f32x4*)(qn + 256 + 8 * lane + 4); } else { g1a = (f32x4){0, 0, 0, 0}; g1b = g1a; }
    const float bfl = bfg[lane & 7];
    float run1 = 0.f;
#pragma unroll 1
    for (int rr0 = 0; rr0 < nrows; rr0 += 4) {
      u32x4 w0s[4], w1s[4];
#pragma unroll
      for (int k = 0; k < 4; ++k) { const bf16_t* pr = projc + (size_t)(row0 + rr0 + k) * 768;
          w0s[k] = *(const u32x4*)(pr + 8 * lane); w1s[k] = (u32x4){0, 0, 0, 0}; if (lane < 32) w1s[k] = *(const u32x4*)(pr + 512 + 8 * lane); }
#pragma unroll
      for (int k = 0; k < 4; ++k) {
        const int row = row0 + rr0 + k;
        const u32x4 w0 = w0s[k], w1 = w1s[k];
        float a[8], b[8];
#pragma unroll
        for (int i = 0; i < 4; ++i) { a[2 * i] = __uint_as_float(w0[i] << 16); a[2 * i + 1] = __uint_as_float(w0[i] & 0xffff0000u);
                                      b[2 * i] = __uint_as_float(w1[i] << 16); b[2 * i + 1] = __uint_as_float(w1[i] & 0xffff0000u); }
        float sa = 0.f, sb = 0.f;
#pragma unroll
        for (int i = 0; i < 8; ++i) { sa += a[i] * a[i]; sb += b[i] * b[i]; }
        float skv = (lane < 32) ? sa : 0.f, sq = ((lane >= 32) ? sa : 0.f) + ((lane < 16) ? sb : 0.f);
        skv = wave_sum(skv); sq = wave_sum(sq);
        const float rkv = 1.0f / sqrtf(skv * (1.0f / 256.0f) + EPS), rq = 1.0f / sqrtf(sq * (1.0f / 384.0f) + EPS);
        const float r0 = (lane < 32) ? rkv : rq;
        f32x4 y0 = (f32x4){a[0], a[1], a[2], a[3]} * r0 * g0a, y1 = (f32x4){a[4], a[5], a[6], a[7]} * r0 * g0b;
        if (lane < 32) { *(u32x4*)(latn + (size_t)row * 256 + 8 * lane) = pack8(y0, y1);
            out_store8(p.out + O_LATP, p.out + O_LATS, 256, row, 8 * lane, y0, y1); }
        else { *(u32x4*)(cqn + (size_t)row * 384 + 8 * (lane - 32)) = pack8(y0, y1); }
        if (lane < 16) { f32x4 z0 = (f32x4){b[0], b[1], b[2], b[3]} * rq * g1a, z1 = (f32x4){b[4], b[5], b[6], b[7]} * rq * g1b;
            *(u32x4*)(cqn + (size_t)row * 384 + 256 + 8 * lane) = pack8(z0, z1); }
        float ob[8];
#pragma unroll
        for (int i = 0; i < 8; ++i) ob[i] = __shfl_xor(b[i], 2);
        if (lane >= 16 && lane < 20) {
            const int pos = row_pos(row); const bool first = lane < 18; const int j0 = 8 * (lane - (first ? 16 : 18));
            const float* t = rope + (size_t)pos * 32 + j0;
            const f32x4 c0 = *(const f32x4*)t, c1 = *(const f32x4*)(t + 4), s0 = *(const f32x4*)(t + 16), s1 = *(const f32x4*)(t + 20);
            float cc[8] = {c0.x, c0.y, c0.z, c0.w, c1.x, c1.y, c1.z, c1.w}, ss[8] = {s0.x, s0.y, s0.z, s0.w, s1.x, s1.y, s1.z, s1.w};
            float o[8];
#pragma unroll
            for (int i = 0; i < 8; ++i) o[i] = first ? (b[i] * cc[i] - ob[i] * ss[i]) : (b[i] * cc[i] + ob[i] * ss[i]);
            const f32x4 o0 = (f32x4){o[0], o[1], o[2], o[3]}, o1 = (f32x4){o[4], o[5], o[6], o[7]};
            *(u32x4*)(krb + (size_t)row * 32 + 8 * (lane - 16)) = pack8(o0, o1);
            out_store8(p.out + O_KRP, p.out + O_KRS, 32, row, 8 * (lane - 16), o0, o1);
        }
        {
            float z = 0.f;
#pragma unroll
            for (int i = 0; i < 8; ++i) { const float t = __shfl(b[i], 20); if ((lane & 7) == i) z = t; }
            const float lf = log_sigmoid(z + bfl);
            run1 += lf;
            if (lane < 8) {
                LC[(size_t)row * 8 + lane] = run1;
                if (row < RS0) { const int bb = row >> 13, t = row & 8191; p.out[O_LFP + (size_t)(bb * LP + NMETA + t) * 8 + lane] = lf; }
                else if (row < RM0) { p.out[O_LFS + (size_t)(row - RS0) * 8 + lane] = lf; }
                else { const int m = row - RM0;
#pragma unroll 1
                    for (int bb = 0; bb < NB; ++bb) p.out[O_LFP + (size_t)(bb * LP + m) * 8 + lane] = lf; }
            }
        }
      }
    }
    if (lane < 8) TT[(size_t)gi * 8 + lane] = run1;
}

template <int DK> struct ACfg { static constexpr int NK = (DK == 64) ? 5 : 6, KP = (DK == 64) ? 176 : 208; };
constexpr int VP = 192;
constexpr float THR = 8.0f;
#define MFMA32(a, b, c) __builtin_amdgcn_mfma_f32_32x32x16_bf16((a), (b), (c), 0, 0, 0)
DI int crow(int r, int hi) { return (r & 3) + 8 * (r >> 2) + 4 * hi; }
DI s16x4 vtr(const LAS unsigned char* p) { return __builtin_bit_cast(s16x4, __builtin_amdgcn_ds_read_tr16_b64_v4i16((LAS v4i16_t*)p)); }
DI float bf16_round(float x) { return __uint_as_float(pk2(x, 0.f) << 16); }
DI u32x4 bias_chunk(float bv) {
    const unsigned h = pk2(bv, 0.f) & 0xffffu; const float r1 = bv - __uint_as_float(h << 16);
    const unsigned m = pk2(r1, 0.f) & 0xffffu; const float r2 = r1 - __uint_as_float(m << 16);
    const unsigned l = pk2(r2, 0.f) & 0xffffu;
    return (u32x4){0x3F80u | (h << 16), m | (l << 16), 0u, 0u};
}
DI void rope_qfrag(bf16x8& x1, bf16x8& x2, const float* t) {
    const f32x4 c0 = *(const f32x4*)t, c1 = *(const f32x4*)(t + 4), s0 = *(const f32x4*)(t + 16), s1 = *(const f32x4*)(t + 20);
    const float cc[8] = {c0.x, c0.y, c0.z, c0.w, c1.x, c1.y, c1.z, c1.w}, ss[8] = {s0.x, s0.y, s0.z, s0.w, s1.x, s1.y, s1.z, s1.w};
    float o1[8], o2[8];
#pragma unroll
    for (int i = 0; i < 8; ++i) { const float a = bf2f((unsigned short)x1[i]), b = bf2f((unsigned short)x2[i]); o1[i] = a * cc[i] - b * ss[i]; o2[i] = b * cc[i] + a * ss[i]; }
    const u32x4 w1 = (u32x4){pk2(o1[0], o1[1]), pk2(o1[2], o1[3]), pk2(o1[4], o1[5]), pk2(o1[6], o1[7])};
    const u32x4 w2 = (u32x4){pk2(o2[0], o2[1]), pk2(o2[2], o2[3]), pk2(o2[4], o2[5]), pk2(o2[6], o2[7])};
    x1 = __builtin_bit_cast(bf16x8, w1); x2 = __builtin_bit_cast(bf16x8, w2);
}
template <int DK, bool FOX>
DI void load_qfrags(const Params& p, int qrow0  , int r32, int h, int hi, bf16x8 (&qf)[DK / 16 + 1]) {
    unsigned char* ws = p.ws;
    const char* qb_ = FOX ? (const char*)((const bf16_t*)(ws + WS_FQ) + (size_t)qrow0 * 512 + h * 64) : (const char*)((const bf16_t*)(ws + WS_QMLA) + (size_t)qrow0 * 768 + h * 96);
    const unsigned qo = (unsigned)(r32 * (FOX ? 512 : 768) + 8 * hi) * 2u;
#pragma unroll
    for (int d0 = 0; d0 < DK / 16; ++d0) qf[d0] = *(const bf16x8*)(qb_ + qo + 32 * d0);
    if (!FOX) { const char* rt_ = (const char*)((const float*)(ws + WS_ROPE) + (size_t)row_pos(qrow0) * 32); rope_qfrag(qf[DK / 16 - 2], qf[DK / 16 - 1], (const float*)(rt_ + (unsigned)(r32 * 32 + 8 * hi) * 4u)); }
    const u32x4 ex = hi == 0 ? (u32x4){0x3F800000u, 0x3F803F80u, 0u, 0u} : (u32x4){0u, 0u, 0u, 0u};
    qf[DK / 16] = __builtin_bit_cast(bf16x8, ex);
}
template <int DK, int NKB>
DI void attn_qk(const LAS unsigned char* Kb, const bf16x8 (&qf)[DK / 16 + 1], f32x16 (&s)[NKB], int lane, const f32x16& negm) {
    constexpr int NK = ACfg<DK>::NK, KP = ACfg<DK>::KP;
    const LAS unsigned char* kp = Kb + (lane & 31) * KP + (lane >> 5) * 16;
    f32x16 z;
#pragma unroll
    for (int r = 0; r < 16; ++r) z[r] = (DK == 64) ? 0.f : negm[r];
#pragma unroll
    for (int d0 = 0; d0 < NK; ++d0)
#pragma unroll
        for (int blk = 0; blk < NKB; ++blk) {
            const bf16x8 kf = *(const LAS bf16x8*)(kp + blk * 32 * KP + d0 * 32);
            s[blk] = MFMA32(kf, qf[d0], d0 == 0 ? z : s[blk]);
        }
}
template <int NKB, bool CINIT>
DI void attn_sm_a(f32x16 (&s)[NKB], f32x16 (&o)[2], float& rref, float& l, bf16x8& qfx, bool first, int maskmode, int mparam, int lane, float& rmin, f32x16& negm) {
    const int r32 = lane & 31, hi = lane >> 5;
    if (CINIT && maskmode == 1) {
#pragma unroll
        for (int blk = 0; blk < NKB; ++blk)
#pragma unroll
            for (int r = 0; r < 16; ++r) if (blk * 32 + crow(r, hi) < 48) s[blk][r] = NEGF;
    }
    if (maskmode == 2) {
        const int lim = mparam + r32;
#pragma unroll
        for (int blk = 0; blk < NKB; ++blk)
#pragma unroll
            for (int r = 0; r < 16; ++r) if (blk * 32 + crow(r, hi) > lim) s[blk][r] = NEGF;
    }
    float mx = s[0][0];
#pragma unroll
    for (int blk = 0; blk < NKB; ++blk)
#pragma unroll
        for (int r = 0; r < 16; ++r) mx = fmaxf(mx, s[blk][r]);
    mx = fmaxf(mx, __shfl_xor(mx, 32));
    const bool need = first || (mx > THR);
    if (__any(need)) {
        const float rn = need ? bf16_round(rref + mx) : rref;
        const float d = rn - rref; rref = rn;
#pragma unroll
        for (int blk = 0; blk < NKB; ++blk)
#pragma unroll
            for (int r = 0; r < 16; ++r) s[blk][r] -= d;
        const float f = __builtin_amdgcn_exp2f(-d);
        l *= f;
#pragma unroll
        for (int dd = 0; dd < 2; ++dd)
#pragma unroll
            for (int r = 0; r < 16; ++r) o[dd][r] *= f;
        if (CINIT) {
#pragma unroll
            for (int r = 0; r < 16; ++r) negm[r] = -rref;
        } else if (hi == 0) qfx[0] = (short)(pk2(-rref, 0.f) & 0xffffu);
        float mn = rref;
#pragma unroll
        for (int off = 1; off < 64; off <<= 1) mn = fminf(mn, __shfl_xor(mn, off));
        rmin = mn;
    }
}
template <int NKB>
DI void attn_sm_b(f32x16 (&s)[NKB], float& l, bf16x8 (&pf)[NKB][2]) {
    float ls = 0.f;
#pragma unroll
    for (int blk = 0; blk < NKB; ++blk)
#pragma unroll
        for (int r = 0; r < 16; ++r) { s[blk][r] = __builtin_amdgcn_exp2f(s[blk][r]); ls += s[blk][r]; }
    l += ls;
#pragma unroll
    for (int blk = 0; blk < NKB; ++blk)
#pragma unroll
        for (int s2 = 0; s2 < 2; ++s2) {
            const u32x4 w = (u32x4){pk2(s[blk][8 * s2 + 0], s[blk][8 * s2 + 1]), pk2(s[blk][8 * s2 + 2], s[blk][8 * s2 + 3]),
                                    pk2(s[blk][8 * s2 + 4], s[blk][8 * s2 + 5]), pk2(s[blk][8 * s2 + 6], s[blk][8 * s2 + 7])};
            pf[blk][s2] = __builtin_bit_cast(bf16x8, w);
        }
}
template <int NKB>
DI void attn_pv(const LAS unsigned char* Vb, const bf16x8 (&pf)[NKB][2], f32x16 (&o)[2], int lane) {
    const int hi = lane >> 5, q4 = (lane & 15) >> 2, p4 = lane & 3, gb = (lane >> 4) & 1;
    const LAS unsigned char* vp = Vb + (4 * hi + q4) * VP + 32 * gb + 8 * p4;
#pragma unroll
    for (int blk = 0; blk < NKB; ++blk)
#pragma unroll
        for (int s2 = 0; s2 < 2; ++s2)
#pragma unroll
            for (int d = 0; d < 2; ++d) {
                const LAS unsigned char* a = vp + (blk * 32 + 16 * s2) * VP + d * 64;
                const s16x4 lo = vtr(a), hi4 = vtr(a + 8 * VP);
                const bf16x8 vf = __builtin_shufflevector(lo, hi4, 0, 1, 2, 3, 4, 5, 6, 7);
                o[d] = MFMA32(vf, pf[blk][s2], o[d]);
            }
}
template <int NKB>
DI void attn_sm_pv(f32x16 (&s)[NKB], float& l, const LAS unsigned char* Vb, f32x16 (&o)[2], int lane) {
    const int hi = lane >> 5, q4 = (lane & 15) >> 2, p4 = lane & 3, gb = (lane >> 4) & 1;
    const LAS unsigned char* vp = Vb + (4 * hi + q4) * VP + 32 * gb + 8 * p4;
    float ls0 = 0.f, ls1 = 0.f;
#pragma unroll
    for (int blk = 0; blk < NKB; ++blk) {
#pragma unroll
        for (int r = 0; r < 16; r += 2) { s[blk][r] = __builtin_amdgcn_exp2f(s[blk][r]); s[blk][r + 1] = __builtin_amdgcn_exp2f(s[blk][r + 1]); ls0 += s[blk][r]; ls1 += s[blk][r + 1]; }
#pragma unroll
        for (int s2 = 0; s2 < 2; ++s2) {
            const u32x4 w = (u32x4){pk2(s[blk][8 * s2 + 0], s[blk][8 * s2 + 1]), pk2(s[blk][8 * s2 + 2], s[blk][8 * s2 + 3]),
                                    pk2(s[blk][8 * s2 + 4], s[blk][8 * s2 + 5]), pk2(s[blk][8 * s2 + 6], s[blk][8 * s2 + 7])};
            const bf16x8 pfr = __builtin_bit_cast(bf16x8, w);
#pragma unroll
            for (int d = 0; d < 2; ++d) {
                const LAS unsigned char* a = vp + (blk * 32 + 16 * s2) * VP + d * 64;
                const s16x4 lo = vtr(a), hi4 = vtr(a + 8 * VP);
                const bf16x8 vf = __builtin_shufflevector(lo, hi4, 0, 1, 2, 3, 4, 5, 6, 7);
                o[d] = MFMA32(vf, pfr, o[d]);
            }
        }
    }
    l += ls0 + ls1;
}
DI void attn_store_o(bf16_t* orow, const f32x16 (&o)[2], float l, int hi) {
    l = l + __shfl_xor(l, 32);
    const float inv = 1.0f / l;
#pragma unroll
    for (int d = 0; d < 2; ++d)
#pragma unroll
        for (int g = 0; g < 4; ++g)
            *(u32x2*)(orow + d * 32 + 8 * g + 4 * hi) = (u32x2){pk2(o[d][4 * g] * inv, o[d][4 * g + 1] * inv), pk2(o[d][4 * g + 2] * inv, o[d][4 * g + 3] * inv)};
}

constexpr int A_K0 = 0, A_KSZ = 2 * 15360, A_V0 = 2 * A_KSZ, A_VSZ = 2 * 64 * VP, A_TP = A_V0 + 2 * A_VSZ, A_CBN = A_TP + 1024, A_FLG = A_CBN + 64;
template <bool FOX>
DI void attn_prompt_unit(const Params& p, LAS unsigned char* lds, int b, int h, int qb) {
    constexpr int DK = FOX ? 64 : 96, CPR = DK / 8, NK = ACfg<DK>::NK, KP = ACfg<DK>::KP;
    unsigned char* ws = p.ws;
    int tid_o = threadIdx.x; asm volatile("" : "+v"(tid_o));
    const int tid = tid_o, lane = tid & 63, wid = __builtin_amdgcn_readfirstlane(tid >> 6), r32 = lane & 31, hi = lane >> 5;
    const bf16_t* kh = (const bf16_t*)(ws + (FOX ? WS_FKH : WS_KNH)) + (size_t)h * RT * 64; const bf16_t* vh = (const bf16_t*)(ws + (FOX ? WS_FVH : WS_VMH)) + (size_t)h * RT * 64;
    const bf16_t* krb = (const bf16_t*)(ws + WS_KR); const float* LC = (const float*)(ws + WS_LC); const float* TT = (const float*)(ws + WS_TT);
    bf16_t* mixed = (bf16_t*)(ws + WS_MIXED);
    LAS float* TPs = (LAS float*)(lds + A_TP);
    __syncthreads();
    if (FOX && wid == 0) {
        float t[4];
#pragma unroll
        for (int i = 0; i < 4; ++i) t[i] = TT[(size_t)(b * 256 + 4 * lane + i) * 8 + h];
        float e[4]; e[0] = 0.f; e[1] = t[0]; e[2] = t[0] + t[1]; e[3] = e[2] + t[2]; const float tot = e[3] + t[3];
        float inc = tot;
#pragma unroll
        for (int off = 1; off < 64; off <<= 1) { const float v = __shfl_up(inc, off); if (lane >= off) inc += v; }
        const float ex = inc - tot;
#pragma unroll
        for (int i = 0; i < 4; ++i) TPs[4 * lane + i] = ex + e[i];
    }
    __syncthreads();
    const float ref = FOX ? TPs[8 * qb] : 0.f;
    const float tpmeta = FOX ? -TT[(size_t)(NGRP - 1) * 8 + h] : 0.f;
    const int qrow = b * SEQ + 256 * qb + 32 * wid + r32;
    bf16x8 qf[DK / 16 + 1];
    f32x16 o[2];
#pragma unroll
    for (int r = 0; r < 16; ++r) { o[0][r] = 0.f; o[1][r] = 0.f; }
    float rref = 0.f, l = 0.f, rmin = 0.f, qkb = 0.f;
    f32x16 negm;
#pragma unroll
    for (int r = 0; r < 16; ++r) negm[r] = 0.f;
    LAS float* CBN = (LAS float*)(lds + A_CBN); LAS int* FLG = (LAS int*)(lds + A_FLG);
    bool done = false;
    const int ktmax = 4 * qb + 3, mykt = 4 * qb + (wid >> 1);
    const int vj = tid >> 3, vp = tid & 7, rj = tid >> 2, rp = tid & 3;
    u32x4 rk0_0, rk0_1, rk1_0 = (u32x4){0, 0, 0, 0}, rk1_1 = (u32x4){0, 0, 0, 0}, rv_0, rv_1; float rb_0 = 0.f, rb_1 = 0.f;
#define TROW0(kt) ((kt) < 0 ? RM0 : b * SEQ + 64 * (kt))
#define JOFF(kt, j) ((kt) < 0 ? ((j) >= 48 ? (j) - 48 : 0) : (j))
#define LOADKV(kt, U) do { const int r0_ = TROW0(kt); \
        { const unsigned of_ = (unsigned)(JOFF(kt, vj) * 64 + vp * 8) * 2u; \
          rk0_##U = *(const u32x4*)((const char*)(kh + (size_t)r0_ * 64) + of_); rv_##U = *(const u32x4*)((const char*)(vh + (size_t)r0_ * 64) + of_); } \
        if (!FOX) { \
               if (tid < 256) { const char* rb_ = (const char*)(krb + (size_t)r0_ * 32); rk1_##U = *(const u32x4*)(rb_ + (unsigned)(JOFF(kt, rj) * 32 + rp * 8) * 2u); } } \
        if (tid < 64) { rb_##U = 0.f; \
          if (FOX) { const float tp = (kt) < 0 ? tpmeta : TPs[2 * (kt) + (tid >> 5)]; rb_##U = -(*(const float*)((const char*)(LC + (size_t)r0_ * 8 + h) + (unsigned)JOFF(kt, tid) * 32u) + tp - ref) * LOG2E; } \
          if ((kt) < 0 && tid < 48) rb_##U = NEGF; } \
    } while (0)
#define STOREKV(slot, U) do { LAS unsigned char* B_ = lds + A_K0 + (slot) * A_KSZ + (U) * 64 * KP; \
        *(LAS u32x4*)(B_ + vj * KP + vp * 16) = rk0_##U; \
        if (!FOX && tid < 256) *(LAS u32x4*)(B_ + rj * KP + (8 + rp) * 16) = rk1_##U; \
        if (FOX && tid < 64) { *(LAS u32x4*)(B_ + tid * KP + DK * 2) = bias_chunk(rb_##U); *(LAS u32x4*)(B_ + tid * KP + DK * 2 + 16) = (u32x4){0u, 0u, 0u, 0u}; } \
        *(LAS u32x4*)(lds + A_V0 + (slot) * A_VSZ + (U) * 64 * VP + vj * VP + vp * 16) = rv_##U; \
        if (FOX && tid == 63) CBN[(slot) * 2 + (U)] = rb_##U; \
    } while (0)
#define COMPUTE(kt, slot, U) do { \
        if (FOX && !first && !done && CBN[(slot) * 2 + (U)] + qkb - rmin < -130.0f) done = true;     \
        if ((kt) <= mykt && !done) { \
            const int mm = (FOX && (kt) == mykt) ? 2 : ((!FOX && (kt) < 0) ? 1 : 0); \
            attn_qk<DK, 2>(lds + A_K0 + (slot) * A_KSZ + (U) * 64 * KP, qf, sA, lane, negm); \
            attn_sm_a<2, !FOX>(sA, o, rref, l, qf[DK / 16], first, mm, 32 * (wid & 1), lane, rmin, negm); \
            first = false; \
            attn_sm_pv<2>(sA, l, lds + A_V0 + (slot) * A_VSZ + (U) * 64 * VP, o, lane); } } while (0)
    const int Smax = 2 * qb + 1;
    LOADKV(2 * Smax + 1, 0); LOADKV(2 * Smax, 1);
    load_qfrags<DK, FOX>(p, b * SEQ + 256 * qb + 32 * wid, r32, h, hi, qf);
    if (FOX) {
        float a = 0.f, c = 0.f;
#pragma unroll
        for (int i = 0; i < 8; ++i) { const float x0 = bf2f((unsigned short)qf[0][i]), x1 = bf2f((unsigned short)qf[1][i]), x2 = bf2f((unsigned short)qf[2][i]), x3 = bf2f((unsigned short)qf[3][i]);
            a += x0 * x0 + x1 * x1; c += x2 * x2 + x3 * x3; }
        a += __shfl_xor(a, 32); c += __shfl_xor(c, 32);
#pragma unroll
        for (int off = 1; off < 32; off <<= 1) { a = fmaxf(a, __shfl_xor(a, off)); c = fmaxf(c, __shfl_xor(c, off)); }
        const unsigned* kn2 = (const unsigned*)(ws + WS_KINF) + 2 * h;
        qkb = 1.02f * (sqrtf(a * __uint_as_float(kn2[0])) + sqrtf(c * __uint_as_float(kn2[1])));
    }
    STOREKV(Smax & 1, 0); STOREKV(Smax & 1, 1);
    __syncthreads();
    f32x16 sA[2];
    bool first = true;
    if (wid >= 4) __builtin_amdgcn_s_setprio(1);
#pragma unroll 1
    for (int S = Smax; S >= -1; --S) {
        const int slot = S & 1;
        if (S >= 1) { LOADKV(2 * S - 1, 0); LOADKV(2 * S - 2, 1); } else if (S == 0) { LOADKV(-1, 0); }
        if (S >= 0) { COMPUTE(2 * S + 1, slot, 0); COMPUTE(2 * S, slot, 1); } else { COMPUTE(-1, slot, 0); }
        if (S >= 1) { STOREKV(slot ^ 1, 0); STOREKV(slot ^ 1, 1); } else if (S == 0) { STOREKV(slot ^ 1, 0); }
        if (FOX && lane == 0) FLG[slot * 8 + wid] = done ? 1 : 0;
        __syncthreads();
        if (FOX) { const i32x4 f0 = *(const LAS i32x4*)(FLG + slot * 8), f1 = *(const LAS i32x4*)(FLG + slot * 8 + 4);
            if ((f0.x & f0.y & f0.z & f0.w & f1.x & f1.y & f1.z & f1.w) != 0) break; }
    }
    __builtin_amdgcn_s_setprio(0);
#undef LOADKV
#undef STOREKV
#undef COMPUTE
#undef TROW0
#undef JOFF
    attn_store_o(mixed + (size_t)qrow * 1024 + (FOX ? 512 : 0) + h * 64, o, l, hi);
}

constexpr int SWB = 14336, S_V = 7680, S_TP = S_V + 32 * VP;
constexpr int M_O = 0, M_ML = 65536;
template <bool FOX>
DI void attn_sample_unit(const Params& p, LAS unsigned char* lds0, int sb, int h) {
    constexpr int DK = FOX ? 64 : 96, CPR = DK / 8, NK = ACfg<DK>::NK, KP = ACfg<DK>::KP, NKC = 32 * CPR / 64;
    unsigned char* ws = p.ws;
    int tid_o = threadIdx.x; asm volatile("" : "+v"(tid_o));
    const int tid = tid_o, lane = tid & 63, wid = __builtin_amdgcn_readfirstlane(tid >> 6), r32 = lane & 31, hi = lane >> 5;
    LAS unsigned char* lds = lds0 + wid * SWB;
    const bf16_t* kh = (const bf16_t*)(ws + (FOX ? WS_FKH : WS_KNH)) + (size_t)h * RT * 64; const bf16_t* vh = (const bf16_t*)(ws + (FOX ? WS_FVH : WS_VMH)) + (size_t)h * RT * 64;
    const bf16_t* knc = (const bf16_t*)(ws + WS_KNC) + (size_t)h * 131072 * 64; const bf16_t* vmc = (const bf16_t*)(ws + WS_VMC) + (size_t)h * 131072 * 64;
    const bf16_t* krb = (const bf16_t*)(ws + WS_KR); const bf16_t* ckr = (const bf16_t*)(ws + WS_CKR);
    const float* LC = (const float*)(ws + WS_LC); const float* CLC = (const float*)(ws + WS_CLC); const float* CTT = (const float*)(ws + WS_CTT);
    const float* cfk = p.in[4]; const float* cfv = p.in[5];
    bf16_t* mixed = (bf16_t*)(ws + WS_MIXED);
    LAS float* TPs = (LAS float*)(lds + S_TP);
    __syncthreads();
    float tall = 0.f;
    if (FOX) {
        const float t0 = CTT[(size_t)(sb * 128 + 2 * lane) * 8 + h], t1 = CTT[(size_t)(sb * 128 + 2 * lane + 1) * 8 + h];
        const float tot = t0 + t1; float inc = tot;
#pragma unroll
        for (int off = 1; off < 64; off <<= 1) { const float v = __shfl_up(inc, off); if (lane >= off) inc += v; }
        const float ex = inc - tot;
        TPs[2 * lane] = ex; TPs[2 * lane + 1] = ex + t0;
        tall = __shfl(inc, 63);
    }
    const int row0 = RS0 + sb * 32, qrow = row0 + r32;
    bf16x8 qf[DK / 16 + 1];
    load_qfrags<DK, FOX>(p, row0, r32, h, hi, qf);
    f32x16 o[2];
#pragma unroll
    for (int r = 0; r < 16; ++r) { o[0][r] = 0.f; o[1][r] = 0.f; }
    float rref = 0.f, l = 0.f, rmin = 0.f;
    f32x16 negm;
#pragma unroll
    for (int r = 0; r < 16; ++r) negm[r] = 0.f;
    f32x16 s1[1];
    bool first = true;
    if (wid == 0) {
        const char* nk_ = (const char*)(kh + (size_t)row0 * 64); const char* nv_ = (const char*)(vh + (size_t)row0 * 64);
#pragma unroll
        for (int i = 0; i < 4; ++i) { const unsigned off = (unsigned)(((lane >> 3) + 8 * i) * 64 + (lane & 7) * 8) * 2u;
            *(LAS u32x4*)(lds + (lane >> 3) * KP + (lane & 7) * 16 + i * 8 * KP) = *(const u32x4*)(nk_ + off); *(LAS u32x4*)(lds + S_V + (lane >> 3) * VP + (lane & 7) * 16 + i * 8 * VP) = *(const u32x4*)(nv_ + off); }
        if (!FOX) { const char* nr_ = (const char*)(krb + (size_t)row0 * 32);
#pragma unroll
            for (int i = 0; i < 2; ++i) *(LAS u32x4*)(lds + (lane >> 2) * KP + (8 + (lane & 3)) * 16 + i * 16 * KP) = *(const u32x4*)(nr_ + (unsigned)((lane >> 2) * 32 + (lane & 3) * 8) * 2u + i * 16 * 64); }
        if (FOX && lane < 32) { const float bv = FOX ? -(*(const float*)((const char*)(LC + (size_t)row0 * 8 + h) + (unsigned)lane * 32u)) * LOG2E : 0.f;
            *(LAS u32x4*)(lds + lane * KP + DK * 2) = bias_chunk(bv); *(LAS u32x4*)(lds + lane * KP + DK * 2 + 16) = (u32x4){0u, 0u, 0u, 0u}; }
        asm volatile("s_waitcnt lgkmcnt(0)" ::: "memory");
        attn_qk<DK, 1>(lds, qf, s1, lane, negm);
        attn_sm_a<1, !FOX>(s1, o, rref, l, qf[DK / 16], true, FOX ? 2 : 0, 0, lane, rmin, negm);
        attn_sm_pv<1>(s1, l, lds + S_V, o, lane);
        first = false;
    }
    const size_t crow0 = (size_t)sb * PAST;
    const unsigned ldk0 = (lane >> 3) * KP + (lane & 7) * 16, ldv0 = S_V + (lane >> 3) * VP + (lane & 7) * 16;
    const unsigned so0 = FOX ? (unsigned)((lane >> 3) * 512 + h * 64 + (lane & 7) * 8) * 4u : (unsigned)((lane >> 3) * 64 + (lane & 7) * 8) * 2u;
    constexpr unsigned SROW8 = FOX ? 8u * 512u * 4u : 8u * 64u * 2u;
    if (FOX) {
        f32x4 rk[4][2], rv[4][2]; float rc = 0.f;
#define LOADC(tt) do { const char* kb_ = (const char*)(cfk + (crow0 + 32 * (tt)) * 512); const char* vb_ = (const char*)(cfv + (crow0 + 32 * (tt)) * 512); \
            _Pragma("unroll") for (int i = 0; i < 4; ++i) { const unsigned so_ = so0 + i * SROW8; rk[i][0] = *(const f32x4*)(kb_ + so_); rk[i][1] = *(const f32x4*)(kb_ + so_ + 16); rv[i][0] = *(const f32x4*)(vb_ + so_); rv[i][1] = *(const f32x4*)(vb_ + so_ + 16); } \
            if (lane < 32) rc = *(const float*)((const char*)(CLC + (crow0 + 32 * (tt)) * 8 + h) + (unsigned)lane * 32u); } while (0)
        LOADC(127 - wid);
#pragma unroll 1
        for (int t = 127 - wid; t >= 0; t -= 8) {
#if 0
            for (int i = 0; i < 4; ++i) { const unsigned so_ = so0 + i * SROW8; rk[i][0] = *(const f32x4*)(kb_ + so_); rk[i][1] = *(const f32x4*)(kb_ + so_ + 16); rv[i][0] = *(const f32x4*)(vb_ + so_); rv[i][1] = *(const f32x4*)(vb_ + so_ + 16); }
#endif
#pragma unroll
            for (int i = 0; i < 4; ++i) { *(LAS u32x4*)(lds + ldk0 + i * 8 * KP) = pack8(rk[i][0], rk[i][1]); *(LAS u32x4*)(lds + ldv0 + i * 8 * VP) = pack8(rv[i][0], rv[i][1]); }
            if (lane < 32) { *(LAS u32x4*)(lds + lane * KP + DK * 2) = bias_chunk(-(rc + TPs[t] - tall) * LOG2E); *(LAS u32x4*)(lds + lane * KP + DK * 2 + 16) = (u32x4){0u, 0u, 0u, 0u}; }
            if (t >= 8) LOADC(t - 8);
            asm volatile("s_waitcnt lgkmcnt(0)" ::: "memory");
            attn_qk<DK, 1>(lds, qf, s1, lane, negm);
            attn_sm_a<1, !FOX>(s1, o, rref, l, qf[DK / 16], first, 0, 0, lane, rmin, negm);
            attn_sm_pv<1>(s1, l, lds + S_V, o, lane);
            first = false;
        }
#undef LOADC
    } else {
        const unsigned ro0 = (unsigned)((lane >> 2) * 32 + (lane & 3) * 8) * 2u, rld0 = (lane >> 2) * KP + (8 + (lane & 3)) * 16;
        u32x4 rk[4], rr[2], rv[4];
#define LOADC(tt) do { const char* kb_ = (const char*)(knc + (crow0 + 32 * (tt)) * 64); const char* vb_ = (const char*)(vmc + (crow0 + 32 * (tt)) * 64); const char* rb_ = (const char*)(ckr + (crow0 + 32 * (tt)) * 32); \
            _Pragma("unroll") for (int i = 0; i < 4; ++i) { const unsigned so_ = so0 + i * SROW8; rk[i] = *(const u32x4*)(kb_ + so_); rv[i] = *(const u32x4*)(vb_ + so_); } \
            _Pragma("unroll") for (int i = 0; i < 2; ++i) rr[i] = *(const u32x4*)(rb_ + ro0 + i * 16 * 64); } while (0)
        LOADC(127 - wid);
#pragma unroll 1
        for (int t = 127 - wid; t >= 0; t -= 8) {
#pragma unroll
            for (int i = 0; i < 4; ++i) { *(LAS u32x4*)(lds + ldk0 + i * 8 * KP) = rk[i]; *(LAS u32x4*)(lds + ldv0 + i * 8 * VP) = rv[i]; }
#pragma unroll
            for (int i = 0; i < 2; ++i) *(LAS u32x4*)(lds + rld0 + i * 16 * KP) = rr[i];
            if (t >= 8) LOADC(t - 8);
            asm volatile("s_waitcnt lgkmcnt(0)" ::: "memory");
            attn_qk<DK, 1>(lds, qf, s1, lane, negm);
            attn_sm_a<1, !FOX>(s1, o, rref, l, qf[DK / 16], first, 0, 0, lane, rmin, negm);
            attn_sm_pv<1>(s1, l, lds + S_V, o, lane);
            first = false;
        }
#undef LOADC
    }
    l = l + __shfl_xor(l, 32);
    __syncthreads();
    {
        LAS float* MO = (LAS float*)(lds0 + M_O) + (size_t)(wid * 32 + r32) * 64; LAS float* ML = (LAS float*)(lds0 + M_ML) + (wid * 32 + r32) * 2;
#pragma unroll
        for (int d = 0; d < 2; ++d)
#pragma unroll
            for (int g = 0; g < 4; ++g) *(LAS f32x4*)(MO + d * 32 + 8 * g + 4 * hi) = (f32x4){o[d][4 * g], o[d][4 * g + 1], o[d][4 * g + 2], o[d][4 * g + 3]};
        if (hi == 0) { ML[0] = rref; ML[1] = l; }
    }
    __syncthreads();
    {
        const int q = tid >> 4, c4 = (tid & 15) * 4;
        const LAS float* ML = (const LAS float*)(lds0 + M_ML) + q * 2; const LAS float* MO = (const LAS float*)(lds0 + M_O) + q * 64 + c4;
        float M = ML[0];
#pragma unroll
        for (int w = 1; w < 8; ++w) M = fmaxf(M, ML[w * 64]);
        float L = 0.f; f32x4 acc = (f32x4){0.f, 0.f, 0.f, 0.f};
#pragma unroll
        for (int w = 0; w < 8; ++w) { const float f = __builtin_amdgcn_exp2f(ML[w * 64] - M); L += ML[w * 64 + 1] * f; acc = acc + *(const LAS f32x4*)(MO + w * 2048) * f; }
        const float inv = 1.0f / L;
        *(u32x2*)((char*)(mixed + (size_t)row0 * 1024 + (FOX ? 512 : 0) + h * 64) + (unsigned)(q * 1024 + c4) * 2u) = (u32x2){pk2(acc.x * inv, acc.y * inv), pk2(acc.z * inv, acc.w * inv)};
    }
}

#define XB_TMO      128
#define XB_XCNT(j)  (256  + 64 * (j))
#define XB_XSUB(j)  (1280 + 64 * (j))
#define XB_XGEN(j)  (2304 + 64 * (j))
#define XB_TOP      3328
#define XB_TOPGEN   3392
#define XCD_BAR_WORDS 3456
#define XB_SPIN_CAP (1u << 18)

__device__ __forceinline__ unsigned xb_ld(unsigned* p)              { return __hip_atomic_load(p, __ATOMIC_RELAXED, __HIP_MEMORY_SCOPE_AGENT); }
__device__ __forceinline__ unsigned xb_add(unsigned* p, unsigned v) { return __hip_atomic_fetch_add(p, v, __ATOMIC_RELAXED, __HIP_MEMORY_SCOPE_AGENT); }
__device__ __forceinline__ unsigned xb_xcc_id() { return (unsigned)__builtin_amdgcn_s_getreg((3 << 11) | 20) & 0xFu; }
#define XB_SPIN(cond, bar) do { unsigned _sp = 0; while (cond) { __builtin_amdgcn_s_sleep(1); \
    if ((++_sp & 255u) == 0u) { if (xb_ld(&(bar)[XB_TMO])) break; if (_sp > XB_SPIN_CAP) { atomicAdd(&(bar)[XB_TMO], 1u); break; } } } } while (0)

struct XcdBarrier {
    unsigned* bar; unsigned x;
    volatile LAS unsigned* st;
};

__device__ __forceinline__ XcdBarrier xcd_barrier_post(unsigned* bar, volatile LAS unsigned* st) {
    XcdBarrier b; b.bar = bar; b.x = xb_xcc_id(); b.st = st;
    if (threadIdx.x == 0) (void)xb_add(&bar[XB_XCNT(b.x)], 1u);
    return b;
}
__device__ __forceinline__ void xcd_barrier_complete(unsigned* bar, unsigned x, unsigned& nloc, unsigned& nx) {
    const unsigned G = gridDim.x * gridDim.y * gridDim.z;
    unsigned sum, cnt, mine, sp = 0u;
    for (;;) {
        sum = 0u; cnt = 0u; mine = 0u;
#pragma unroll
        for (unsigned j = 0; j < 16; ++j) { const unsigned c = xb_ld(&bar[XB_XCNT(j)]); sum += c; cnt += (c > 0u) ? 1u : 0u; mine = (j == x) ? c : mine; }
        if (sum == G) break;
        __builtin_amdgcn_s_sleep(1);
        if ((++sp & 255u) == 0u) { if (xb_ld(&bar[XB_TMO])) break; if (sp > XB_SPIN_CAP) { atomicAdd(&bar[XB_TMO], 1u); break; } }
    }
    nloc = mine > 0u ? mine : 1u; nx = cnt > 0u ? cnt : 1u;
}

__device__ __forceinline__ void xcd_barrier(const XcdBarrier& b) {
    asm volatile("s_waitcnt vmcnt(0)" ::: "memory");
    __syncthreads();
    if (threadIdx.x == 0) {
        unsigned* bar = b.bar;
        __builtin_amdgcn_s_waitcnt(0);
        unsigned nloc = b.st[0], nx = b.st[1];
        if (nloc == 0u) { xcd_barrier_complete(bar, b.x, nloc, nx); b.st[0] = nloc; b.st[1] = nx; }
        const unsigned old = xb_add(&bar[XB_XSUB(b.x)], 1u);
        const unsigned gen = old / nloc;
        if (old + 1u == (gen + 1u) * nloc) {
            __builtin_amdgcn_fence(__ATOMIC_RELEASE, "agent");
            asm volatile("s_waitcnt vmcnt(0)" ::: "memory");
            const unsigned og = xb_add(&bar[XB_TOP], 1u);
            const unsigned tg = og / nx;
            if (og + 1u == (tg + 1u) * nx) xb_add(&bar[XB_TOPGEN], 1u);
            else XB_SPIN(xb_ld(&bar[XB_TOPGEN]) == tg, bar);
            __builtin_amdgcn_fence(__ATOMIC_ACQUIRE, "agent");
            xb_add(&bar[XB_XGEN(b.x)], 1u);
            asm volatile("s_waitcnt vmcnt(0)" ::: "memory");
        } else {
            XB_SPIN(xb_ld(&bar[XB_XGEN(b.x)]) == gen, bar);
            __builtin_amdgcn_fence(__ATOMIC_ACQUIRE, "agent");
            asm volatile("s_waitcnt vmcnt(0)" ::: "memory");
        }
    }
    __syncthreads();
}


constexpr size_t WS_XBAR = 800 * 1024;
constexpr int LDS_XB = LDS_BYTES - 64;
constexpr int NPHASE = 10;
__global__ void __launch_bounds__(512, 2) mega_fwd(Params p) {
    extern __shared__ __attribute__((aligned(16))) unsigned char lds_raw[];
    LAS unsigned char* lds = (LAS unsigned char*)lds_raw;
    __builtin_assume(__builtin_amdgcn_workitem_id_y() == 0); __builtin_assume(__builtin_amdgcn_workitem_id_z() == 0);
    cg::grid_group grid = cg::this_grid();
    unsigned char* ws = p.ws;
    const int tid = threadIdx.x, lane = tid & 63, wid = __builtin_amdgcn_readfirstlane(tid >> 6);
    const int G = gridDim.x, gw = blockIdx.x * 8 + wid, NGW = G * 8, gt = blockIdx.x * 512 + tid, NGT = G * 512;
    const int lo = p.ph_lo, hi = p.ph_hi;
    if (threadIdx.x < 2) ((volatile LAS unsigned*)(lds + LDS_XB))[threadIdx.x] = 0u;
    __syncthreads();
    XcdBarrier xbar; xbar.bar = (unsigned*)(ws + WS_XBAR); xbar.x = 0; xbar.st = nullptr;
    if (hi - lo > 1) xbar = xcd_barrier_post((unsigned*)(ws + WS_XBAR), (volatile LAS unsigned*)(lds + LDS_XB));
#ifdef PH_ONLY
#define IN(k) ((k) == PH_ONLY && lo <= (k) && (k) < hi)
#else
#define IN(k) (lo <= (k) && (k) < hi)
#endif
#define SEAM(k) do { if (IN(k) && IN((k) + 1)) { if (hi > 1000) grid.sync();   else xcd_barrier(xbar); } } while (0)
#define PHASE_IDS() int tid_q = threadIdx.x; asm volatile("" : "+v"(tid_q)); const int lane = tid_q & 63, gt = blockIdx.x * 512 + tid_q; (void)gt; (void)lane

    if (IN(0)) {
        PHASE_IDS();
        LAS float* scr = (LAS float*)(lds + wid * 8448);
        constexpr int I_IN = 16 * 70, I_UQ = 6 * 24, I_UKV = 4 * 32, I_OUT = 16 * 32, I_G = 16 * 88, I_D = 44 * 32;
        constexpr int NITEMS = I_IN + I_UQ + I_UKV + I_OUT + 2 * I_G + I_D;
        for (int it = gw; it < NITEMS; it += NGW) {
            int r = it;
            if (r < I_IN) { p0_transpose_item(p.in[9], 1024, DIN, ((bf16_t*)(ws + WS_WIN)), 1, scr, r, lane); continue; } r -= I_IN;
            if (r < I_UQ) { p0_transpose_item(p.in[12], 384, 768, ((bf16_t*)(ws + WS_WUQ)), 4, scr, r, lane); continue; } r -= I_UQ;
            if (r < I_UKV) { p0_transpose_item(p.in[14], 256, 1024, ((bf16_t*)(ws + WS_WUKV)), 0, scr, r, lane); continue; } r -= I_UKV;
            if (r < I_OUT) { p0_transpose_item(p.in[15], 1024, 1024, ((bf16_t*)(ws + WS_WOUT)), 0, scr, r, lane); continue; } r -= I_OUT;
            if (r < I_G) { p0_transpose_item(p.in[17], 1024, DFF, ((bf16_t*)(ws + WS_WGU)), 2, scr, r, lane, p.in[16]); continue; } r -= I_G;
            if (r < I_G) { p0_transpose_item(p.in[18], 1024, DFF, ((bf16_t*)(ws + WS_WGU)), 3, scr, r, lane, p.in[16]); continue; } r -= I_G;
            p0_transpose_item(p.in[19], DFF, 1024, ((bf16_t*)(ws + WS_WDN)), 0, scr, r, lane);
        }
        if (gt < 16) ((unsigned*)(ws + WS_KINF))[gt] = 0u;
        for (int c = gt; c < RT; c += NGT) { ((float*)(ws + WS_SS1))[c] = 0.f; ((float*)(ws + WS_SS2))[c] = 0.f; }
        for (int c = gt; c < 88 * 128; c += NGT) ((u32x4*)(((bf16_t*)(ws + WS_WIN)) + (size_t)680 * 1024))[c] = (u32x4){0, 0, 0, 0};
        bf16_t* XN = (bf16_t*)(ws + WS_XN);
        for (int r0 = gw; r0 < RT; r0 += 2 * NGW) {
            const int r1 = r0 + NGW;
            const float* xa = x_of_row(p, r0); const float* xb = r1 < RT ? x_of_row(p, r1) : nullptr;
            if (xa && xb) { norm_rows2_to_bf16(xa, xb, p.in[8], XN + (size_t)r0 * DM, XN + (size_t)r1 * DM, lane); continue; }
#pragma unroll 1
            for (int k = 0; k < 2; ++k) { const int r = k ? r1 : r0; if (r >= RT) break; const float* xr = k ? xb : xa;
                if (xr) norm_row_to_bf16(xr, p.in[8], XN + (size_t)r * DM, lane);
                else { ((u32x4*)(XN + (size_t)r * DM))[lane] = (u32x4){0, 0, 0, 0}; ((u32x4*)(XN + (size_t)r * DM))[lane + 64] = (u32x4){0, 0, 0, 0}; } }
        }
        for (int i = gt; i < LP * 16; i += NGT) rope_entry((float*)(ws + WS_ROPE), i);
        { const float* cl = p.in[2]; bf16_t* CLAT = (bf16_t*)(ws + WS_CLAT);
          for (int c = gt; c < 131072 * 32; c += NGT) { const f32x4 a = ((const f32x4*)cl)[2 * (size_t)c], b2 = ((const f32x4*)cl)[2 * (size_t)c + 1]; ((u32x4*)CLAT)[c] = pack8(a, b2); }
          const float* ck = p.in[3]; bf16_t* CKR = (bf16_t*)(ws + WS_CKR);
          for (int c = gt; c < 131072 * 4; c += NGT) { const f32x4 a = ((const f32x4*)ck)[2 * (size_t)c], b2 = ((const f32x4*)ck)[2 * (size_t)c + 1]; ((u32x4*)CKR)[c] = pack8(a, b2); } }
        for (int g = gw; g < 4096; g += NGW) cache_cum_group(p.in[6], (float*)(ws + WS_CLC), (float*)(ws + WS_CTT), g, lane);
    }
    SEAM(0);
    if (IN(1)) {
        { pg8::Gemm g{(const bf16_t*)(ws + WS_XN), ((bf16_t*)(ws + WS_WIN)), RT, 2304, 1024}; pg8::StaticOrder S; S.init(RT, 2304, G, (int)blockIdx.x);
          EpiG1 E{(bf16_t*)(ws + WS_PROJC), (bf16_t*)(ws + WS_FQ), (bf16_t*)(ws + WS_FKH), (bf16_t*)(ws + WS_FVH), p.out, (unsigned*)(ws + WS_KINF)};
          pg8::gemm_phase<EpiG1, pg8::StaticOrder, false, true>(lds, g, S, E); }
        { pg8::Gemm g{(const bf16_t*)(ws + WS_CLAT), ((bf16_t*)(ws + WS_WUKV)), 131072, 1024, 256}; pg8::StaticOrder S; S.init(131072, 1024, G, (int)blockIdx.x);
          EpiKV E{(bf16_t*)(ws + WS_KNC), (bf16_t*)(ws + WS_VMC), (size_t)131072};
          pg8::gemm_phase<EpiKV, pg8::StaticOrder, false, true>(lds, g, S, E); }
    }
    SEAM(1);
    if (IN(2)) { PHASE_IDS(); for (int gi = gw; gi < NGRP; gi += NGW) p2_group(p, gi, lane); }
    SEAM(2);
    if (IN(3)) {
        { pg8::Gemm g{(const bf16_t*)(ws + WS_CQN), ((bf16_t*)(ws + WS_WUQ)), RT, 768, 384}; pg8::StaticOrder S; S.init(RT, 768, G, (int)blockIdx.x);
          EpiBf16 E{(bf16_t*)(ws + WS_QMLA), 768};
          pg8::gemm_phase<EpiBf16, pg8::StaticOrder, false, true>(lds, g, S, E); }
        { pg8::Gemm g{(const bf16_t*)(ws + WS_LATN), ((bf16_t*)(ws + WS_WUKV)), RT, 1024, 256}; pg8::StaticOrder S; S.init(RT, 1024, G, (int)blockIdx.x);
          EpiKV E{(bf16_t*)(ws + WS_KNH), (bf16_t*)(ws + WS_VMH), (size_t)RT};
          pg8::gemm_phase<EpiKV, pg8::StaticOrder, false, true>(lds, g, S, E); }
    }
    SEAM(3);
    if (IN(4)) {
        const int bx = blockIdx.x;
        if (G == 256) {
#pragma unroll 1
            for (int r = 15; r >= 0; --r) {
                if (r == (bx & 15)) {
#pragma unroll 1
                    for (int k = 0; k < 2; ++k) { const int u = 2 * bx + k, sb = u >> 4, h = u & 7;
                        if ((u >> 3) & 1) attn_sample_unit<true>(p, lds, sb, h); else attn_sample_unit<false>(p, lds, sb, h); }
                }
                const int j = r >> 1, type = (r ^ bx) & 1, bh = (bx >> 1) & 63, q4 = (bx & 1) + 2 * (bx >> 7), qb = 4 * j + ((j & 1) ? 3 - q4 : q4);
                if (type) attn_prompt_unit<true>(p, lds, bh >> 3, (bh + j) & 7, qb); else attn_prompt_unit<false>(p, lds, bh >> 3, bh & 7, qb);
            }
        } else {
            for (int su = 2 * bx; su < 512; su += 2 * G) {
#pragma unroll 1
                for (int k = 0; k < 2; ++k) { const int u = su + k, sb = u >> 4, h = u & 7;
                    if ((u >> 3) & 1) attn_sample_unit<true>(p, lds, sb, h); else attn_sample_unit<false>(p, lds, sb, h); }
            }
            for (int ui = bx; ui < 4096; ui += G) {
                const int qb = 31 - (ui >> 7), c = ui & 127, type = c >> 6, b = (c >> 3) & 7, h = c & 7;
                if (type) attn_prompt_unit<true>(p, lds, b, h, qb); else attn_prompt_unit<false>(p, lds, b, h, qb);
            }
        }
    }
    SEAM(4);
    if (IN(5)) {
        pg8::Gemm g{(const bf16_t*)(ws + WS_MIXED), ((bf16_t*)(ws + WS_WOUT)), RS0, 1024, 1024}; pg8::StaticOrder S; S.init(RS0, 1024, G, (int)blockIdx.x);
        EpiRes E{p.in[0], p.in[1], (bf16_t*)(ws + WS_HN), (float*)(ws + WS_SS1)};
        pg8::gemm_phase<EpiRes, pg8::StaticOrder, true, true>(lds, g, S, E);
        { pg8::Gemm g2{(const bf16_t*)(ws + WS_MIXED), ((bf16_t*)(ws + WS_WOUT)), RT, 1024, 256, 1024}; SplitOrder S2{(int)blockIdx.x, 4};
          EpiPart E2{(float*)(ws + WS_XPART)};
          pg8::gemm_phase<EpiPart, SplitOrder, false, true>(lds, g2, S2, E2); }
        xcd_barrier(xbar);
        {
            PHASE_IDS();
            bf16_t* x1b = (bf16_t*)(ws + WS_HN); float* ss1 = (float*)(ws + WS_SS1);
            for (int r = RS0 + gw; r < RM0; r += NGW) {
                const float* xr = p.in[1] + (size_t)(r - RS0) * DM + 16 * lane; const float* xp = (const float*)(ws + WS_XPART) + (size_t)(r - RS0) * 1024 + 16 * lane;
                f32x4 v[4];
#pragma unroll
                for (int j = 0; j < 4; ++j) v[j] = ((const f32x4*)xr)[j];
#pragma unroll
                for (int ks = 0; ks < 4; ++ks)
#pragma unroll
                    for (int j = 0; j < 4; ++j) v[j] = v[j] + ((const f32x4*)(xp + (size_t)ks * 1024 * 1024))[j];
                float sq = 0.f;
#pragma unroll
                for (int j = 0; j < 4; ++j) sq += (v[j].x * v[j].x + v[j].y * v[j].y) + (v[j].z * v[j].z + v[j].w * v[j].w);
                sq = wave_sum(sq);
                ((u32x4*)(x1b + (size_t)r * DM))[2 * lane] = pack8(v[0], v[1]); ((u32x4*)(x1b + (size_t)r * DM))[2 * lane + 1] = pack8(v[2], v[3]);
                if (lane == 0) ss1[r] = sq;
            }
        }
    }
    if (IN(5) && IN(7)) xcd_barrier(xbar);
    if (IN(7)) {
        pg8::Gemm g{(const bf16_t*)(ws + WS_HN), ((bf16_t*)(ws + WS_WGU)), RT, 2 * DFF, 1024}; pg8::StaticOrder S; S.init(RT, 2 * DFF, G, (int)blockIdx.x);
        EpiSwiglu E{(bf16_t*)(ws + WS_ACT), (const float*)(ws + WS_SS1)};
        pg8::gemm_phase<EpiSwiglu, pg8::StaticOrder, true, true>(lds, g, S, E);
    }
    SEAM(7);
    if (IN(8)) {
        pg8::Gemm g{(const bf16_t*)(ws + WS_ACT), ((bf16_t*)(ws + WS_WDN)), RS0, 1024, DFF, 0}; pg8::StaticOrder S; S.init(RS0, 1024, G, (int)blockIdx.x);
        EpiAcc E{(bf16_t*)(ws + WS_HN), (float*)(ws + WS_SS2)};
        pg8::gemm_phase<EpiAcc, pg8::StaticOrder, true, true>(lds, g, S, E);
        { pg8::Gemm g2{(const bf16_t*)(ws + WS_ACT), ((bf16_t*)(ws + WS_WDN)), RT, 1024, 256, DFF}; SplitOrder S2{(int)blockIdx.x, 11};
          EpiPart E2{(float*)(ws + WS_XPART)};
          pg8::gemm_phase<EpiPart, SplitOrder, false, true>(lds, g2, S2, E2); }
    }
    SEAM(8);
    if (IN(9)) {
        PHASE_IDS();
        const bf16_t* x2b = (const bf16_t*)(ws + WS_HN); const float* ss2 = (const float*)(ws + WS_SS2); const float* g = p.in[20];
        f32x4 gg[4];
#pragma unroll
        for (int j = 0; j < 4; ++j) gg[j] = ((const f32x4*)g)[4 * lane + j];
        for (int r = RS0 + gw; r < RM0; r += NGW) {
            const u32x4 w0 = ((const u32x4*)(x2b + (size_t)r * DM))[2 * lane], w1 = ((const u32x4*)(x2b + (size_t)r * DM))[2 * lane + 1];
            f32x4 v[4];
            v[0] = (f32x4){__uint_as_float(w0.x << 16), __uint_as_float(w0.x & 0xffff0000u), __uint_as_float(w0.y << 16), __uint_as_float(w0.y & 0xffff0000u)};
            v[1] = (f32x4){__uint_as_float(w0.z << 16), __uint_as_float(w0.z & 0xffff0000u), __uint_as_float(w0.w << 16), __uint_as_float(w0.w & 0xffff0000u)};
            v[2] = (f32x4){__uint_as_float(w1.x << 16), __uint_as_float(w1.x & 0xffff0000u), __uint_as_float(w1.y << 16), __uint_as_float(w1.y & 0xffff0000u)};
            v[3] = (f32x4){__uint_as_float(w1.z << 16), __uint_as_float(w1.z & 0xffff0000u), __uint_as_float(w1.w << 16), __uint_as_float(w1.w & 0xffff0000u)};
            const float* xp = (const float*)(ws + WS_XPART) + (size_t)(r - RS0) * 1024 + 16 * lane;
#pragma unroll 1
            for (int ks = 0; ks < 11; ++ks) {
#pragma unroll
                for (int j = 0; j < 4; ++j) v[j] = v[j] + ((const f32x4*)(xp + (size_t)ks * 1024 * 1024))[j]; }
            float sq = 0.f;
#pragma unroll
            for (int j = 0; j < 4; ++j) sq += (v[j].x * v[j].x + v[j].y * v[j].y) + (v[j].z * v[j].z + v[j].w * v[j].w);
            const float rstd = 1.0f / sqrtf(wave_sum(sq) * (1.0f / DM) + EPS);
            f32x4* o4 = (f32x4*)(p.out + (size_t)r * DM) + 4 * lane;
#pragma unroll
            for (int j = 0; j < 4; ++j) o4[j] = v[j] * rstd * gg[j];
        }
        for (int rb = gw; rb < RS0; rb += 4 * NGW) {
            u32x4 w0[4], w1[4]; float sr[4];
#pragma unroll
            for (int k = 0; k < 4; ++k) { const int r = rb + k * NGW; const u32x4* src = (const u32x4*)(x2b + (size_t)(r < RS0 ? r : rb) * DM); w0[k] = src[2 * lane]; w1[k] = src[2 * lane + 1]; sr[k] = ss2[r < RS0 ? r : rb]; }
#pragma unroll
            for (int k = 0; k < 4; ++k) { const int r = rb + k * NGW; if (r >= RS0) break;
                const float rstd = 1.0f / sqrtf(sr[k] * (1.0f / DM) + EPS);
                f32x4* o4 = (f32x4*)(p.out + (size_t)r * DM) + 4 * lane;
                o4[0] = (f32x4){__uint_as_float(w0[k].x << 16), __uint_as_float(w0[k].x & 0xffff0000u), __uint_as_float(w0[k].y << 16), __uint_as_float(w0[k].y & 0xffff0000u)} * rstd * gg[0];
                o4[1] = (f32x4){__uint_as_float(w0[k].z << 16), __uint_as_float(w0[k].z & 0xffff0000u), __uint_as_float(w0[k].w << 16), __uint_as_float(w0[k].w & 0xffff0000u)} * rstd * gg[1];
                o4[2] = (f32x4){__uint_as_float(w1[k].x << 16), __uint_as_float(w1[k].x & 0xffff0000u), __uint_as_float(w1[k].y << 16), __uint_as_float(w1[k].y & 0xffff0000u)} * rstd * gg[2];
                o4[3] = (f32x4){__uint_as_float(w1[k].z << 16), __uint_as_float(w1[k].z & 0xffff0000u), __uint_as_float(w1[k].w << 16), __uint_as_float(w1[k].w & 0xffff0000u)} * rstd * gg[3];
            }
        }
    }
#undef IN
#undef SEAM
}

#ifndef MK_N_LAUNCHES
#define MK_N_LAUNCHES 1
#endif
extern "C" void kernel_launch(void* const* d_in, const int* in_sizes, int n_in, void* d_out, int out_size, void* d_ws, size_t ws_size, hipStream_t stream) {
    static int grid = 0;
    if (grid == 0) {
        if (n_in != 21 || (size_t)out_size != O_END || ws_size < WS_END) { fprintf(stderr, "kernel_launch: unexpected shapes n_in %d out %d ws %zu (need %zu)\n", n_in, out_size, ws_size, (size_t)WS_END); grid = -1; return; }
        int dev = 0, cus = 0, per_cu = 0;
        hipGetDevice(&dev); hipDeviceGetAttribute(&cus, hipDeviceAttributeMultiprocessorCount, dev);
        if (hipFuncSetAttribute((const void*)mega_fwd, hipFuncAttributeMaxDynamicSharedMemorySize, LDS_BYTES) != hipSuccess) { fprintf(stderr, "kernel_launch: hipFuncSetAttribute failed\n"); grid = -1; return; }
        if (hipOccupancyMaxActiveBlocksPerMultiprocessor(&per_cu, (const void*)mega_fwd, 512, LDS_BYTES) != hipSuccess || per_cu < 1) { fprintf(stderr, "kernel_launch: occupancy query says %d\n", per_cu); per_cu = 1; }
        (void)hipGetLastError();
        grid = cus;
    }
    if (grid < 0) return;
    Params prm{};
    for (int i = 0; i < 21; ++i) prm.in[i] = (const float*)d_in[i];
    prm.out = (float*)d_out; prm.ws = (unsigned char*)d_ws;
#if MK_N_LAUNCHES == 1
    (void)hipMemsetAsync((unsigned char*)d_ws + WS_XBAR, 0, 16384, stream);
    prm.ph_lo = 0; prm.ph_hi = NPHASE;
    void* args[] = {&prm};
    hipError_t e = hipLaunchCooperativeKernel((const void*)mega_fwd, dim3(grid), dim3(512), args, LDS_BYTES, stream);
    if (e != hipSuccess) fprintf(stderr, "cooperative launch failed: %s (grid %d)\n", hipGetErrorString(e), grid);
#ifdef PROBE_EXTRA_PHASE
    { Params q2 = prm; q2.ph_lo = PROBE_EXTRA_PHASE; q2.ph_hi = PROBE_EXTRA_PHASE + 1; hipLaunchKernelGGL(mega_fwd, dim3(grid), dim3(512), LDS_BYTES, stream, q2); }
#endif
#else
    for (int k = 0; k < NPHASE; ++k) { prm.ph_lo = k; prm.ph_hi = k + 1; hipLaunchKernelGGL(mega_fwd, dim3(grid), dim3(512), LDS_BYTES, stream, prm); }
#endif
}
```
